# Optimizing an MI355X kernel written in HIP

```python
import math
import jax, jax.numpy as jnp
from jax import lax
import numpy as np

D_MODEL = 2048
BATCH = 1
SEQ = 8192
DEPTH = 4

MIXER_ORDER = ("mla", "hyena", "diff")
N_MIXERS = len(MIXER_ORDER)

RMS_EPS = 1e-6
ROPE_THETA = 10000.0
Q_BLOCK = 128

MLA_HEADS = 16
MLA_Q_LORA = 768
MLA_KV_LORA = 512
MLA_NOPE = 128
MLA_ROPE = 64
MLA_V = 128
MLA_SCALE = (MLA_NOPE + MLA_ROPE) ** -0.5

HY_ORDER = 2
HY_EMB_DIM = 33
HY_FILTER_WIDTH = 64
HY_SHORT = 3
HY_TARGET = 1e-2
HY_FAST_PCT = 0.3
HY_SLOW_PCT = 1.5
HY_MAX_DECAY = math.log(HY_TARGET) / HY_FAST_PCT
HY_MIN_DECAY = math.log(HY_TARGET) / HY_SLOW_PCT
HY_SHIFT = 0.0

DIFF_HEAD_DIM = 128
DIFF_HEADS = D_MODEL // (2 * DIFF_HEAD_DIM)
DIFF_QK = DIFF_HEADS * 2 * DIFF_HEAD_DIM
DIFF_SCALE = DIFF_HEAD_DIM ** -0.5
DIFF_EPS = 1e-5

D_FF = -(-8 * D_MODEL // (3 * 256)) * 256

kernel_name = "hybrid_mla_hyena_diffattn_encoder"


def _rms_norm(x, g, eps=RMS_EPS):
    xf = x.astype(jnp.float32)
    y = xf * lax.rsqrt(jnp.mean(xf * xf, axis=-1, keepdims=True) + eps)
    return (y * g.astype(jnp.float32)).astype(x.dtype)


def _rope_tables(seq, dim):
    inv = 1.0 / (ROPE_THETA ** (jnp.arange(0, dim, 2, dtype=jnp.float32) / dim))
    ang = jnp.arange(seq, dtype=jnp.float32)[:, None] * inv[None, :]
    return jnp.cos(ang), jnp.sin(ang)


def _apply_rope(x, cos, sin):
    shape = (x.shape[1],) + (1,) * (x.ndim - 3) + (cos.shape[-1],)
    c = cos.reshape(shape).astype(x.dtype)
    s = sin.reshape(shape).astype(x.dtype)
    x1, x2 = jnp.split(x, 2, axis=-1)
    return jnp.concatenate([x1 * c - x2 * s, x1 * s + x2 * c], axis=-1)


def _blocked_attention(q, k, v, scale):
    b, h, s, dk = q.shape
    nb = s // Q_BLOCK
    qb = q.reshape(b, h, nb, Q_BLOCK, dk).transpose(2, 0, 1, 3, 4)

    def block(qblk):
        sc = jnp.einsum("bhqd,bhkd->bhqk", qblk, k).astype(jnp.float32) * scale
        p = jax.nn.softmax(sc, axis=-1).astype(v.dtype)
        return jnp.einsum("bhqk,bhkd->bhqd", p, v)

    o = lax.map(block, qb)
    return o.transpose(1, 2, 0, 3, 4).reshape(b, h, s, v.shape[-1])


def _mla(xn, w_in, q_norm, w_uq, kv_norm, w_ukv, w_o, cos, sin):
    b, s, _ = xn.shape
    hcat = xn @ w_in
    c_q = hcat[..., :MLA_Q_LORA]
    c_kv = hcat[..., MLA_Q_LORA:MLA_Q_LORA + MLA_KV_LORA]
    k_r = hcat[..., MLA_Q_LORA + MLA_KV_LORA:]
    q = (_rms_norm(c_q, q_norm) @ w_uq).reshape(b, s, MLA_HEADS, MLA_NOPE + MLA_ROPE)
    q = jnp.concatenate([q[..., :MLA_NOPE], _apply_rope(q[..., MLA_NOPE:], cos, sin)], axis=-1)
    kv = (_rms_norm(c_kv, kv_norm) @ w_ukv).reshape(b, s, MLA_HEADS, MLA_NOPE + MLA_V)
    k_r = _apply_rope(k_r[:, :, None, :], cos, sin)
    k = jnp.concatenate([kv[..., :MLA_NOPE], jnp.broadcast_to(k_r, (b, s, MLA_HEADS, MLA_ROPE))], axis=-1)
    v = kv[..., MLA_NOPE:]
    o = _blocked_attention(q.transpose(0, 2, 1, 3), k.transpose(0, 2, 1, 3), v.transpose(0, 2, 1, 3), MLA_SCALE)
    return o.transpose(0, 2, 1, 3).reshape(b, s, MLA_HEADS * MLA_V) @ w_o


def _hyena_filter_spectrum(seq, f_w1, f_b1, f_freq, f_w2, f_b2, f_w3, f_b3, f_w4):
    f32 = jnp.float32
    t = jnp.linspace(0.0, 1.0, seq, dtype=f32)[:, None]
    bands = (HY_EMB_DIM - 1) // 2
    w = 2.0 * math.pi * jnp.arange(seq, dtype=f32)[:, None] / seq
    f = jnp.linspace(1e-4, bands - 1, bands, dtype=f32)[None, :]
    z = jnp.concatenate([t, jnp.cos(f * w), -jnp.sin(f * w)], axis=-1)
    freq = f_freq.astype(f32)
    h = jnp.sin(freq * (z @ f_w1.astype(f32) + f_b1.astype(f32)))
    h = jnp.sin(freq * (h @ f_w2.astype(f32) + f_b2.astype(f32)))
    h = jnp.sin(freq * (h @ f_w3.astype(f32) + f_b3.astype(f32)))
    h = (h @ f_w4.astype(f32)).reshape(seq, 2, HY_ORDER, D_MODEL)
    deltas = jnp.abs(jnp.linspace(HY_MIN_DECAY, HY_MAX_DECAY, D_MODEL, dtype=f32))
    decay = jnp.exp(-t * deltas[None, :])
    h = h * (decay[:, None, None, :] + HY_SHIFT)
    kern = jnp.concatenate([h[:, 0], jnp.zeros((1, HY_ORDER, D_MODEL), f32), h[:0:-1, 1]], axis=0)
    kern = kern / jnp.sum(jnp.abs(kern), axis=0, keepdims=True)
    return jnp.fft.rfft(kern, axis=0)


def _hyena(xn, w_in, conv_w, conv_b, f_w1, f_b1, f_freq, f_w2, f_b2, f_w3, f_b3, f_w4, bias, w_out):
    b, s, _ = xn.shape
    u = xn @ w_in
    up = jnp.pad(u, ((0, 0), (1, 1), (0, 0)))
    u = up[:, :-2] * conv_w[0] + up[:, 1:-1] * conv_w[1] + up[:, 2:] * conv_w[2] + conv_b
    x1, x2, z = jnp.split(u, 3, axis=-1)
    spec = _hyena_filter_spectrum(s, f_w1, f_b1, f_freq, f_w2, f_b2, f_w3, f_b3, f_w4)
    for o, gate in enumerate((x1, x2)):
        zf = jnp.fft.rfft(z.astype(jnp.float32), n=2 * s, axis=1)
        conv = jnp.fft.irfft(zf * spec[None, :, o, :], n=2 * s, axis=1)[:, :s]
        z = gate * (conv.astype(z.dtype) + z * bias[o])
    return z @ w_out


def _diff_attention(xn, w_qkv, lq1, lk1, lq2, lk2, subln, w_o, cos, sin, layer_idx):
    f32 = jnp.float32
    b, s, _ = xn.shape
    qkv = xn @ w_qkv
    q = qkv[..., :DIFF_QK].reshape(b, s, DIFF_HEADS, 2, DIFF_HEAD_DIM)
    k = qkv[..., DIFF_QK:2 * DIFF_QK].reshape(b, s, DIFF_HEADS, 2, DIFF_HEAD_DIM)
    v = qkv[..., 2 * DIFF_QK:].reshape(b, s, DIFF_HEADS, 2 * DIFF_HEAD_DIM)
    q = _apply_rope(q, cos, sin)
    k = _apply_rope(k, cos, sin)
    lam_init = 0.8 - 0.6 * math.exp(-0.3 * layer_idx)
    lam = (jnp.exp(jnp.sum(lq1.astype(f32) * lk1.astype(f32)))
           - jnp.exp(jnp.sum(lq2.astype(f32) * lk2.astype(f32))) + lam_init)
    qh = q.transpose(0, 2, 3, 1, 4)
    kh = k.transpose(0, 2, 3, 1, 4)
    vh = v.transpose(0, 2, 1, 3)
    nb = s // Q_BLOCK
    qb = qh.reshape(b, DIFF_HEADS, 2, nb, Q_BLOCK, DIFF_HEAD_DIM).transpose(3, 0, 1, 2, 4, 5)

    def block(qblk):
        sc = jnp.einsum("bhcqd,bhckd->bhcqk", qblk, kh).astype(f32) * DIFF_SCALE
        p = jax.nn.softmax(sc, axis=-1)
        wgt = p[:, :, 0] - lam * p[:, :, 1]
        return jnp.einsum("bhqk,bhkd->bhqd", wgt.astype(vh.dtype), vh)

    o = lax.map(block, qb).transpose(1, 2, 0, 3, 4).reshape(b, DIFF_HEADS, s, 2 * DIFF_HEAD_DIM)
    o = _rms_norm(o, subln, DIFF_EPS) * (1.0 - lam_init)
    return o.transpose(0, 2, 1, 3).reshape(b, s, DIFF_HEADS * 2 * DIFF_HEAD_DIM) @ w_o


def _swiglu(xn, w_gate, w_up, w_down):
    return (jax.nn.silu(xn @ w_gate) * (xn @ w_up)) @ w_down


def setup_inputs(seed: int = 0) -> dict:
    key = jax.random.key(seed)
    keys = iter(jax.random.split(key, 96))
    f32 = jnp.float32

    def dense(fi, fo):
        return jax.random.normal(next(keys), (fi, fo), f32) * fi ** -0.5

    def gain(n):
        return 1.0 + 0.01 * jax.random.normal(next(keys), (n,), f32)

    def small(shape, scale):
        return scale * jax.random.normal(next(keys), shape, f32)

    p = {"x": jax.random.normal(next(keys), (BATCH, SEQ, D_MODEL), f32)}
    for i in range(DEPTH):
        kind = MIXER_ORDER[i % N_MIXERS]
        pre = "l%d_" % i
        p[pre + "mix_norm"] = gain(D_MODEL)
        if kind == "mla":
            p[pre + "mla_w_in"] = dense(D_MODEL, MLA_Q_LORA + MLA_KV_LORA + MLA_ROPE)
            p[pre + "mla_q_norm"] = gain(MLA_Q_LORA)
            p[pre + "mla_w_uq"] = dense(MLA_Q_LORA, MLA_HEADS * (MLA_NOPE + MLA_ROPE))
            p[pre + "mla_kv_norm"] = gain(MLA_KV_LORA)
            p[pre + "mla_w_ukv"] = dense(MLA_KV_LORA, MLA_HEADS * (MLA_NOPE + MLA_V))
            p[pre + "mla_w_o"] = dense(MLA_HEADS * MLA_V, D_MODEL)
        elif kind == "hyena":
            p[pre + "hy_w_in"] = dense(D_MODEL, 3 * D_MODEL)
            p[pre + "hy_conv_w"] = small((HY_SHORT, 3 * D_MODEL), HY_SHORT ** -0.5)
            p[pre + "hy_conv_b"] = small((3 * D_MODEL,), 0.01)
            p[pre + "hy_f_w1"] = dense(HY_EMB_DIM, HY_FILTER_WIDTH)
            p[pre + "hy_f_b1"] = small((HY_FILTER_WIDTH,), 0.1)
            p[pre + "hy_f_freq"] = gain(HY_FILTER_WIDTH)
            p[pre + "hy_f_w2"] = dense(HY_FILTER_WIDTH, HY_FILTER_WIDTH)
            p[pre + "hy_f_b2"] = small((HY_FILTER_WIDTH,), 0.1)
            p[pre + "hy_f_w3"] = dense(HY_FILTER_WIDTH, HY_FILTER_WIDTH)
            p[pre + "hy_f_b3"] = small((HY_FILTER_WIDTH,), 0.1)
            p[pre + "hy_f_w4"] = dense(HY_FILTER_WIDTH, 2 * HY_ORDER * D_MODEL)
            p[pre + "hy_bias"] = small((HY_ORDER, D_MODEL), 0.5)
            p[pre + "hy_w_out"] = dense(D_MODEL, D_MODEL)
        else:
            p[pre + "da_w_qkv"] = dense(D_MODEL, 3 * DIFF_QK)
            p[pre + "da_lq1"] = small((DIFF_HEAD_DIM,), 0.1)
            p[pre + "da_lk1"] = small((DIFF_HEAD_DIM,), 0.1)
            p[pre + "da_lq2"] = small((DIFF_HEAD_DIM,), 0.1)
            p[pre + "da_lk2"] = small((DIFF_HEAD_DIM,), 0.1)
            p[pre + "da_subln"] = gain(2 * DIFF_HEAD_DIM)
            p[pre + "da_w_o"] = dense(DIFF_QK, D_MODEL)
        p[pre + "ffn_norm"] = gain(D_MODEL)
        p[pre + "ffn_w_gate"] = dense(D_MODEL, D_FF)
        p[pre + "ffn_w_up"] = dense(D_MODEL, D_FF)
        p[pre + "ffn_w_down"] = dense(D_FF, D_MODEL)
    p["final_norm"] = gain(D_MODEL)
    return p


def reference(x,
              l0_mix_norm, l0_mla_w_in, l0_mla_q_norm, l0_mla_w_uq, l0_mla_kv_norm, l0_mla_w_ukv, l0_mla_w_o,
              l0_ffn_norm, l0_ffn_w_gate, l0_ffn_w_up, l0_ffn_w_down,
              l1_mix_norm, l1_hy_w_in, l1_hy_conv_w, l1_hy_conv_b, l1_hy_f_w1, l1_hy_f_b1, l1_hy_f_freq,
              l1_hy_f_w2, l1_hy_f_b2, l1_hy_f_w3, l1_hy_f_b3, l1_hy_f_w4, l1_hy_bias, l1_hy_w_out,
              l1_ffn_norm, l1_ffn_w_gate, l1_ffn_w_up, l1_ffn_w_down,
              l2_mix_norm, l2_da_w_qkv, l2_da_lq1, l2_da_lk1, l2_da_lq2, l2_da_lk2, l2_da_subln, l2_da_w_o,
              l2_ffn_norm, l2_ffn_w_gate, l2_ffn_w_up, l2_ffn_w_down,
              l3_mix_norm, l3_mla_w_in, l3_mla_q_norm, l3_mla_w_uq, l3_mla_kv_norm, l3_mla_w_ukv, l3_mla_w_o,
              l3_ffn_norm, l3_ffn_w_gate, l3_ffn_w_up, l3_ffn_w_down,
              final_norm):
    seq = x.shape[1]
    mla_cos, mla_sin = _rope_tables(seq, MLA_ROPE)
    diff_cos, diff_sin = _rope_tables(seq, DIFF_HEAD_DIM)
    mix_norms = (l0_mix_norm, l1_mix_norm, l2_mix_norm, l3_mix_norm)
    mixer_params = (
        (l0_mla_w_in, l0_mla_q_norm, l0_mla_w_uq, l0_mla_kv_norm, l0_mla_w_ukv, l0_mla_w_o),
        (l1_hy_w_in, l1_hy_conv_w, l1_hy_conv_b, l1_hy_f_w1, l1_hy_f_b1, l1_hy_f_freq,
         l1_hy_f_w2, l1_hy_f_b2, l1_hy_f_w3, l1_hy_f_b3, l1_hy_f_w4, l1_hy_bias, l1_hy_w_out),
        (l2_da_w_qkv, l2_da_lq1, l2_da_lk1, l2_da_lq2, l2_da_lk2, l2_da_subln, l2_da_w_o),
        (l3_mla_w_in, l3_mla_q_norm, l3_mla_w_uq, l3_mla_kv_norm, l3_mla_w_ukv, l3_mla_w_o),
    )
    ffn_params = (
        (l0_ffn_norm, l0_ffn_w_gate, l0_ffn_w_up, l0_ffn_w_down),
        (l1_ffn_norm, l1_ffn_w_gate, l1_ffn_w_up, l1_ffn_w_down),
        (l2_ffn_norm, l2_ffn_w_gate, l2_ffn_w_up, l2_ffn_w_down),
        (l3_ffn_norm, l3_ffn_w_gate, l3_ffn_w_up, l3_ffn_w_down),
    )
    for i in range(DEPTH):
        kind = MIXER_ORDER[i % N_MIXERS]
        xn = _rms_norm(x, mix_norms[i])
        if kind == "mla":
            x = x + _mla(xn, *mixer_params[i], mla_cos, mla_sin)
        elif kind == "hyena":
            x = x + _hyena(xn, *mixer_params[i])
        else:
            x = x + _diff_attention(xn, *mixer_params[i], diff_cos, diff_sin, i)
        f_norm, w_gate, w_up, w_down = ffn_params[i]
        x = x + _swiglu(_rms_norm(x, f_norm), w_gate, w_up, w_down)
    return _rms_norm(x, final_norm)
```

```cpp
#include <hip/hip_runtime.h>
#include <hip/hip_bf16.h>
#include <hip/hip_cooperative_groups.h>
#include <cstdio>
#include <cstdint>
namespace cg = cooperative_groups;

#ifndef MK_MULTI
#define MK_MULTI 0
#endif

#ifndef HY_REP_FFT
#define HY_REP_FFT 0
#endif
#ifndef HY_REP_KERN
#define HY_REP_KERN 0
#endif
#define LAS __attribute__((address_space(3)))
typedef unsigned short bf16_t;
typedef short bf16x8 __attribute__((ext_vector_type(8)));
typedef short s16x4 __attribute__((ext_vector_type(4)));
typedef float f32x4 __attribute__((ext_vector_type(4)));
typedef float f32x2 __attribute__((ext_vector_type(2)));
typedef float f32x16 __attribute__((ext_vector_type(16)));
typedef unsigned u32x4 __attribute__((ext_vector_type(4)));
typedef unsigned u32x2 __attribute__((ext_vector_type(2)));

constexpr int S = 8192, D = 2048, FF = 5632, NT512 = 512;
constexpr float RMS_EPS = 1e-6f;
constexpr int LDS_BYTES = 155648;

constexpr size_t MiB = 1u << 20;
constexpr size_t E_IN = (size_t)1536 * 2048, E_UQ = (size_t)3072 * 768, E_UKV = (size_t)4096 * 512, E_O = (size_t)2048 * 2048,
                 E_GU = (size_t)11264 * 2048, E_DN = (size_t)2048 * 5632, E_HY = (size_t)6144 * 2048;
constexpr size_t W0_IN = 0, W0_UQ = W0_IN + E_IN, W0_UKV = W0_UQ + E_UQ, W0_O = W0_UKV + E_UKV, W0_GU = W0_O + E_O, W0_DN = W0_GU + E_GU;
constexpr size_t W1_IN = W0_DN + E_DN, W1_O = W1_IN + E_HY, W1_GU = W1_O + E_O, W1_DN = W1_GU + E_GU;
constexpr size_t W2_IN = W1_DN + E_DN, W2_O = W2_IN + E_HY, W2_GU = W2_O + E_O, W2_DN = W2_GU + E_GU;
constexpr size_t W3_IN = W2_DN + E_DN, W3_UQ = W3_IN + E_IN, W3_UKV = W3_UQ + E_UQ, W3_O = W3_UKV + E_UKV, W3_GU = W3_O + E_O, W3_DN = W3_GU + E_GU;
constexpr size_t W_END_E = W3_DN + E_DN;
constexpr size_t WS_W = 0;
constexpr size_t WS_XB = ((W_END_E * 2 + MiB - 1) / MiB) * MiB;
constexpr size_t WS_AO = WS_XB + 32 * MiB;
constexpr size_t WS_SSQ = WS_AO + 32 * MiB;
constexpr size_t WS_MC = WS_SSQ + 4 * MiB, WS_MS = WS_MC + 1 * MiB;
constexpr size_t WS_DC = WS_MS + 1 * MiB, WS_DS = WS_DC + 2 * MiB;
constexpr size_t WS_H3 = WS_DS + 2 * MiB;
constexpr size_t WS_BAR = WS_H3 + 2 * MiB;
constexpr size_t WS_R = WS_BAR + 1 * MiB;
constexpr size_t R_CQ = WS_R, R_CKV = R_CQ + 12 * MiB, R_Q = R_CKV + 8 * MiB, R_K = R_Q + 48 * MiB, R_V = R_K + 48 * MiB;
constexpr size_t R_UT = WS_R, R_YT = R_UT + 192 * MiB, R_SPEC = R_YT + 32 * MiB, R_Z1 = R_SPEC + 64 * MiB, R_HY_END = R_Z1 + 16 * MiB;
constexpr size_t R_QD = WS_R, R_KD = R_QD + 32 * MiB, R_VD = R_KD + 32 * MiB, R_T = R_VD + 32 * MiB;
constexpr size_t R_H = WS_R;
constexpr size_t WS_END = R_HY_END;

struct Args { const float* in[54]; float* out; unsigned char* ws; int ph_lo, ph_hi, li, pad; };
typedef const __attribute__((address_space(4))) Args KA;
__device__ __forceinline__ KA* largs() { KA* p = (KA*)__builtin_amdgcn_kernarg_segment_ptr(); asm volatile("" : "+s"(p)); return p; }

__device__ __forceinline__ unsigned cvt_pk_bf16(float lo, float hi) { unsigned r; asm volatile("v_cvt_pk_bf16_f32 %0, %1, %2" : "=v"(r) : "v"(lo), "v"(hi)); return r; }
__device__ __forceinline__ float wave_sum(float v) {
#pragma unroll
    for (int o = 1; o < 64; o <<= 1) v += __shfl_xor(v, o);
    return v;
}
__device__ __forceinline__ int ltid() { int t = threadIdx.x; asm volatile("" : "+v"(t)); return t; }
__device__ __forceinline__ int lbid() { int b = blockIdx.x; asm volatile("" : "+s"(b)); return b; }
#define LDS_WAIT() asm volatile("s_waitcnt lgkmcnt(0)" ::: "memory")
__device__ __forceinline__ void sincos_acc(float x, float& s, float& c) {
    const double xd = (double)x; const double q = __builtin_rint(xd * 0.15915494309189533577);
    const float r = (float)(xd - q * 6.283185307179586476925);
    float sgn = 1.f, rr = r;
    if (rr > 1.5707963267948966f) { rr = 3.14159265358979323846f - rr; sgn = -1.f; }
    else if (rr < -1.5707963267948966f) { rr = -3.14159265358979323846f - rr; sgn = -1.f; }
    const float z = rr * rr;
    float ps = -7.6471637318198164759e-13f; ps = fmaf(ps, z, 1.6059043836821614599e-10f); ps = fmaf(ps, z, -2.5052108385441718775e-8f); ps = fmaf(ps, z, 2.7557319223985890653e-6f);
    ps = fmaf(ps, z, -1.9841269841269841270e-4f); ps = fmaf(ps, z, 8.3333333333333333333e-3f); ps = fmaf(ps, z, -1.6666666666666666667e-1f);
    s = fmaf(rr * z, ps, rr);
    float pc = 4.7794773323873852974e-14f; pc = fmaf(pc, z, -1.1470745597729724714e-11f); pc = fmaf(pc, z, 2.0876756987868098979e-9f); pc = fmaf(pc, z, -2.7557319223985890653e-7f);
    pc = fmaf(pc, z, 2.4801587301587301587e-5f); pc = fmaf(pc, z, -1.3888888888888888889e-3f); pc = fmaf(pc, z, 4.1666666666666666667e-2f); pc = fmaf(pc, z, -0.5f);
    c = sgn * fmaf(pc, z, 1.0f);
}
__device__ __forceinline__ float sin_acc(float x) { float s, c; sincos_acc(x, s, c); return s; }

namespace pg8 {
#define PG8_LAS __attribute__((address_space(3)))
constexpr int BM = 256, BK = 64, HALF = 128, HTB = HALF * BK * 2, STAGE_BYTES = 8 * HTB, NXCD = 8, WGM = 8;
__host__ __device__ __forceinline__ int lds_byte(int r, int c) { const int st = (r >> 4) * 2 + (c >> 5), rr = r & 15, cc = c & 31, ob = rr * 64 + cc * 2; return st * 1024 + (ob ^ (((ob >> 9) & 1) << 5)); }
__host__ __device__ __forceinline__ void stage_rc(int b, int& R, int& C) { const int st = b / 1024, sb = b % 1024, swz = sb ^ (((sb >> 9) & 1) << 5); R = (st >> 1) * 16 + swz / 64; C = (st & 1) * 32 + (swz % 64) / 2; }
__host__ __device__ __forceinline__ int perm32(int rho) { const int n = rho >> 4, i = rho & 15; return 8 * (i >> 2) + 4 * n + (i & 3); }
struct Unit { int pm, pn; };
struct Gemm { const bf16_t* A; const bf16_t* Bt; int M, N, K; };
struct StaticOrder {
    int nM, nN, nwg, G, c;
    __host__ __device__ void init(int M, int N, int G_, int c_) { nM = M / BM; nN = N / BM; nwg = nM * nN; G = G_; c = c_; }
    __host__ __device__ bool next(int i, Unit& u) const {
        const long L = (long)i * G + c; if (L >= nwg) return false;
        int wgid = (int)L; { const int q = nwg / NXCD, r = nwg % NXCD, xcd = wgid % NXCD, off = wgid / NXCD; wgid = (xcd < r ? xcd * (q + 1) : r * (q + 1) + (xcd - r) * q) + off; }
        const int nig = WGM * nN, gid = wgid / nig, fm = gid * WGM, gsz = (nM - fm) < WGM ? (nM - fm) : WGM;
        u.pm = fm + ((wgid % nig) % gsz); u.pn = (wgid % nig) / gsz; return true;
    }
};

template <class Epi, class Sched>
__device__ __forceinline__ void gemm_phase(PG8_LAS unsigned char* lds, const Gemm g, const Sched& S, const Epi& E) {
    const int tid = ltid(), wid = __builtin_amdgcn_readfirstlane(tid >> 6), lane = tid & 63, wr = wid >> 2, wc = wid & 3, fr = lane & 15, fq = lane >> 4;
    const int K = g.K, nt = K / BK;
    unsigned voffA[2], voffB[2];
#pragma unroll
    for (int i = 0; i < 2; ++i) { int R, C; stage_rc(tid * 16 + i * 8192, R, C); const int Rb = ((R & ~31) + perm32(R & 31));
        voffA[i] = (unsigned)(R * K + C) * 2u; voffB[i] = (unsigned)(Rb * K + C) * 2u; }
    const size_t kstep = (size_t)(BK * 2);
    const size_t hstep = (size_t)HALF * K * 2;
    const size_t tstep = 2 * hstep;
    const unsigned ldsw = (unsigned)wid * 1024u;
    const int aoff = lds_byte(wr * 64 + fr, fq * 8), boff = lds_byte(wc * 32 + fr, fq * 8);
#define PG8_SA(b, h) (((b) * 2 + (h)) * HTB)
#define PG8_SB(b, h) ((4 + (b) * 2 + (h)) * HTB)
#define PG8_STAGE(bufoff, gbase, voff) do { _Pragma("unroll") for (int _i = 0; _i < 2; ++_i) \
        __builtin_amdgcn_global_load_lds((const unsigned*)((const char*)(gbase) + (voff)[_i]), (PG8_LAS unsigned*)(lds + (bufoff) + ldsw + _i * 8192), 16, 0, 0); } while (0)
#define PG8_LDA(dst, b, h) do { _Pragma("unroll") for (int m = 0; m < 4; ++m) _Pragma("unroll") for (int k = 0; k < 2; ++k) dst[m][k] = *(const PG8_LAS bf16x8*)(lds + PG8_SA(b, h) + aoff + m * 2048 + k * 1024); } while (0)
#define PG8_LDB(dst, b, h) do { _Pragma("unroll") for (int n = 0; n < 2; ++n) _Pragma("unroll") for (int k = 0; k < 2; ++k) dst[n][k] = *(const PG8_LAS bf16x8*)(lds + PG8_SB(b, h) + boff + n * 2048 + k * 1024); } while (0)
#define PG8_MMA(ai, bj, At, Bt) do { __builtin_amdgcn_s_setprio(1); _Pragma("unroll") for (int m = 0; m < 4; ++m) _Pragma("unroll") for (int n = 0; n < 2; ++n) _Pragma("unroll") for (int k = 0; k < 2; ++k) \
        acc[ai][bj][m][n] = __builtin_amdgcn_mfma_f32_16x16x32_bf16(Bt[n][k], At[m][k], acc[ai][bj][m][n], 0, 0, 0); __builtin_amdgcn_s_setprio(0); } while (0)
#define PG8_WAIT_V(n) asm volatile("s_waitcnt vmcnt(" #n ")" ::: "memory")
#define PG8_WAIT_L(n) asm volatile("s_waitcnt lgkmcnt(" #n ")" ::: "memory")
#define PG8_BAR __builtin_amdgcn_s_barrier()
#define PG8_SCHED __builtin_amdgcn_sched_barrier(0)
    Unit cur, nxt; int ui = 0;
    if (!S.next(0, cur)) return;
    f32x4 acc[2][2][4][2];
#pragma unroll
    for (int a = 0; a < 2; ++a)
#pragma unroll
        for (int b = 0; b < 2; ++b)
#pragma unroll
            for (int m = 0; m < 4; ++m)
#pragma unroll
                for (int n = 0; n < 2; ++n) acc[a][b][m][n] = (f32x4){0.f, 0.f, 0.f, 0.f};
    bf16x8 At[4][2], B0[2][2], B1[2][2];
    const char* cA = (const char*)g.A + (size_t)cur.pm * tstep; const char* cB = (const char*)g.Bt + (size_t)cur.pn * tstep;
    PG8_STAGE(PG8_SB(0, 0), cB, voffB); PG8_STAGE(PG8_SB(0, 1), cB + hstep, voffB); PG8_STAGE(PG8_SA(0, 0), cA, voffA); PG8_STAGE(PG8_SA(0, 1), cA + hstep, voffA);
    if (wr == 1) PG8_BAR;
    PG8_WAIT_V(2); PG8_BAR;
    PG8_STAGE(PG8_SB(1, 0), cB + kstep, voffB); PG8_STAGE(PG8_SA(1, 0), cA + kstep, voffA); PG8_STAGE(PG8_SB(1, 1), cB + hstep + kstep, voffB);
    PG8_WAIT_V(6); PG8_BAR;
    for (;;) {
        const bool has_next = S.next(ui + 1, nxt);
        const char* nA = has_next ? (const char*)g.A + (size_t)nxt.pm * tstep : cA; const char* nB = has_next ? (const char*)g.Bt + (size_t)nxt.pn * tstep : cB;
        for (int t = 0; t < nt; t += 2) {
            const bool last = (t == nt - 2);
            const char* a1 = cA + (size_t)(t + 1) * kstep;
            const char* a2 = last ? nA : cA + (size_t)(t + 2) * kstep; const char* b2 = last ? nB : cB + (size_t)(t + 2) * kstep;
            const char* a3 = a2 + kstep; const char* b3 = b2 + kstep;
            PG8_LDB(B0, 0, 0); PG8_LDB(B1, 0, 1); PG8_SCHED; PG8_LDA(At, 0, 0); PG8_STAGE(PG8_SA(1, 1), a1 + hstep, voffA);
            PG8_WAIT_V(8); PG8_WAIT_L(0); PG8_BAR; PG8_MMA(0, 0, At, B0); PG8_MMA(0, 1, At, B1); PG8_BAR; PG8_SCHED;
            PG8_LDA(At, 0, 1); PG8_STAGE(PG8_SB(0, 0), b2, voffB); PG8_STAGE(PG8_SB(0, 1), b2 + hstep, voffB); PG8_STAGE(PG8_SA(0, 0), a2, voffA);
            PG8_WAIT_V(8); PG8_WAIT_L(0); PG8_BAR; PG8_MMA(1, 0, At, B0); PG8_MMA(1, 1, At, B1); PG8_BAR; PG8_SCHED;
            PG8_LDB(B0, 1, 0); PG8_LDB(B1, 1, 1); PG8_SCHED; PG8_LDA(At, 1, 0); PG8_STAGE(PG8_SA(0, 1), a2 + hstep, voffA);
            PG8_WAIT_V(8); PG8_WAIT_L(0); PG8_BAR; PG8_MMA(0, 0, At, B0); PG8_MMA(0, 1, At, B1); PG8_BAR; PG8_SCHED;
            PG8_LDA(At, 1, 1); PG8_STAGE(PG8_SB(1, 0), b3, voffB); PG8_STAGE(PG8_SB(1, 1), b3 + hstep, voffB); PG8_STAGE(PG8_SA(1, 0), a3, voffA);
            PG8_WAIT_V(8); PG8_WAIT_L(0); PG8_BAR; PG8_MMA(1, 0, At, B0); PG8_MMA(1, 1, At, B1); PG8_BAR; PG8_SCHED;
        }
        if (wr == 0) PG8_BAR;
        E(acc, cur, wr, wc, fr, fq);
        if (!has_next) break;
#pragma unroll
        for (int a = 0; a < 2; ++a)
#pragma unroll
            for (int b = 0; b < 2; ++b)
#pragma unroll
                for (int m = 0; m < 4; ++m)
#pragma unroll
                    for (int n = 0; n < 2; ++n) acc[a][b][m][n] = (f32x4){0.f, 0.f, 0.f, 0.f};
        cur = nxt; cA = nA; cB = nB; ++ui;
        if (wr == 1) PG8_BAR;
    }
    PG8_WAIT_V(0);
    PG8_BAR;
#undef PG8_SA
#undef PG8_SB
#undef PG8_STAGE
#undef PG8_LDA
#undef PG8_LDB
#undef PG8_MMA
#undef PG8_WAIT_V
#undef PG8_WAIT_L
#undef PG8_BAR
#undef PG8_SCHED
}
}

enum { EM_MLA_IN = 0, EM_MLA_UQ = 1, EM_MLA_UKV = 2, EM_RES = 3, EM_HY_IN = 4, EM_DIFF_QKV = 5, EM_GU = 6 };
struct Epi {
    static constexpr bool PERM = true;
    int mode;
    const float* ssq_in; float inv_k;
    float* ssq_out; float* ssq_out2;
    bf16_t* o0; bf16_t* o1; bf16_t* o2;
    float* xf; const float* xr;
    const float* cs; const float* sn;
    LAS float* exch;
    __device__ __forceinline__ static void st8(bf16_t* p, f32x4 a, f32x4 b) {
        u32x4 w; w.x = cvt_pk_bf16(a[0], a[1]); w.y = cvt_pk_bf16(a[2], a[3]); w.z = cvt_pk_bf16(b[0], b[1]); w.w = cvt_pk_bf16(b[2], b[3]); *(u32x4*)p = w; }
    __device__ __forceinline__ static void st4(bf16_t* p, f32x4 a) { u32x2 w; w.x = cvt_pk_bf16(a[0], a[1]); w.y = cvt_pk_bf16(a[2], a[3]); *(u32x2*)p = w; }
    __device__ __forceinline__ static float dot8(f32x4 a, f32x4 b) { return (a[0] * a[0] + a[1] * a[1]) + (a[2] * a[2] + a[3] * a[3]) + (b[0] * b[0] + b[1] * b[1]) + (b[2] * b[2] + b[3] * b[3]); }
    __device__ __forceinline__ void operator()(const f32x4 (&acc)[2][2][4][2], const pg8::Unit& u, int wr, int wc, int fr_, int fq_) const {
        int fr = fr_, fq = fq_; asm volatile("" : "+v"(fr), "+v"(fq));
        const int cw = wc * 32 + 8 * fq;
#pragma unroll
        for (int ai = 0; ai < 2; ++ai)
#pragma unroll
        for (int m = 0; m < 4; ++m) {
            const int r = u.pm * 256 + ai * 128 + wr * 64 + m * 16 + fr;
            float rs = 1.f;
            if (mode != EM_RES) { float t = 0.f;
#pragma unroll
                for (int p = 0; p < 8; ++p) t += ssq_in[(size_t)p * S + r];
                rs = rsqrtf(t * inv_k + RMS_EPS); }
            if (mode == EM_MLA_IN) {
                if (u.pn < 5) {
                    bf16_t* dst = (u.pn < 3) ? (o0 + (size_t)r * 768 + u.pn * 256) : (o1 + (size_t)r * 512 + (u.pn - 3) * 256);
                    float part = 0.f;
#pragma unroll
                    for (int bj = 0; bj < 2; ++bj) { const f32x4 v0 = acc[ai][bj][m][0] * rs, v1 = acc[ai][bj][m][1] * rs; part += dot8(v0, v1); st8(dst + bj * 128 + cw, v0, v1); }
                    part += __shfl_xor(part, 16); part += __shfl_xor(part, 32);
                    if (fq == 0) exch[(ai * 128 + wr * 64 + m * 16 + fr) * 4 + wc] = part;
                } else if (wc == 0) {
#pragma unroll
                    for (int n = 0; n < 2; ++n) { const int i0 = 8 * fq + 4 * n;
                        const f32x4 c = *(const f32x4*)(cs + (size_t)r * 32 + i0), s = *(const f32x4*)(sn + (size_t)r * 32 + i0);
                        const f32x4 x1 = acc[ai][0][m][n] * rs, x2 = acc[ai][1][m][n] * rs;
                        const f32x4 y1 = x1 * c - x2 * s, y2 = x1 * s + x2 * c;
                        u32x2 w1, w2; w1.x = cvt_pk_bf16(y1[0], y1[1]); w1.y = cvt_pk_bf16(y1[2], y1[3]); w2.x = cvt_pk_bf16(y2[0], y2[1]); w2.y = cvt_pk_bf16(y2[2], y2[3]);
                        bf16_t* kp = o2 + (size_t)r * 192 + 128 + i0;
#pragma unroll
                        for (int h = 0; h < 16; ++h) { *(u32x2*)(kp + (size_t)h * S * 192) = w1; *(u32x2*)(kp + (size_t)h * S * 192 + 32) = w2; } }
                }
            } else if (mode == EM_MLA_UQ) {
                if (u.pn < 8) {
#pragma unroll
                    for (int bj = 0; bj < 2; ++bj) { const int c = u.pn * 256 + bj * 128 + cw; st8(o0 + ((size_t)(c >> 7) * S + r) * 192 + (c & 127), acc[ai][bj][m][0] * rs, acc[ai][bj][m][1] * rs); }
                } else { const int head = 4 * (u.pn - 8) + wc;
#pragma unroll
                    for (int n = 0; n < 2; ++n) { const int i0 = 8 * fq + 4 * n;
                        const f32x4 c = *(const f32x4*)(cs + (size_t)r * 32 + i0), s = *(const f32x4*)(sn + (size_t)r * 32 + i0);
                        const f32x4 x1 = acc[ai][0][m][n] * rs, x2 = acc[ai][1][m][n] * rs;
                        bf16_t* qp = o0 + ((size_t)head * S + r) * 192 + 128 + i0;
                        st4(qp, x1 * c - x2 * s); st4(qp + 32, x1 * s + x2 * c); }
                }
            } else if (mode == EM_MLA_UKV) {
                st8(o0 + ((size_t)u.pn * S + r) * 192 + cw, acc[ai][0][m][0] * rs, acc[ai][0][m][1] * rs);
                st8(o1 + ((size_t)u.pn * S + r) * 128 + cw, acc[ai][1][m][0] * rs, acc[ai][1][m][1] * rs);
            } else if (mode == EM_RES) {
                float part = 0.f;
#pragma unroll
                for (int bj = 0; bj < 2; ++bj) { const int c = u.pn * 256 + bj * 128 + cw; bf16_t* bp = o0 + (size_t)r * 2048 + c;
                    f32x4 p0, p1;
                    if (xr) { const float* xq = xr + (size_t)r * 2048 + c; p0 = *(const f32x4*)xq; p1 = *(const f32x4*)(xq + 4); }
                    else { const u32x4 w = *(const u32x4*)bp;
                        p0 = (f32x4){__uint_as_float(w.x << 16), __uint_as_float(w.x & 0xffff0000u), __uint_as_float(w.y << 16), __uint_as_float(w.y & 0xffff0000u)};
                        p1 = (f32x4){__uint_as_float(w.z << 16), __uint_as_float(w.z & 0xffff0000u), __uint_as_float(w.w << 16), __uint_as_float(w.w & 0xffff0000u)}; }
                    const f32x4 x0 = p0 + acc[ai][bj][m][0], x1 = p1 + acc[ai][bj][m][1];
                    part += dot8(x0, x1); st8(bp, x0, x1); }
                part += __shfl_xor(part, 16); part += __shfl_xor(part, 32);
                if (fq == 0) exch[(ai * 128 + wr * 64 + m * 16 + fr) * 4 + wc] = part;
            } else if (mode == EM_HY_IN) {
#pragma unroll
                for (int bj = 0; bj < 2; ++bj)
#pragma unroll
                for (int n = 0; n < 2; ++n)
#pragma unroll
                for (int e = 0; e < 4; ++e) { const int c = u.pn * 256 + bj * 128 + cw + 4 * n + e; const float v = acc[ai][bj][m][n][e] * rs; o0[(size_t)c * S + r] = (bf16_t)(cvt_pk_bf16(v, v) & 0xffffu); }
            } else if (mode == EM_DIFF_QKV) {
                if (u.pn < 16) { bf16_t* dst = (u.pn < 8) ? o0 : o1; const int hc = 2 * (u.pn & 7) + (wc >> 1), ib = 32 * (wc & 1) + 8 * fq;
#pragma unroll
                    for (int n = 0; n < 2; ++n) { const int i0 = ib + 4 * n;
                        const f32x4 c = *(const f32x4*)(cs + (size_t)r * 64 + i0), s = *(const f32x4*)(sn + (size_t)r * 64 + i0);
                        const f32x4 x1 = acc[ai][0][m][n] * rs, x2 = acc[ai][1][m][n] * rs;
                        bf16_t* qp = dst + ((size_t)hc * S + r) * 128 + i0;
                        st4(qp, x1 * c - x2 * s); st4(qp + 64, x1 * s + x2 * c); }
                } else {
#pragma unroll
                    for (int bj = 0; bj < 2; ++bj) st8(o2 + ((size_t)(u.pn - 16) * S + r) * 256 + bj * 128 + cw, acc[ai][bj][m][0] * rs, acc[ai][bj][m][1] * rs);
                }
            } else {
                f32x4 hv[2];
#pragma unroll
                for (int n = 0; n < 2; ++n) { const f32x4 gg = acc[ai][0][m][n] * rs, uu = acc[ai][1][m][n] * rs;
#pragma unroll
                    for (int e = 0; e < 4; ++e) hv[n][e] = gg[e] * __builtin_amdgcn_rcpf(1.f + __expf(-gg[e])) * uu[e]; }
                st8(o0 + (size_t)r * FF + u.pn * 128 + cw, hv[0], hv[1]);
            }
        }
        if (mode == EM_RES || (mode == EM_MLA_IN && u.pn < 5)) {
            asm volatile("s_waitcnt lgkmcnt(0)" ::: "memory"); __builtin_amdgcn_s_barrier();
            const int t = ltid();
            if (t < 256) { const f32x4 p4 = *(const LAS f32x4*)(exch + t * 4); const float tot = (p4[0] + p4[1]) + (p4[2] + p4[3]);
                float* dst = (mode == EM_RES) ? (ssq_out + (size_t)u.pn * S) : ((u.pn < 3) ? (ssq_out + (size_t)u.pn * S) : (ssq_out2 + (size_t)(u.pn - 3) * S));
                dst[u.pm * 256 + t] = tot; }
        }
    }
};

#ifndef ATT192FN
#define ATT192FN attn_body192p
#endif
namespace att {
using bf16 = __hip_bfloat16;
constexpr int   D = 128, NW = 8, QBLK = 32, KVBLK = 64;
constexpr float THR = 8.f;
constexpr int SDEPTH = 2;
constexpr size_t SHM_V = KVBLK * D * 2, SHM_K = KVBLK * D * 2, SHM_ATTN = 2 * SHM_V + 2 * SHM_K + NW * 64 * 4;
using bf16x8 = __attribute__((ext_vector_type(8))) short;
using s16x4  = __attribute__((ext_vector_type(4))) short;
using f32x16 = __attribute__((ext_vector_type(16))) float;
using f32x8  = __attribute__((ext_vector_type(8))) float;
using u32x4  = __attribute__((ext_vector_type(4))) unsigned;
#define KSWZ(row, colB) ((row) * 256 + ((colB) ^ (((row) & 7) << 4)))
#define SBAR() __builtin_amdgcn_sched_barrier(0)
__device__ __forceinline__ int crow(int r, int hi) { return (r & 3) + 8 * (r >> 2) + 4 * hi; }
__device__ __forceinline__ unsigned cvtpk(float lo, float hi) {
  unsigned r; asm volatile("v_cvt_pk_bf16_f32 %0, %1, %2" : "=v"(r) : "v"(lo), "v"(hi)); return r;
}
template <typename TIn> struct Stage;
template <> struct Stage<bf16>  { using T = bf16x8;
  __device__ static __forceinline__ T ld8(const bf16* p) { return *reinterpret_cast<const bf16x8*>(p); }
  __device__ static __forceinline__ bf16x8 tobf(T x) { return x; } };
template <> struct Stage<float> { using T = f32x8;
  __device__ static __forceinline__ T ld8(const float* p) { return *reinterpret_cast<const f32x8*>(p); }
  __device__ static __forceinline__ bf16x8 tobf(T x) {
    u32x4 w = {cvtpk(x[0], x[1]), cvtpk(x[2], x[3]), cvtpk(x[4], x[5]), cvtpk(x[6], x[7])}; return *reinterpret_cast<bf16x8*>(&w); } };

template <int DK> __device__ __forceinline__ void partialSM(f32x16& p0, f32x16& p1, float& m_reg, float& mn, float& alpha) {
  constexpr float SCALE = (DK == 192) ? 0.07216878364870322f : 0.08838834764831845f;
  constexpr float C = SCALE * 1.4426950408889634f;
  float pmax = p0[0]; for (int r = 1; r < 16; ++r) pmax = fmaxf(pmax, p0[r]); for (int r = 0; r < 16; ++r) pmax = fmaxf(pmax, p1[r]);
  { auto rr = __builtin_amdgcn_permlane32_swap(__float_as_uint(pmax), __float_as_uint(pmax), false, false);
    pmax = fmaxf(__uint_as_float(rr[0]), __uint_as_float(rr[1])); }
  if (__builtin_expect(__all(pmax - m_reg <= THR / SCALE), 1)) { mn = m_reg; alpha = 1.f; }
  else { mn = fmaxf(m_reg, pmax); alpha = __builtin_amdgcn_exp2f((m_reg - mn) * C); m_reg = mn; }
  float mnC = -mn * C;
  for (int r = 0; r < 16; ++r) p0[r] = fmaf(p0[r], C, mnC); for (int r = 0; r < 16; ++r) p1[r] = fmaf(p1[r], C, mnC);
  for (int r = 0; r < 16; ++r) p0[r] = __builtin_amdgcn_exp2f(p0[r]);
}
__device__ __forceinline__ void finishSM(f32x16& p0, f32x16& p1, float alpha, float& l_reg, bf16x8& pa0, bf16x8& pa1, bf16x8& pa2, bf16x8& pa3) {
  for (int r = 0; r < 16; ++r) p1[r] = __builtin_amdgcn_exp2f(p1[r]);
  float ps = 0; for (int r = 0; r < 16; ++r) ps += p0[r]; for (int r = 0; r < 16; ++r) ps += p1[r];
  { auto rr = __builtin_amdgcn_permlane32_swap(__float_as_uint(ps), __float_as_uint(ps), false, false);
    ps = __uint_as_float(rr[0]) + __uint_as_float(rr[1]); }
  l_reg = l_reg * alpha + ps;
#define PK4(P, BASE, OUT) do { unsigned a0 = cvtpk(P[BASE + 0], P[BASE + 1]), a1 = cvtpk(P[BASE + 2], P[BASE + 3]);   \
    unsigned b0 = cvtpk(P[BASE + 4], P[BASE + 5]), b1 = cvtpk(P[BASE + 6], P[BASE + 7]);                              \
    auto r0 = __builtin_amdgcn_permlane32_swap(a0, b0, false, false); auto r1 = __builtin_amdgcn_permlane32_swap(a1, b1, false, false); \
    u32x4 w = {r0[0], r1[0], r0[1], r1[1]}; OUT = *reinterpret_cast<bf16x8*>(&w); } while (0)
  PK4(p0, 0, pa0); PK4(p0, 8, pa1); PK4(p1, 0, pa2); PK4(p1, 8, pa3);
#undef PK4
}
__device__ __forceinline__ void qkt(f32x16& p0, f32x16& p1, const bf16* Ks, const bf16x8* qr, int r32, int hi) {
  p0 = f32x16{}; p1 = f32x16{};
  for (int d0 = 0; d0 < 8; ++d0) { int cb = (d0 * 16 + hi * 8) * 2;
    bf16x8 b0 = *reinterpret_cast<const bf16x8*>((const char*)Ks + KSWZ(r32, cb));
    bf16x8 b1 = *reinterpret_cast<const bf16x8*>((const char*)Ks + KSWZ(32 + r32, cb));
    p0 = __builtin_amdgcn_mfma_f32_32x32x16_bf16(b0, qr[d0], p0, 0, 0, 0);
    p1 = __builtin_amdgcn_mfma_f32_32x32x16_bf16(b1, qr[d0], p1, 0, 0, 0); }
}
__device__ __forceinline__ int v_st(int k, int c) { const int kk = (k & ~0xC) | ((k & 4) << 1) | ((k & 8) >> 1); return ((kk >> 3) * 4 + (c >> 5)) * 512 + ((kk & 7) * 32 + (c & 31)) * 2; }
__device__ __forceinline__ int v_rd_base(int lane) { return ((lane & 3) << 3) | (((lane >> 2) & 3) << 6) | (((lane >> 4) & 1) << 5) | (((lane >> 5) & 1) << 8); }
constexpr int v_rd_off(int d0, int ks, int half) { return d0 * 512 + ks * 4096 + half * 2048; }
template <int OFF> __device__ __forceinline__ s16x4 tr_read(int vb) {
  s16x4 r; asm volatile("ds_read_b64_tr_b16 %0, %1 offset:%2" : "=&v"(r) : "v"(vb), "i"(OFF) : "memory"); return r;
}
template <int D0> __device__ __forceinline__ void pv_one(f32x16& od, int vb, bf16x8 pa0, bf16x8 pa1, bf16x8 pa2, bf16x8 pa3) {
  const s16x4 l0 = tr_read<v_rd_off(D0, 0, 0)>(vb), h0 = tr_read<v_rd_off(D0, 0, 1)>(vb), l1 = tr_read<v_rd_off(D0, 1, 0)>(vb), h1 = tr_read<v_rd_off(D0, 1, 1)>(vb);
  const s16x4 l2 = tr_read<v_rd_off(D0, 2, 0)>(vb), h2 = tr_read<v_rd_off(D0, 2, 1)>(vb), l3 = tr_read<v_rd_off(D0, 3, 0)>(vb), h3 = tr_read<v_rd_off(D0, 3, 1)>(vb);
  asm volatile("s_waitcnt lgkmcnt(0)" ::: "memory"); SBAR();
#define PK(L, H) (bf16x8){L[0], L[1], L[2], L[3], H[0], H[1], H[2], H[3]}
  od = __builtin_amdgcn_mfma_f32_32x32x16_bf16(pa0, PK(l0, h0), od, 0, 0, 0);
  od = __builtin_amdgcn_mfma_f32_32x32x16_bf16(pa1, PK(l1, h1), od, 0, 0, 0);
  od = __builtin_amdgcn_mfma_f32_32x32x16_bf16(pa2, PK(l2, h2), od, 0, 0, 0);
  od = __builtin_amdgcn_mfma_f32_32x32x16_bf16(pa3, PK(l3, h3), od, 0, 0, 0);
#undef PK
}
__device__ __forceinline__ void pv_d0(f32x16* o, int vb, bf16x8 pa0, bf16x8 pa1, bf16x8 pa2, bf16x8 pa3) {
  pv_one<0>(o[0], vb, pa0, pa1, pa2, pa3); pv_one<1>(o[1], vb, pa0, pa1, pa2, pa3); pv_one<2>(o[2], vb, pa0, pa1, pa2, pa3); pv_one<3>(o[3], vb, pa0, pa1, pa2, pa3);
}

template <typename TQ, int LDQ, int LDK, int LDV, int LDO>
__device__ __forceinline__ void attn_dense_body(const TQ* __restrict__ Qb, const bf16* __restrict__ Kh, const bf16* __restrict__ Vh,
                                                float* __restrict__ Ob, int seq, char* lds) {
  using St = Stage<bf16>; using SQ = Stage<TQ>;
  int tid_ = threadIdx.x; asm volatile("" : "+v"(tid_)); const int tid = tid_, wid = tid >> 6, lane = tid & 63, r32 = lane & 31, hi = lane >> 5;
  bf16* V_lds = (bf16*)lds; bf16* K_lds = (bf16*)(lds + 2 * SHM_V);
  float* ws = (float*)(lds + 2 * SHM_V + 2 * SHM_K) + wid * 64; float* li_l = ws; float* al_l = ws + 32;
  float m_reg = -1e30f, l_reg = 0; f32x16 o[4] = {}; bf16x8 qr[8];
  const TQ* Qw = Qb + (long)(wid * QBLK + r32) * LDQ + hi * 8;
#pragma unroll
  for (int d0 = 0; d0 < 8; ++d0) qr[d0] = SQ::tobf(SQ::ld8(Qw + d0 * 16));
  const int sr = tid >> 4, sc = (tid & 15) * 8, vst0 = v_st(sr, sc), vst1 = v_st(32 + sr, sc);
  const int vb0 = (int)(uintptr_t)V_lds + v_rd_base(lane);
  struct { typename St::T vs0, vs1, ks0, ks1; } sr_[SDEPTH];
#define SLOAD(i, k0) do { sr_[i].vs0 = St::ld8(&Vh[(long)((k0) + sr) * LDV + sc]); sr_[i].vs1 = St::ld8(&Vh[(long)((k0) + 32 + sr) * LDV + sc]); \
    sr_[i].ks0 = St::ld8(&Kh[(long)((k0) + sr) * LDK + sc]); sr_[i].ks1 = St::ld8(&Kh[(long)((k0) + 32 + sr) * LDK + sc]); } while (0)
#define SWRITE(b, i) do { *(bf16x8*)((char*)V_lds + (b) * SHM_V + vst0) = St::tobf(sr_[i].vs0);          \
    *(bf16x8*)((char*)V_lds + (b) * SHM_V + vst1) = St::tobf(sr_[i].vs1); int kc = sc * 2;               \
    *(bf16x8*)((char*)K_lds + (b) * SHM_K + KSWZ(sr, kc)) = St::tobf(sr_[i].ks0);                       \
    *(bf16x8*)((char*)K_lds + (b) * SHM_K + KSWZ(32 + sr, kc)) = St::tobf(sr_[i].ks1); } while (0)
#define SWAIT() do { if constexpr (SDEPTH == 2) asm volatile("s_waitcnt vmcnt(4)" ::: "memory"); else asm volatile("s_waitcnt vmcnt(0)" ::: "memory"); } while (0)
#define RESC(a) do { if (__any((a) < 1.f)) { if (hi == 0) al_l[r32] = (a); asm volatile("s_waitcnt lgkmcnt(0)" ::: "memory"); \
    for (int d = 0; d < 4; ++d) for (int r = 0; r < 16; ++r) o[d][r] *= al_l[crow(r, hi)]; } } while (0)
  f32x16 pA0, pA1, pB0, pB1; float mnA, mnB, alA, alB; bf16x8 pa0, pa1, pa2, pa3; const int NT = seq / KVBLK;
  constexpr int SE = 0, SO = SDEPTH - 1;
  SLOAD(SE, 0); asm volatile("s_waitcnt vmcnt(0)" ::: "memory"); SWRITE(0, SE); __syncthreads();
  qkt(pA0, pA1, K_lds, qr, r32, hi); partialSM<128>(pA0, pA1, m_reg, mnA, alA);
  SLOAD(SO, KVBLK); if constexpr (SDEPTH == 2) { if (2 < NT) SLOAD(SE, 2 * KVBLK); }
  SWAIT(); SWRITE(1, SO); __syncthreads();
  for (int j = 1; j + 1 < NT; j += 2) {
    SBAR(); qkt(pB0, pB1, (bf16*)((char*)K_lds + SHM_K), qr, r32, hi);
    finishSM(pA0, pA1, alA, l_reg, pa0, pa1, pa2, pa3); SBAR();
    SLOAD(SO, (j + SDEPTH) * KVBLK); SBAR();
    pv_d0(o, vb0, pa0, pa1, pa2, pa3); partialSM<128>(pB0, pB1, m_reg, mnB, alB);
    __syncthreads(); SWAIT(); SWRITE(0, SE);
    RESC(alB); __syncthreads();
    SBAR(); qkt(pA0, pA1, K_lds, qr, r32, hi);
    finishSM(pB0, pB1, alB, l_reg, pa0, pa1, pa2, pa3); SBAR();
    if (SDEPTH == 1 || j + 3 < NT) SLOAD(SE, (j + 1 + SDEPTH) * KVBLK); SBAR();
    pv_d0(o, vb0 + (int)SHM_V, pa0, pa1, pa2, pa3); partialSM<128>(pA0, pA1, m_reg, mnA, alA);
    __syncthreads(); SWAIT(); SWRITE(1, SO);
    RESC(alA); __syncthreads();
  }
  SBAR(); qkt(pB0, pB1, (bf16*)((char*)K_lds + SHM_K), qr, r32, hi);
  finishSM(pA0, pA1, alA, l_reg, pa0, pa1, pa2, pa3); SBAR();
  pv_d0(o, vb0, pa0, pa1, pa2, pa3); partialSM<128>(pB0, pB1, m_reg, mnB, alB);
  __syncthreads(); RESC(alB);
  finishSM(pB0, pB1, alB, l_reg, pa0, pa1, pa2, pa3); SBAR();
  pv_d0(o, vb0 + (int)SHM_V, pa0, pa1, pa2, pa3);
  if (hi == 0) li_l[r32] = l_reg; asm volatile("s_waitcnt lgkmcnt(0)" ::: "memory");
  float rli[16];
#pragma unroll
  for (int r = 0; r < 16; ++r) rli[r] = __builtin_amdgcn_rcpf(li_l[crow(r, hi)]);
  float* Ow = Ob + (long)(wid * QBLK) * LDO;
#pragma unroll
  for (int r = 0; r < 16; ++r) { int orow = crow(r, hi);
    for (int d0 = 0; d0 < 4; ++d0) Ow[(long)orow * LDO + d0 * 32 + r32] = o[d0][r] * rli[r]; }
#undef SLOAD
#undef SWRITE
#undef SWAIT
#undef RESC
}


#define KSWZ192(row, colB) ((row) * 384 + ((colB) ^ (((row) & 7) << 4)))
__device__ __forceinline__ void qkt192(f32x16& p0, f32x16& p1, const char* Ks, const bf16x8* qr, int r32, int hi) {
  p0 = f32x16{}; p1 = f32x16{};
#pragma unroll
  for (int d0 = 0; d0 < 12; ++d0) { const int cb = (d0 * 16 + hi * 8) * 2;
    bf16x8 b0 = *reinterpret_cast<const bf16x8*>(Ks + KSWZ192(r32, cb));
    bf16x8 b1 = *reinterpret_cast<const bf16x8*>(Ks + KSWZ192(32 + r32, cb));
    p0 = __builtin_amdgcn_mfma_f32_32x32x16_bf16(b0, qr[d0], p0, 0, 0, 0);
    p1 = __builtin_amdgcn_mfma_f32_32x32x16_bf16(b1, qr[d0], p1, 0, 0, 0); }
}
template <int LDQ, int LDK, int LDV, int LDO>
__device__ __forceinline__ void attn_body192(const unsigned short* __restrict__ Qb, const unsigned short* __restrict__ Kh, const unsigned short* __restrict__ Vh,
                                             unsigned short* __restrict__ Ob, int seq, char* lds) {
  constexpr size_t SV = 16384, SK = 24576;
  int tid_ = threadIdx.x; asm volatile("" : "+v"(tid_)); const int tid = tid_, wid = tid >> 6, lane = tid & 63, r32 = lane & 31, hi = lane >> 5;
  char* V_lds = lds; char* K_lds = lds + 2 * SV;
  float* ws = (float*)(lds + 2 * SV + 2 * SK) + wid * 64; float* li_l = ws; float* al_l = ws + 32;
  float m_reg = -1e30f, l_reg = 0; f32x16 o[4] = {}; bf16x8 qr[12];
  const unsigned short* Qw = Qb + (long)(wid * QBLK + r32) * LDQ + hi * 8;
#pragma unroll
  for (int d0 = 0; d0 < 12; ++d0) qr[d0] = *reinterpret_cast<const bf16x8*>(Qw + d0 * 16);
  const int sr = tid >> 4, sc = (tid & 15) * 8, vst0 = v_st(sr, sc), vst1 = v_st(32 + sr, sc);
  const unsigned voff0 = (unsigned)(sr * LDV + sc), voff1 = (unsigned)((32 + sr) * LDV + sc);
  unsigned koff[3]; int kst[3];
#pragma unroll
  for (int i = 0; i < 3; ++i) { const int q = tid + 512 * i; const int krow = q / 24, kcol = (q % 24) * 8; koff[i] = (unsigned)(krow * LDK + kcol); kst[i] = KSWZ192(krow, kcol * 2); }
  const int vb0 = (int)(uintptr_t)V_lds + v_rd_base(lane);
  bf16x8 vs0, vs1, ks[3];
#define LD192(k0) do { const unsigned short* vp_ = Vh + (size_t)(k0) * LDV; const unsigned short* kp_ = Kh + (size_t)(k0) * LDK; vs0 = *(const bf16x8*)(vp_ + voff0); vs1 = *(const bf16x8*)(vp_ + voff1); \
    _Pragma("unroll") for (int i_ = 0; i_ < 3; ++i_) ks[i_] = *(const bf16x8*)(kp_ + koff[i_]); } while (0)
#define WR192(b) do { *(bf16x8*)(V_lds + (b) * SV + vst0) = vs0; *(bf16x8*)(V_lds + (b) * SV + vst1) = vs1; \
    _Pragma("unroll") for (int i_ = 0; i_ < 3; ++i_) *(bf16x8*)(K_lds + (b) * SK + kst[i_]) = ks[i_]; } while (0)
  const int NT = seq / KVBLK;
  LD192(0); WR192(0); __syncthreads();
#pragma unroll 1
  for (int j = 0; j < NT; ++j) {
    const int b = j & 1;
    if (j + 1 < NT) LD192((j + 1) * KVBLK);
    f32x16 p0, p1; float mn, al; bf16x8 pa0, pa1, pa2, pa3;
    qkt192(p0, p1, K_lds + b * SK, qr, r32, hi);
    partialSM<192>(p0, p1, m_reg, mn, al);
    if (__any(al < 1.f)) { if (hi == 0) al_l[r32] = al; asm volatile("s_waitcnt lgkmcnt(0)" ::: "memory");
#pragma unroll
      for (int d = 0; d < 4; ++d)
#pragma unroll
        for (int r = 0; r < 16; ++r) o[d][r] *= al_l[crow(r, hi)]; }
    finishSM(p0, p1, al, l_reg, pa0, pa1, pa2, pa3); SBAR();
    pv_d0(o, vb0 + b * (int)SV, pa0, pa1, pa2, pa3);
    if (j + 1 < NT) WR192(b ^ 1);
    __syncthreads();
  }
  if (hi == 0) li_l[r32] = l_reg; asm volatile("s_waitcnt lgkmcnt(0)" ::: "memory");
  float rli[16];
#pragma unroll
  for (int r = 0; r < 16; ++r) rli[r] = __builtin_amdgcn_rcpf(li_l[crow(r, hi)]);
  unsigned short* Ow = Ob + (long)(wid * QBLK) * LDO;
#pragma unroll
  for (int r = 0; r < 16; ++r) { const int orow = crow(r, hi);
#pragma unroll
    for (int d0 = 0; d0 < 4; ++d0) { const float v = o[d0][r] * rli[r]; Ow[(long)orow * LDO + d0 * 32 + r32] = (unsigned short)(cvtpk(v, v) & 0xffffu); } }
  __syncthreads();
#undef LD192
#undef WR192
}
constexpr int NQR = 6;
__device__ __forceinline__ void qkt192p(f32x16& p0, f32x16& p1, const char* Ks, const bf16x8* qr, const char* Qr_lds, int r32, int hi) {
  p0 = f32x16{}; p1 = f32x16{};
#pragma unroll
  for (int d0 = 0; d0 < NQR; ++d0) { const int cb = (d0 * 16 + hi * 8) * 2;
    bf16x8 b0 = *reinterpret_cast<const bf16x8*>(Ks + KSWZ192(r32, cb));
    bf16x8 b1 = *reinterpret_cast<const bf16x8*>(Ks + KSWZ192(32 + r32, cb));
    p0 = __builtin_amdgcn_mfma_f32_32x32x16_bf16(b0, qr[d0], p0, 0, 0, 0);
    p1 = __builtin_amdgcn_mfma_f32_32x32x16_bf16(b1, qr[d0], p1, 0, 0, 0); }
#pragma unroll
  for (int d0 = NQR; d0 < 12; ++d0) { const int cb = (d0 * 16 + hi * 8) * 2;
    bf16x8 q = *reinterpret_cast<const bf16x8*>(Qr_lds + (d0 - NQR) * 1024);
    bf16x8 b0 = *reinterpret_cast<const bf16x8*>(Ks + KSWZ192(r32, cb));
    bf16x8 b1 = *reinterpret_cast<const bf16x8*>(Ks + KSWZ192(32 + r32, cb));
    p0 = __builtin_amdgcn_mfma_f32_32x32x16_bf16(b0, q, p0, 0, 0, 0);
    p1 = __builtin_amdgcn_mfma_f32_32x32x16_bf16(b1, q, p1, 0, 0, 0); }
}
template <int LDQ, int LDK, int LDV, int LDO>
__device__ __forceinline__ void attn_body192p(const unsigned short* __restrict__ Qb, const unsigned short* __restrict__ Kh, const unsigned short* __restrict__ Vh,
                                              unsigned short* __restrict__ Ob, int seq, char* lds) {
  constexpr size_t SV = 16384, SK = 24576;
  int tid_ = threadIdx.x; asm volatile("" : "+v"(tid_)); const int tid = tid_, wid = tid >> 6, lane = tid & 63, r32 = lane & 31, hi = lane >> 5;
  char* V_lds = lds; char* K_lds = lds + 2 * SV; const char* Qr_lds = lds + 2 * SV + 2 * SK + wid * ((12 - NQR) * 1024) + lane * 16;
  float* ws = (float*)(lds + 2 * SV + 2 * SK + 8 * (12 - NQR) * 1024) + wid * 64; float* li_l = ws; float* al_l = ws + 32;
  float m_reg = -1e30f, l_reg = 0; f32x16 o[4] = {}; bf16x8 qr[NQR];
  const unsigned short* Qw = Qb + (long)(wid * QBLK + r32) * LDQ + hi * 8;
#pragma unroll
  for (int d0 = 0; d0 < NQR; ++d0) qr[d0] = *reinterpret_cast<const bf16x8*>(Qw + d0 * 16);
#pragma unroll
  for (int d0 = NQR; d0 < 12; ++d0) *(bf16x8*)(const_cast<char*>(Qr_lds) + (d0 - NQR) * 1024) = *reinterpret_cast<const bf16x8*>(Qw + d0 * 16);
  const int sr = tid >> 4, sc = (tid & 15) * 8, vst0 = v_st(sr, sc), vst1 = v_st(32 + sr, sc);
  const unsigned voff0 = (unsigned)(sr * LDV + sc), voff1 = (unsigned)((32 + sr) * LDV + sc);
  const int kr0 = tid / 24, kc0 = (tid % 24) * 8, kr1 = (tid + 512) / 24, kc1 = ((tid + 512) % 24) * 8, kr2 = (tid + 1024) / 24, kc2 = ((tid + 1024) % 24) * 8;
  const unsigned koff0 = (unsigned)(kr0 * LDK + kc0), koff1 = (unsigned)(kr1 * LDK + kc1), koff2 = (unsigned)(kr2 * LDK + kc2);
  const int kst0 = KSWZ192(kr0, kc0 * 2), kst1 = KSWZ192(kr1, kc1 * 2), kst2 = KSWZ192(kr2, kc2 * 2);
  const int vb0 = (int)(uintptr_t)V_lds + v_rd_base(lane);
  struct { bf16x8 vs0, vs1, ks0, ks1, ks2; } sr_[1];
#define SLOADP(i, k0) do { const unsigned short* vp_ = Vh + (size_t)(k0) * LDV; const unsigned short* kp_ = Kh + (size_t)(k0) * LDK; \
    sr_[i].vs0 = *(const bf16x8*)(vp_ + voff0); sr_[i].vs1 = *(const bf16x8*)(vp_ + voff1); \
    sr_[i].ks0 = *(const bf16x8*)(kp_ + koff0); sr_[i].ks1 = *(const bf16x8*)(kp_ + koff1); sr_[i].ks2 = *(const bf16x8*)(kp_ + koff2); } while (0)
#define SWRITEP(b, i) do { *(bf16x8*)(V_lds + (b) * SV + vst0) = sr_[i].vs0; *(bf16x8*)(V_lds + (b) * SV + vst1) = sr_[i].vs1; \
    *(bf16x8*)(K_lds + (b) * SK + kst0) = sr_[i].ks0; *(bf16x8*)(K_lds + (b) * SK + kst1) = sr_[i].ks1; *(bf16x8*)(K_lds + (b) * SK + kst2) = sr_[i].ks2; } while (0)
#define SWAITP() asm volatile("s_waitcnt vmcnt(0)" ::: "memory")
#define RESCP(a) do { if (__any((a) < 1.f)) { if (hi == 0) al_l[r32] = (a); asm volatile("s_waitcnt lgkmcnt(0)" ::: "memory"); \
    _Pragma("unroll") for (int d = 0; d < 4; ++d) _Pragma("unroll") for (int r = 0; r < 16; ++r) o[d][r] *= al_l[crow(r, hi)]; } } while (0)
  f32x16 pA0, pA1, pB0, pB1; float mnA, mnB, alA, alB; bf16x8 pa0, pa1, pa2, pa3; const int NT = seq / KVBLK;
  constexpr int SE = 0, SO = 0;
  SLOADP(SE, 0); asm volatile("s_waitcnt vmcnt(0)" ::: "memory"); SWRITEP(0, SE); __syncthreads();
  qkt192p(pA0, pA1, K_lds, qr, Qr_lds, r32, hi); partialSM<192>(pA0, pA1, m_reg, mnA, alA);
  SLOADP(SO, KVBLK);
  SWAITP(); SWRITEP(1, SO); __syncthreads();
  for (int j = 1; j + 1 < NT; j += 2) {
    SBAR(); qkt192p(pB0, pB1, K_lds + SK, qr, Qr_lds, r32, hi);
    finishSM(pA0, pA1, alA, l_reg, pa0, pa1, pa2, pa3); SBAR();
    SLOADP(SO, (j + 1) * KVBLK); SBAR();
    pv_d0(o, vb0, pa0, pa1, pa2, pa3); partialSM<192>(pB0, pB1, m_reg, mnB, alB);
    __syncthreads(); SWAITP(); SWRITEP(0, SE);
    RESCP(alB); __syncthreads();
    SBAR(); qkt192p(pA0, pA1, K_lds, qr, Qr_lds, r32, hi);
    finishSM(pB0, pB1, alB, l_reg, pa0, pa1, pa2, pa3); SBAR();
    SLOADP(SE, (j + 2) * KVBLK); SBAR();
    pv_d0(o, vb0 + (int)SV, pa0, pa1, pa2, pa3); partialSM<192>(pA0, pA1, m_reg, mnA, alA);
    __syncthreads(); SWAITP(); SWRITEP(1, SO);
    RESCP(alA); __syncthreads();
  }
  SBAR(); qkt192p(pB0, pB1, K_lds + SK, qr, Qr_lds, r32, hi);
  finishSM(pA0, pA1, alA, l_reg, pa0, pa1, pa2, pa3); SBAR();
  pv_d0(o, vb0, pa0, pa1, pa2, pa3); partialSM<192>(pB0, pB1, m_reg, mnB, alB);
  __syncthreads(); RESCP(alB);
  finishSM(pB0, pB1, alB, l_reg, pa0, pa1, pa2, pa3); SBAR();
  pv_d0(o, vb0 + (int)SV, pa0, pa1, pa2, pa3);
  if (hi == 0) li_l[r32] = l_reg; asm volatile("s_waitcnt lgkmcnt(0)" ::: "memory");
  float rli[16];
#pragma unroll
  for (int r = 0; r < 16; ++r) rli[r] = __builtin_amdgcn_rcpf(li_l[crow(r, hi)]);
  unsigned short* Ow = Ob + (long)(wid * QBLK) * LDO;
#pragma unroll
  for (int r = 0; r < 16; ++r) { const int orow = crow(r, hi);
#pragma unroll
    for (int d0 = 0; d0 < 4; ++d0) { const float v = o[d0][r] * rli[r]; Ow[(long)orow * LDO + d0 * 32 + r32] = (unsigned short)(cvtpk(v, v) & 0xffffu); } }
  __syncthreads();
#undef SLOADP
#undef SWRITEP
#undef SWAITP
#undef RESCP
}
constexpr int NQR2 = 2;
__device__ __forceinline__ int v_st256(int k, int c) { const int kk = (k & ~0xC) | ((k & 4) << 1) | ((k & 8) >> 1); return ((kk >> 3) * 8 + (c >> 5)) * 512 + ((kk & 7) * 32 + (c & 31)) * 2; }
constexpr int v_rd_off256(int d0, int ks, int half) { return d0 * 512 + ks * 8192 + half * 4096; }
template <int D0> __device__ __forceinline__ void pv_one256(f32x16& od, int vb, bf16x8 pa0, bf16x8 pa1, bf16x8 pa2, bf16x8 pa3) {
  const s16x4 l0 = tr_read<v_rd_off256(D0, 0, 0)>(vb), h0 = tr_read<v_rd_off256(D0, 0, 1)>(vb), l1 = tr_read<v_rd_off256(D0, 1, 0)>(vb), h1 = tr_read<v_rd_off256(D0, 1, 1)>(vb);
  const s16x4 l2 = tr_read<v_rd_off256(D0, 2, 0)>(vb), h2 = tr_read<v_rd_off256(D0, 2, 1)>(vb), l3 = tr_read<v_rd_off256(D0, 3, 0)>(vb), h3 = tr_read<v_rd_off256(D0, 3, 1)>(vb);
  asm volatile("s_waitcnt lgkmcnt(0)" ::: "memory"); SBAR();
#define PK(L, H) (bf16x8){L[0], L[1], L[2], L[3], H[0], H[1], H[2], H[3]}
  od = __builtin_amdgcn_mfma_f32_32x32x16_bf16(pa0, PK(l0, h0), od, 0, 0, 0);
  od = __builtin_amdgcn_mfma_f32_32x32x16_bf16(pa1, PK(l1, h1), od, 0, 0, 0);
  od = __builtin_amdgcn_mfma_f32_32x32x16_bf16(pa2, PK(l2, h2), od, 0, 0, 0);
  od = __builtin_amdgcn_mfma_f32_32x32x16_bf16(pa3, PK(l3, h3), od, 0, 0, 0);
#undef PK
}
__device__ __forceinline__ void qkt128q(f32x16& p0, f32x16& p1, const char* Ks, const bf16x8* qr, const char* Qr_lds, int r32, int hi) {
  p0 = f32x16{}; p1 = f32x16{};
#pragma unroll
  for (int d0 = 0; d0 < 8; ++d0) { const int cb = (d0 * 16 + hi * 8) * 2;
    bf16x8 q; if (d0 < NQR2) q = qr[d0 < NQR2 ? d0 : 0]; else q = *reinterpret_cast<const bf16x8*>(Qr_lds + (d0 - NQR2) * 1024);
    bf16x8 b0 = *reinterpret_cast<const bf16x8*>(Ks + KSWZ(r32, cb));
    bf16x8 b1 = *reinterpret_cast<const bf16x8*>(Ks + KSWZ(32 + r32, cb));
    p0 = __builtin_amdgcn_mfma_f32_32x32x16_bf16(b0, q, p0, 0, 0, 0);
    p1 = __builtin_amdgcn_mfma_f32_32x32x16_bf16(b1, q, p1, 0, 0, 0); }
}
template <int LDQ, int LDK, int LDV, int LDO>
__device__ __forceinline__ void attn_body_dv256(const unsigned short* __restrict__ Qb, const unsigned short* __restrict__ Kh, const unsigned short* __restrict__ Vh,
                                                unsigned short* __restrict__ Of, int seq, char* lds) {
  constexpr size_t SV = 32768, SK = 16384;
  int tid_ = threadIdx.x; asm volatile("" : "+v"(tid_)); const int tid = tid_, wid = tid >> 6, lane = tid & 63, r32 = lane & 31, hi = lane >> 5;
  char* V_lds = lds; char* K_lds = lds + 2 * SV; const char* Qr_lds = lds + 2 * SV + 2 * SK + wid * ((8 - NQR2) * 1024) + lane * 16;
  float* ws = (float*)(lds + 2 * SV + 2 * SK + 8 * (8 - NQR2) * 1024) + wid * 64; float* li_l = ws; float* al_l = ws + 32;
  float m_reg = -1e30f, l_reg = 0; f32x16 o[8] = {}; bf16x8 qr[NQR2];
  const unsigned short* Qw = Qb + (long)(wid * QBLK + r32) * LDQ + hi * 8;
#pragma unroll
  for (int d0 = 0; d0 < NQR2; ++d0) qr[d0] = *reinterpret_cast<const bf16x8*>(Qw + d0 * 16);
#pragma unroll
  for (int d0 = NQR2; d0 < 8; ++d0) *(bf16x8*)(const_cast<char*>(Qr_lds) + (d0 - NQR2) * 1024) = *reinterpret_cast<const bf16x8*>(Qw + d0 * 16);
  const int sr = tid >> 4, sc = (tid & 15) * 8; const int kst0 = KSWZ(sr, sc * 2), kst1 = KSWZ(32 + sr, sc * 2);
  const unsigned koff0 = (unsigned)(sr * LDK + sc), koff1 = (unsigned)((32 + sr) * LDK + sc);
  const int vr = tid >> 5, vc = (tid & 31) * 8;
  const unsigned voff = (unsigned)(vr * LDV + vc);
  int vst[4];
#pragma unroll
  for (int i = 0; i < 4; ++i) vst[i] = v_st256(vr + 16 * i, vc);
  const int vb0 = (int)(uintptr_t)V_lds + v_rd_base(lane);
  bf16x8 vs[4], ks0, ks1;
#define LD256(k0) do { const unsigned short* vp_ = Vh + (size_t)(k0) * LDV; const unsigned short* kp_ = Kh + (size_t)(k0) * LDK; \
    _Pragma("unroll") for (int i_ = 0; i_ < 4; ++i_) vs[i_] = *(const bf16x8*)(vp_ + voff + (unsigned)(16 * i_ * LDV)); \
    ks0 = *(const bf16x8*)(kp_ + koff0); ks1 = *(const bf16x8*)(kp_ + koff1); } while (0)
#define WR256(b) do { _Pragma("unroll") for (int i_ = 0; i_ < 4; ++i_) *(bf16x8*)(V_lds + (b) * SV + vst[i_]) = vs[i_]; \
    *(bf16x8*)(K_lds + (b) * SK + kst0) = ks0; *(bf16x8*)(K_lds + (b) * SK + kst1) = ks1; } while (0)
  const int NT = seq / KVBLK;
  LD256(0); WR256(0); __syncthreads();
#pragma unroll 1
  for (int j = 0; j < NT; ++j) {
    const int b = j & 1;
    if (j + 1 < NT) LD256((j + 1) * KVBLK);
    f32x16 p0, p1; float mn, al; bf16x8 pa0, pa1, pa2, pa3;
    qkt128q(p0, p1, K_lds + b * SK, qr, Qr_lds, r32, hi);
    partialSM<128>(p0, p1, m_reg, mn, al);
    if (__any(al < 1.f)) { if (hi == 0) al_l[r32] = al; asm volatile("s_waitcnt lgkmcnt(0)" ::: "memory");
#pragma unroll
      for (int d = 0; d < 8; ++d)
#pragma unroll
        for (int r = 0; r < 16; ++r) o[d][r] *= al_l[crow(r, hi)]; }
    finishSM(p0, p1, al, l_reg, pa0, pa1, pa2, pa3); SBAR();
    const int vb = vb0 + b * (int)SV;
    pv_one256<0>(o[0], vb, pa0, pa1, pa2, pa3); pv_one256<1>(o[1], vb, pa0, pa1, pa2, pa3); pv_one256<2>(o[2], vb, pa0, pa1, pa2, pa3); pv_one256<3>(o[3], vb, pa0, pa1, pa2, pa3);
    pv_one256<4>(o[4], vb, pa0, pa1, pa2, pa3); pv_one256<5>(o[5], vb, pa0, pa1, pa2, pa3); pv_one256<6>(o[6], vb, pa0, pa1, pa2, pa3); pv_one256<7>(o[7], vb, pa0, pa1, pa2, pa3);
    if (j + 1 < NT) WR256(b ^ 1);
    __syncthreads();
  }
  if (hi == 0) li_l[r32] = l_reg; asm volatile("s_waitcnt lgkmcnt(0)" ::: "memory");
  float rli[16];
#pragma unroll
  for (int r = 0; r < 16; ++r) rli[r] = __builtin_amdgcn_rcpf(li_l[crow(r, hi)]);
  unsigned short* Ow = Of + (long)(wid * QBLK) * LDO;
#pragma unroll
  for (int r = 0; r < 16; ++r) { const int orow = crow(r, hi);
#pragma unroll
    for (int d0 = 0; d0 < 8; ++d0) { const float v = o[d0][r] * rli[r]; Ow[(long)orow * LDO + d0 * 32 + r32] = (unsigned short)(cvtpk(v, v) & 0xffffu); } }
  __syncthreads();
#undef LD256
#undef WR256
}
}

enum { MAP_ID = 0, MAP_MLA_IN = 1, MAP_UQ = 2, MAP_DQKV = 3, MAP_GATE = 4, MAP_UP = 5 };
__device__ __forceinline__ int dmap(int kind, int n) {
    switch (kind) {
        case MAP_MLA_IN: return (n < 1312) ? n : (1408 + (n - 1312));
        case MAP_UQ: { const int head = n / 192, d = n % 192; if (d < 128) return head * 128 + d; const int r = d - 128, bj = r >> 5, i = r & 31; return 2048 + (head >> 2) * 256 + bj * 128 + (head & 3) * 32 + i; }
        case MAP_DQKV: { if (n >= 4096) return n; const int base = n & ~255, r = n & 255, blk = r >> 7, d = r & 127, bj = d >> 6, i = d & 63; return base + bj * 128 + blk * 64 + i; }
        case MAP_GATE: return (n >> 7) * 256 + (n & 127);
        case MAP_UP: return (n >> 7) * 256 + 128 + (n & 127);
        default: return n;
    }
}
__device__ __forceinline__ void cvt_item(const float* W, int K, int N, const float* g, bf16_t* WT, int kind, LAS float* scr, int item, int lane) {
    const int nblk = N / 32, kb = item / nblk, nb = item % nblk, k0 = 64 * kb, n0 = 32 * nb;
#pragma unroll 8
    for (int i = 0; i < 32; ++i) { const int kk = 2 * i + (lane >> 5); scr[kk * 33 + (lane & 31)] = W[(size_t)(k0 + kk) * N + n0 + (lane & 31)]; }
    LDS_WAIT(); asm volatile("" ::: "memory");
    const int c = lane & 7; const int drow0 = dmap(kind, n0);
    float gv[8];
#pragma unroll
    for (int e = 0; e < 8; ++e) gv[e] = g ? g[k0 + 8 * c + e] : 1.f;
#pragma unroll
    for (int j = 0; j < 4; ++j) { const int n = (lane >> 3) + 8 * j; const LAS float* s = scr + (8 * c) * 33 + n;
        u32x4 o; o.x = cvt_pk_bf16(s[0 * 33] * gv[0], s[1 * 33] * gv[1]); o.y = cvt_pk_bf16(s[2 * 33] * gv[2], s[3 * 33] * gv[3]);
        o.z = cvt_pk_bf16(s[4 * 33] * gv[4], s[5 * 33] * gv[5]); o.w = cvt_pk_bf16(s[6 * 33] * gv[6], s[7 * 33] * gv[7]);
        *(u32x4*)(WT + (size_t)(drow0 + n) * K + k0 + 8 * c) = o; }
    LDS_WAIT(); asm volatile("" ::: "memory");
}

__device__ __forceinline__ void cvt_gate_tail(const float* Wg, const float* g, bf16_t* WT, LAS float* scr, int gw, int NGW, int lane) {
    constexpr int NIT = (2048 / 64) * (5632 / 32);
#pragma unroll 1
    for (int it = gw; it < NIT; it += NGW) cvt_item(Wg, 2048, 5632, g, WT, MAP_GATE, scr, it, lane);
}

constexpr int FN = 16384, FNLOG = 14;
#define FP(i) ((i) + (((i) >> 5) << 2))
__device__ __forceinline__ f32x2 cmul(f32x2 a, f32x2 b) { return (f32x2){a.x * b.x - a.y * b.y, a.x * b.y + a.y * b.x}; }
__device__ __forceinline__ f32x2 twiddle(int idx, int M, float sign) {
    const float rev = (float)idx / (float)M;
    return (f32x2){__builtin_amdgcn_cosf(rev), sign * __builtin_amdgcn_sinf(rev)};
}
__device__ __forceinline__ f32x2 rot16(f32x2 v, int jj, float sgn) {
    const float h = 0.70710678118654752f, c1 = 0.92387953251128674f, s1 = 0.38268343236508977f;
    float c, s;
    switch (jj & 7) {
        case 0: return v;
        case 1: c = c1; s = s1; break;
        case 2: c = h; s = h; break;
        case 3: c = s1; s = c1; break;
        case 4: return (f32x2){-sgn * v.y, sgn * v.x};
        case 5: c = -s1; s = c1; break;
        case 6: c = -h; s = h; break;
        default: c = -c1; s = s1; break;
    }
    s *= sgn;
    return (f32x2){v.x * c - v.y * s, v.x * s + v.y * c};
}
#define FADDR(j) ((ls >= 5) ? (a0 + (j) * ps) : (a0 + (j) * s + (((low + (j) * s) >> 5) << 2)))
template <int R> __device__ __forceinline__ void fft_dif_pass(LAS f32x2* L, int ls  , int tid) {
    const int s = 1 << ls; const int ps = (ls >= 5) ? FP(s) : s;
#pragma unroll 1
    for (int g = tid; g < (FN >> R); g += 512) {
        const int low = g & (s - 1); const int i0 = ((g - low) << R) | low; const int a0 = FP(i0);
        f32x2 e[1 << R];
#pragma unroll
        for (int j = 0; j < (1 << R); ++j) e[j] = L[FADDR(j)];
        f32x2 wq[4];
        if (R == 4) { wq[3] = twiddle(low, 16 * s, -1.f); wq[2] = cmul(wq[3], wq[3]); wq[1] = cmul(wq[2], wq[2]); wq[0] = cmul(wq[1], wq[1]); }
#pragma unroll
        for (int q = R - 1; q >= 0; --q) {
            const int sp = 1 << q;
#pragma unroll
            for (int j = 0; j < (1 << R); ++j) if ((j & sp) == 0) {
                const f32x2 a = e[j], b = e[j + sp];
                e[j] = a + b;
                f32x2 d = a - b; const int jj = j & (sp - 1);
                if (R == 4) d = cmul(d, wq[q]);
                e[j + sp] = rot16(d, jj * (8 >> q), -1.f);
            }
        }
#pragma unroll
        for (int j = 0; j < (1 << R); ++j) L[FADDR(j)] = e[j];
    }
}
template <int R> __device__ __forceinline__ void fft_dit_pass(LAS f32x2* L, int ls, int tid) {
    const int s = 1 << ls; const int ps = (ls >= 5) ? FP(s) : s;
#pragma unroll 1
    for (int g = tid; g < (FN >> R); g += 512) {
        const int low = g & (s - 1); const int i0 = ((g - low) << R) | low; const int a0 = FP(i0);
        f32x2 e[1 << R];
#pragma unroll
        for (int j = 0; j < (1 << R); ++j) e[j] = L[FADDR(j)];
        f32x2 wq[4];
        if (R == 4) { wq[3] = twiddle(low, 16 * s, 1.f); wq[2] = cmul(wq[3], wq[3]); wq[1] = cmul(wq[2], wq[2]); wq[0] = cmul(wq[1], wq[1]); }
#pragma unroll
        for (int q = 0; q < R; ++q) {
            const int sp = 1 << q;
#pragma unroll
            for (int j = 0; j < (1 << R); ++j) if ((j & sp) == 0) {
                const int jj = j & (sp - 1);
                f32x2 b = e[j + sp];
                if (R == 4) b = cmul(b, wq[q]);
                b = rot16(b, jj * (8 >> q), 1.f);
                const f32x2 a = e[j];
                e[j] = a + b; e[j + sp] = a - b;
            }
        }
#pragma unroll
        for (int j = 0; j < (1 << R); ++j) L[FADDR(j)] = e[j];
    }
}
__device__ __forceinline__ void fft_fwd(LAS f32x2* L, int tid) {
    __syncthreads();
    fft_dif_pass<4>(L, 10, tid); __syncthreads();
    fft_dif_pass<4>(L, 6, tid); __syncthreads();
    fft_dif_pass<4>(L, 2, tid); __syncthreads();
    fft_dif_pass<2>(L, 0, tid); __syncthreads();
}
__device__ __forceinline__ void fft_inv(LAS f32x2* L, int tid) {
    __syncthreads();
    fft_dit_pass<2>(L, 0, tid); __syncthreads();
    fft_dit_pass<4>(L, 2, tid); __syncthreads();
    fft_dit_pass<4>(L, 6, tid); __syncthreads();
    fft_dit_pass<4>(L, 10, tid); __syncthreads();
}
__device__ __forceinline__ int brev14(int p) { return (int)(__builtin_bitreverse32((unsigned)p) >> 18); }
__device__ __forceinline__ float block_sum(float v, LAS float* red, int tid) {
    v = wave_sum(v);
    __syncthreads();
    if ((tid & 63) == 0) red[tid >> 6] = v;
    __syncthreads();
    float t = 0.f;
#pragma unroll
    for (int i = 0; i < 8; ++i) t += red[i];
    return t;
}
__device__ __forceinline__ f32x2 unpk_bf2(unsigned w) { return (f32x2){__uint_as_float(w << 16), __uint_as_float(w & 0xffff0000u)}; }
__device__ __forceinline__ void spec_mul(LAS f32x2* L, const unsigned* Kp, int tid) {
#pragma unroll 2
    for (int p = tid; p < FN; p += 512) {
        const int k = brev14(p), k2 = (FN - k) & (FN - 1), p2 = brev14(k2);
        if (p > p2) continue;
        const f32x2 z1 = L[FP(p)], z2 = L[FP(p2)], g1 = unpk_bf2(Kp[p]), g2 = unpk_bf2(Kp[p2]);
        const f32x2 ka = (f32x2){0.5f * (g1.x + g2.x), 0.5f * (g1.y - g2.y)};
        const f32x2 kb = (f32x2){0.5f * (g1.y + g2.y), -0.5f * (g1.x - g2.x)};
        const f32x2 P = (ka + kb) * 0.5f, M = (ka - kb) * 0.5f;
        const f32x2 z2c = (f32x2){z2.x, -z2.y}, z1c = (f32x2){z1.x, -z1.y};
        const f32x2 y1 = cmul(z1, P) + cmul(z2c, M);
        const f32x2 Pc = (f32x2){P.x, -P.y}, Mc = (f32x2){M.x, -M.y};
        const f32x2 y2 = cmul(z2, Pc) + cmul(z1c, Mc);
        L[FP(p)] = y1; if (p2 != p) L[FP(p2)] = y2;
    }
}

#define XB_TMO      128
#define XB_XCNT(j)  (256  + 64 * (j))
#define XB_XSUB(j)  (1280 + 64 * (j))
#define XB_XGEN(j)  (2304 + 64 * (j))
#define XB_TOP      3328
#define XB_TOPGEN   3392
#define XCD_BAR_WORDS 3456
#define XB_SPIN_CAP (1u << 18)
__device__ __forceinline__ unsigned xb_ld(unsigned* p)              { return __hip_atomic_load(p, __ATOMIC_RELAXED, __HIP_MEMORY_SCOPE_AGENT); }
__device__ __forceinline__ unsigned xb_add(unsigned* p, unsigned v) { return __hip_atomic_fetch_add(p, v, __ATOMIC_RELAXED, __HIP_MEMORY_SCOPE_AGENT); }
__device__ __forceinline__ unsigned xb_xcc_id() { return (unsigned)__builtin_amdgcn_s_getreg((3 << 11) | 20) & 0xFu; }
#define XB_SPIN(cond, bar) do { unsigned _sp = 0; while (cond) { __builtin_amdgcn_s_sleep(1); \
    if ((++_sp & 255u) == 0u) { if (xb_ld(&(bar)[XB_TMO])) break; if (_sp > XB_SPIN_CAP) { atomicAdd(&(bar)[XB_TMO], 1u); break; } } } } while (0)
struct XcdBarrier { unsigned* bar; unsigned x; volatile LAS unsigned* st; };
__device__ __forceinline__ XcdBarrier xcd_barrier_post(unsigned* bar, volatile LAS unsigned* st) {
    XcdBarrier b; b.bar = bar; b.x = xb_xcc_id(); b.st = st;
    if (threadIdx.x == 0) (void)xb_add(&bar[XB_XCNT(b.x)], 1u);
    return b;
}
__device__ __forceinline__ void xcd_barrier_complete(unsigned* bar, unsigned x, unsigned& nloc, unsigned& nx) {
    const unsigned G = gridDim.x * gridDim.y * gridDim.z;
    unsigned sum, cnt, mine, sp = 0u;
    for (;;) {
        sum = 0u; cnt = 0u; mine = 0u;
#pragma unroll
        for (unsigned j = 0; j < 16; ++j) { const unsigned c = xb_ld(&bar[XB_XCNT(j)]); sum += c; cnt += (c > 0u) ? 1u : 0u; mine = (j == x) ? c : mine; }
        if (sum == G) break;
        __builtin_amdgcn_s_sleep(1);
        if ((++sp & 255u) == 0u) { if (xb_ld(&bar[XB_TMO])) break; if (sp > XB_SPIN_CAP) { atomicAdd(&bar[XB_TMO], 1u); break; } }
    }
    nloc = mine > 0u ? mine : 1u; nx = cnt > 0u ? cnt : 1u;
}
__device__ __forceinline__ void xcd_barrier(const XcdBarrier& b) {
    asm volatile("s_waitcnt vmcnt(0)" ::: "memory");
    __syncthreads();
    if (threadIdx.x == 0) {
        unsigned* bar = b.bar;
        __builtin_amdgcn_s_waitcnt(0);
        unsigned nloc = b.st[0], nx = b.st[1];
        if (nloc == 0u) { xcd_barrier_complete(bar, b.x, nloc, nx); b.st[0] = nloc; b.st[1] = nx; }
        const unsigned old = xb_add(&bar[XB_XSUB(b.x)], 1u);
        const unsigned gen = old / nloc;
        if (old + 1u == (gen + 1u) * nloc) {
            __builtin_amdgcn_fence(__ATOMIC_RELEASE, "agent");
            asm volatile("s_waitcnt vmcnt(0)" ::: "memory");
            const unsigned og = xb_add(&bar[XB_TOP], 1u);
            const unsigned tg = og / nx;
            if (og + 1u == (tg + 1u) * nx) xb_add(&bar[XB_TOPGEN], 1u);
            else XB_SPIN(xb_ld(&bar[XB_TOPGEN]) == tg, bar);
            __builtin_amdgcn_fence(__ATOMIC_ACQUIRE, "agent");
            xb_add(&bar[XB_XGEN(b.x)], 1u);
            asm volatile("s_waitcnt vmcnt(0)" ::: "memory");
        } else {
            XB_SPIN(xb_ld(&bar[XB_XGEN(b.x)]) == gen, bar);
            __builtin_amdgcn_fence(__ATOMIC_ACQUIRE, "agent");
            asm volatile("s_waitcnt vmcnt(0)" ::: "memory");
        }
    }
    __syncthreads();
}

#define T_NONE 0
#define T_P0 1
#define T_GEMM 2
#define T_AMLA 3
#define T_ADIFF 4
#define T_HY 5
#define T_TR 6
#define T_FINAL 7
constexpr int N_PHASES = 1 + 4 * 7 + 1;
__host__ __device__ __forceinline__ int layer_kind(int layer) { return layer == 1 ? 1 : (layer == 2 ? 2 : 0); }
__host__ __device__ __forceinline__ int phase_type(int ph, bool& sync_after) {
    sync_after = true;
    if (ph == 0) return T_P0;
    if (ph == N_PHASES - 1) { sync_after = false; return T_FINAL; }
    const int layer = (ph - 1) / 7, slot = (ph - 1) % 7, kind = layer_kind(layer);
    if (slot == 0 || slot >= 4) return T_GEMM;
    if (kind == 0) { if (slot == 1) { sync_after = false; return T_GEMM; } if (slot == 2) return T_GEMM; return T_AMLA; }
    if (kind == 1) { if (slot == 1) return T_HY; if (slot == 2) return T_TR; sync_after = false; return T_NONE; }
    if (slot == 1) return T_ADIFF; sync_after = false; return T_NONE;
}

struct Ctx {
    unsigned char* ws; bf16_t* WB; bf16_t* XB; bf16_t* AO; float* SSQ; float* MC; float* MS; float* DC; float* DS; float* H3; float* X;
};
__device__ __forceinline__ Ctx make_ctx(KA& a) {
    Ctx c; c.ws = a.ws; c.WB = (bf16_t*)(a.ws + WS_W); c.XB = (bf16_t*)(a.ws + WS_XB); c.AO = (bf16_t*)(a.ws + WS_AO); c.SSQ = (float*)(a.ws + WS_SSQ);
    c.MC = (float*)(a.ws + WS_MC); c.MS = (float*)(a.ws + WS_MS); c.DC = (float*)(a.ws + WS_DC); c.DS = (float*)(a.ws + WS_DS); c.H3 = (float*)(a.ws + WS_H3); c.X = a.out; return c;
}

__device__ __forceinline__ void phase_p0(KA& a, LAS unsigned char* lds) {
    const Ctx c = make_ctx(a);
    const int tid = ltid(), lane = tid & 63, wave = __builtin_amdgcn_readfirstlane(tid >> 6);
    const int G = gridDim.x, bx = lbid(), gw = bx * 8 + wave, NGW = G * 8, gt = bx * 512 + tid, NGT = G * 512;
    bf16_t* WB = c.WB; float* SSQ = c.SSQ;
    for (int i = gt; i < 13 * 8 * S - S; i += NGT) SSQ[S + i] = 0.f;
    LAS float* scr = (LAS float*)(lds + wave * 16384);
#define CJ(src, K_, N_, gptr, off_, kind_) do { const float* W = a.in[src]; const float* g = gptr; const int nitems = ((K_) / 64) * ((N_) / 32); \
        _Pragma("unroll 1") for (int it = gw; it < nitems; it += NGW) cvt_item(W, K_, N_, g, WB + (off_), kind_, scr, it, lane); } while (0)
    CJ(2, 2048, 1344, a.in[1], W0_IN, MAP_MLA_IN); CJ(4, 768, 3072, a.in[3], W0_UQ, MAP_UQ); CJ(6, 512, 4096, a.in[5], W0_UKV, MAP_ID); CJ(7, 2048, 2048, nullptr, W0_O, MAP_ID);
    CJ(9, 2048, 5632, a.in[8], W0_GU, MAP_GATE); CJ(10, 2048, 5632, a.in[8], W0_GU, MAP_UP); CJ(11, 5632, 2048, nullptr, W0_DN, MAP_ID);
    CJ(13, 2048, 6144, a.in[12], W1_IN, MAP_ID); CJ(25, 2048, 2048, nullptr, W1_O, MAP_ID);
    CJ(28, 2048, 5632, a.in[26], W1_GU, MAP_UP); CJ(29, 5632, 2048, nullptr, W1_DN, MAP_ID);
    CJ(31, 2048, 6144, a.in[30], W2_IN, MAP_DQKV); CJ(37, 2048, 2048, nullptr, W2_O, MAP_ID);
    CJ(40, 2048, 5632, a.in[38], W2_GU, MAP_UP); CJ(41, 5632, 2048, nullptr, W2_DN, MAP_ID);
    CJ(43, 2048, 1344, a.in[42], W3_IN, MAP_MLA_IN); CJ(45, 768, 3072, a.in[44], W3_UQ, MAP_UQ); CJ(47, 512, 4096, a.in[46], W3_UKV, MAP_ID); CJ(48, 2048, 2048, nullptr, W3_O, MAP_ID);
    CJ(51, 2048, 5632, a.in[49], W3_GU, MAP_UP); CJ(52, 5632, 2048, nullptr, W3_DN, MAP_ID);
#undef CJ
    for (int i = gt; i < 2 * 192 * 256; i += NGT) {
        const int mtx = i / (192 * 256), rem = i % (192 * 256), rr = rem / 256, ch = rem % 256;
        const int row = rr < 96 ? 1312 + rr : 1440 + (rr - 96);
        *(u32x4*)(WB + (mtx ? W3_IN : W0_IN) + (size_t)row * 2048 + ch * 8) = (u32x4){0u, 0u, 0u, 0u};
    }
#pragma unroll 1
    for (int r = gw; r < S; r += NGW) {
        const f32x4* xr = (const f32x4*)(a.in[0] + (size_t)r * D) + lane; f32x4* xo = (f32x4*)(c.X + (size_t)r * D) + lane;
        u32x2* xb = (u32x2*)(c.XB + (size_t)r * D) + lane; float s2 = 0.f;
#pragma unroll
        for (int j = 0; j < 8; ++j) { const f32x4 v = xr[64 * j]; s2 += (v.x * v.x + v.y * v.y) + (v.z * v.z + v.w * v.w);
            u32x2 w; w.x = cvt_pk_bf16(v.x, v.y); w.y = cvt_pk_bf16(v.z, v.w); xb[64 * j] = w; }
        s2 = wave_sum(s2); if (lane == 0) SSQ[r] = s2;
    }
#pragma unroll 1
    for (int i = gt; i < S * 32; i += NGT) { const int pos = i >> 5, f = i & 31;
        const float inv = (float)exp(-9.210340371976184 * ((double)(2 * f) / 64.0)); const float ang = (float)pos * inv;
        float s, cc; sincos_acc(ang, s, cc); c.MC[i] = cc; c.MS[i] = s; }
#pragma unroll 1
    for (int i = gt; i < S * 64; i += NGT) { const int pos = i >> 6, f = i & 63;
        const float inv = (float)exp(-9.210340371976184 * ((double)(2 * f) / 128.0)); const float ang = (float)pos * inv;
        float s, cc; sincos_acc(ang, s, cc); c.DC[i] = cc; c.DS[i] = s; }
    {
        LAS float* hs = (LAS float*)(lds + 131072 + wave * 1024);
        const float* W1 = a.in[16]; const float* b1 = a.in[17]; const float* fr = a.in[18]; const float* W2 = a.in[19]; const float* b2 = a.in[20];
        const float* W3 = a.in[21]; const float* b3 = a.in[22];
#pragma unroll 1
        for (int l = gw; l < S; l += NGW) {
            asm volatile("" ::: "memory");
            const float fq = fr[lane];
            const float t = (float)l * (1.0f / 8191.0f); const float w = 6.283185307179586f * (float)l / 8192.0f;
            if (lane < 33) { float z;
                if (lane == 0) z = t;
                else { const int k = (lane - 1) & 15; const float f = 1e-4f + (float)k * ((15.0f - 1e-4f) / 15.0f); float s, cc; sincos_acc(f * w, s, cc); z = (lane <= 16) ? cc : -s; }
                hs[lane] = z; }
            LDS_WAIT();
            float acc = 0.f;
#pragma unroll 3
            for (int k = 0; k < 33; ++k) acc = fmaf(hs[k], W1[k * 64 + lane], acc);
            float h = sin_acc(fq * (acc + b1[lane])); hs[64 + lane] = h; LDS_WAIT();
            acc = 0.f;
#pragma unroll 4
            for (int k = 0; k < 64; ++k) acc = fmaf(hs[64 + k], W2[k * 64 + lane], acc);
            h = sin_acc(fq * (acc + b2[lane])); hs[128 + lane] = h; LDS_WAIT();
            acc = 0.f;
#pragma unroll 4
            for (int k = 0; k < 64; ++k) acc = fmaf(hs[128 + k], W3[k * 64 + lane], acc);
            h = sin_acc(fq * (acc + b3[lane])); c.H3[(((size_t)(lane >> 2) * S) + l) * 4 + (lane & 3)] = h;
            LDS_WAIT();
        }
    }
    __syncthreads();
}

__device__ __forceinline__ void phase_gemm(KA& a, int ph, LAS unsigned char* lds) {
    const Ctx c = make_ctx(a); unsigned char* ws = c.ws;
    const int layer = (ph - 1) / 7, slot = (ph - 1) % 7, kind = layer_kind(layer);
    const size_t w_in = layer == 0 ? W0_IN : layer == 1 ? W1_IN : layer == 2 ? W2_IN : W3_IN;
    const size_t w_o = layer == 0 ? W0_O : layer == 1 ? W1_O : layer == 2 ? W2_O : W3_O;
    const size_t w_gu = layer == 0 ? W0_GU : layer == 1 ? W1_GU : layer == 2 ? W2_GU : W3_GU;
    const size_t w_dn = layer == 0 ? W0_DN : layer == 1 ? W1_DN : layer == 2 ? W2_DN : W3_DN;
    const size_t w_uq = layer == 0 ? W0_UQ : W3_UQ, w_ukv = layer == 0 ? W0_UKV : W3_UKV;
    float* ssq_mix = c.SSQ + (size_t)(2 * layer) * 8 * S; float* ssq_ffn = c.SSQ + (size_t)(2 * layer + 1) * 8 * S; float* ssq_nxt = c.SSQ + (size_t)(2 * layer + 2) * 8 * S;
    float* ssq_cq = c.SSQ + (size_t)(9 + (layer ? 2 : 0)) * 8 * S; float* ssq_ckv = ssq_cq + 8 * S;
    Epi E{}; E.exch = (LAS float*)(lds + 131072); const bf16_t* A = c.XB; const bf16_t* Bt = c.WB; int N = 2048, K = 2048;
    if (slot == 0) {
        E.ssq_in = ssq_mix; E.inv_k = 1.f / 2048.f; Bt = c.WB + w_in;
        if (kind == 0) { E.mode = EM_MLA_IN; E.o0 = (bf16_t*)(ws + R_CQ); E.o1 = (bf16_t*)(ws + R_CKV); E.o2 = (bf16_t*)(ws + R_K); E.ssq_out = ssq_cq; E.ssq_out2 = ssq_ckv; E.cs = c.MC; E.sn = c.MS; N = 1536; }
        else if (kind == 1) { E.mode = EM_HY_IN; E.o0 = (bf16_t*)(ws + R_UT); N = 6144; }
        else { E.mode = EM_DIFF_QKV; E.o0 = (bf16_t*)(ws + R_QD); E.o1 = (bf16_t*)(ws + R_KD); E.o2 = (bf16_t*)(ws + R_VD); E.cs = c.DC; E.sn = c.DS; N = 6144; }
    } else if (slot == 1) { E.mode = EM_MLA_UQ; E.ssq_in = ssq_cq; E.inv_k = 1.f / 768.f; E.o0 = (bf16_t*)(ws + R_Q); E.cs = c.MC; E.sn = c.MS; A = (const bf16_t*)(ws + R_CQ); Bt = c.WB + w_uq; N = 3072; K = 768; }
    else if (slot == 2) { E.mode = EM_MLA_UKV; E.ssq_in = ssq_ckv; E.inv_k = 1.f / 512.f; E.o0 = (bf16_t*)(ws + R_K); E.o1 = (bf16_t*)(ws + R_V); A = (const bf16_t*)(ws + R_CKV); Bt = c.WB + w_ukv; N = 4096; K = 512; }
    else if (slot == 4) { E.mode = EM_RES; E.xr = (layer == 0) ? a.in[0] : nullptr; E.o0 = c.XB; E.ssq_out = ssq_ffn; A = c.AO; Bt = c.WB + w_o; }
    else if (slot == 5) { E.mode = EM_GU; E.ssq_in = ssq_ffn; E.inv_k = 1.f / 2048.f; E.o0 = (bf16_t*)(ws + R_H); Bt = c.WB + w_gu; N = 11264; }
    else { E.mode = EM_RES; E.xr = nullptr; E.o0 = c.XB; E.ssq_out = ssq_nxt; A = (const bf16_t*)(ws + R_H); Bt = c.WB + w_dn; K = 5632; }
    pg8::Gemm g{A, Bt, S, N, K}; pg8::StaticOrder so; so.init(S, N, (int)gridDim.x, lbid());
    pg8::gemm_phase<Epi, pg8::StaticOrder>(lds, g, so, E);
    if (slot == 5 && layer < 3) {
        const int G = gridDim.x, bx = lbid(), first = (32 * 44) % G, nconv = G - first;
        if (bx >= first) { const int tid = ltid(), lane = tid & 63, wave = __builtin_amdgcn_readfirstlane(tid >> 6);
            const float* Wg = layer == 0 ? a.in[27] : layer == 1 ? a.in[39] : a.in[50];
            const float* gn = layer == 0 ? a.in[26] : layer == 1 ? a.in[38] : a.in[49];
            const size_t wo = layer == 0 ? W1_GU : layer == 1 ? W2_GU : W3_GU;
            cvt_gate_tail(Wg, gn, c.WB + wo, (LAS float*)(lds + wave * 16384), (bx - first) * 8 + wave, nconv * 8, lane); }
    }
}

__device__ __forceinline__ void phase_amla(KA& a, char* lds) {
    unsigned char* ws = a.ws; bf16_t* AO = (bf16_t*)(ws + WS_AO);
    const bf16_t* Q = (const bf16_t*)(ws + R_Q); const bf16_t* Kk = (const bf16_t*)(ws + R_K); const bf16_t* V = (const bf16_t*)(ws + R_V);
    const int G = gridDim.x, bx = lbid();
#pragma unroll 1
    for (int it = bx; it < 512; it += G) {
        const int h = (it & 7) + 8 * (it >> 8), qb = (it >> 3) & 31; const size_t q0 = (size_t)qb * 256;
        att::ATT192FN<192, 192, 128, 2048>(Q + ((size_t)h * S + q0) * 192, Kk + (size_t)h * S * 192, V + (size_t)h * S * 128, AO + q0 * 2048 + h * 128, S, lds);
    }
}

__device__ __forceinline__ void phase_adiff(KA& a, char* lds) {
    unsigned char* ws = a.ws; bf16_t* AO = (bf16_t*)(ws + WS_AO);
    const int G = gridDim.x, bx = lbid();
    const bf16_t* Qd = (const bf16_t*)(ws + R_QD); const bf16_t* Kd = (const bf16_t*)(ws + R_KD); const bf16_t* Vd = (const bf16_t*)(ws + R_VD);
    bf16_t* T = (bf16_t*)(ws + R_T) + (size_t)bx * (2 * 256 * 256);
#pragma unroll 1
    for (int it = bx; it < 256; it += G) {
        const int h = it & 7, qb = it >> 3; const size_t q0 = (size_t)qb * 256;
#pragma unroll 1
        for (int comp = 0; comp < 2; ++comp) {
            att::attn_body_dv256<128, 128, 256, 256>(Qd + ((size_t)(2 * h + comp) * S + q0) * 128, Kd + (size_t)(2 * h + comp) * S * 128, Vd + (size_t)h * S * 256,
                                                     T + comp * (256 * 256), S, lds);
        }
        __syncthreads();
        const int tid = ltid(), lane = tid & 63, wave = __builtin_amdgcn_readfirstlane(tid >> 6);
        float lam; { const float* lq1 = a.in[32]; const float* lk1 = a.in[33]; const float* lq2 = a.in[34]; const float* lk2 = a.in[35];
            float s1 = lq1[lane] * lk1[lane] + lq1[lane + 64] * lk1[lane + 64], s2 = lq2[lane] * lk2[lane] + lq2[lane + 64] * lk2[lane + 64];
            s1 = wave_sum(s1); s2 = wave_sum(s2); lam = __expf(s1) - __expf(s2) + 0.470713018f; }
        const float* subln = a.in[36];
        const f32x4 gsub = *(const f32x4*)(subln + 4 * lane);
#pragma unroll 1
        for (int rr = 0; rr < 32; ++rr) { const int row = wave * 32 + rr;
            const u32x2 w0 = *(const u32x2*)(T + (size_t)row * 256 + 4 * lane), w1 = *(const u32x2*)(T + 256 * 256 + (size_t)row * 256 + 4 * lane);
            const f32x4 t0 = {__uint_as_float(w0.x << 16), __uint_as_float(w0.x & 0xffff0000u), __uint_as_float(w0.y << 16), __uint_as_float(w0.y & 0xffff0000u)};
            const f32x4 t1 = {__uint_as_float(w1.x << 16), __uint_as_float(w1.x & 0xffff0000u), __uint_as_float(w1.y << 16), __uint_as_float(w1.y & 0xffff0000u)};
            const f32x4 d = t0 - t1 * lam;
            float s2 = (d.x * d.x + d.y * d.y) + (d.z * d.z + d.w * d.w); s2 = wave_sum(s2);
            const float rn = rsqrtf(s2 * (1.f / 256.f) + 1e-5f) * (1.f - 0.470713018f);
            const f32x4 ov = d * rn * gsub;
            u32x2 w; w.x = cvt_pk_bf16(ov.x, ov.y); w.y = cvt_pk_bf16(ov.z, ov.w);
            *(u32x2*)(AO + (q0 + row) * 2048 + h * 256 + 4 * lane) = w;
        }
        __syncthreads();
    }
}

__device__ __forceinline__ void phase_hyena(KA& a, LAS unsigned char* lds) {
    unsigned char* ws = a.ws; const float* H3 = (const float*)(ws + WS_H3);
    const int tid = ltid(); const int G = gridDim.x, bx = lbid();
    LAS f32x2* L = (LAS f32x2*)lds;
    LAS float* w8s = (LAS float*)(lds + 147456);
    LAS float* red = (LAS float*)(lds + 147456 + 2048);
    const bf16_t* UT = (const bf16_t*)(ws + R_UT);
    bf16_t* YT = (bf16_t*)(ws + R_YT);
    f32x2* SP0 = (f32x2*)(ws + R_SPEC) + (size_t)bx * 2 * FN; f32x2* SP1 = SP0 + FN;
    unsigned* SPb0 = (unsigned*)SP0; unsigned* SPb1 = SPb0 + FN;
    f32x2* Z1 = (f32x2*)(ws + R_Z1) + (size_t)bx * S;
    const float* cw = a.in[14]; const float* cb = a.in[15]; const float* W4 = a.in[23]; const float* hb = a.in[24];
#pragma unroll 1
    for (int pp = bx; pp < 1024; pp += G) {
        const int ca = 2 * pp, cbn = 2 * pp + 1;
        const float dla = fabsf(-3.0701134573253944f + (float)ca * ((-15.350567286626972f + 3.0701134573253944f) / 2047.0f));
        const float dlb = fabsf(-3.0701134573253944f + (float)cbn * ((-15.350567286626972f + 3.0701134573253944f) / 2047.0f));
#pragma unroll 1
        for (int rk = 0; rk < 1 + HY_REP_KERN; ++rk) {
        __syncthreads();
        { const int k = tid >> 3, j = tid & 7, o = j >> 2, jj = j & 3;
          w8s[tid] = W4[(size_t)k * 8192 + (jj >> 1) * 4096 + o * 2048 + ((jj & 1) ? cbn : ca)]; }
        __syncthreads();
        float sa0 = 0.f, sb0 = 0.f, sa1 = 0.f, sb1 = 0.f;
#pragma unroll 1
        for (int g = 0; g < 4; ++g) {
            const int lbase = tid + 2048 * g;
            f32x4 acc0[4], acc1[4];
#pragma unroll
            for (int li = 0; li < 4; ++li) { acc0[li] = (f32x4){0.f, 0.f, 0.f, 0.f}; acc1[li] = (f32x4){0.f, 0.f, 0.f, 0.f}; }
#pragma unroll 2
            for (int k4 = 0; k4 < 16; ++k4) {
                f32x4 hv[4];
#pragma unroll
                for (int li = 0; li < 4; ++li) hv[li] = *(const f32x4*)(H3 + ((size_t)k4 * S + (lbase + 512 * li)) * 4);
#pragma unroll
                for (int e = 0; e < 4; ++e) { const f32x4 wA = *(const LAS f32x4*)(w8s + (k4 * 4 + e) * 8), wB = *(const LAS f32x4*)(w8s + (k4 * 4 + e) * 8 + 4);
#pragma unroll
                    for (int li = 0; li < 4; ++li) { acc0[li] += wA * hv[li][e]; acc1[li] += wB * hv[li][e]; } }
            }
#pragma unroll
            for (int li = 0; li < 4; ++li) { const int l = lbase + 512 * li;
                const float t = (float)l * (1.0f / 8191.0f);
                const float da = __expf(-t * dla), db = __expf(-t * dlb);
                const f32x2 f0 = (f32x2){acc0[li][0] * da, acc0[li][1] * db}, b0 = (f32x2){acc0[li][2] * da, acc0[li][3] * db};
                const f32x2 f1 = (f32x2){acc1[li][0] * da, acc1[li][1] * db}, b1 = (f32x2){acc1[li][2] * da, acc1[li][3] * db};
                L[FP(l)] = f0; SP1[l] = f1; sa0 += fabsf(f0.x); sb0 += fabsf(f0.y); sa1 += fabsf(f1.x); sb1 += fabsf(f1.y);
                if (l == 0) { L[FP(S)] = (f32x2){0.f, 0.f}; SP1[S] = (f32x2){0.f, 0.f}; }
                else { L[FP(FN - l)] = b0; SP1[FN - l] = b1; sa0 += fabsf(b0.x); sb0 += fabsf(b0.y); sa1 += fabsf(b1.x); sb1 += fabsf(b1.y); }
            }
        }
        const float ta0 = block_sum(sa0, red, tid); const float tb0 = block_sum(sb0, red, tid);
        const float ta1 = block_sum(sa1, red, tid); const float tb1 = block_sum(sb1, red, tid);
        { const float ia = 1.f / ta0, ib = 1.f / tb0;
#pragma unroll 1
          for (int p = tid; p < FN; p += 512) { f32x2 v = L[FP(p)]; v.x *= ia; v.y *= ib; L[FP(p)] = v; } }
        fft_fwd(L, tid);
#pragma unroll 4
        for (int i = 0; i < 16; ++i) { const int p = 2 * (tid + 512 * i); const f32x4 v = *(const LAS f32x4*)(L + FP(p)); u32x2 w; w.x = cvt_pk_bf16(v[0], v[1]); w.y = cvt_pk_bf16(v[2], v[3]); *(u32x2*)(SPb0 + p) = w; }
        __syncthreads();
        { const float ia = 1.f / ta1, ib = 1.f / tb1;
#pragma unroll 4
          for (int i = 0; i < 16; ++i) { const int p = 2 * (tid + 512 * i); f32x4 v = *(const f32x4*)(SP1 + p); v[0] *= ia; v[1] *= ib; v[2] *= ia; v[3] *= ib; *(LAS f32x4*)(L + FP(p)) = v; } }
        fft_fwd(L, tid);
#pragma unroll 4
        for (int i = 0; i < 16; ++i) { const int p = 2 * (tid + 512 * i); const f32x4 v = *(const LAS f32x4*)(L + FP(p)); u32x2 w; w.x = cvt_pk_bf16(v[0], v[1]); w.y = cvt_pk_bf16(v[2], v[3]); *(u32x2*)(SPb1 + p) = w; }
        __syncthreads();
        }
        const bf16_t* ux1a = UT + (size_t)ca * S; const bf16_t* ux1b = UT + (size_t)cbn * S;
        const bf16_t* ux2a = UT + (size_t)(D + ca) * S; const bf16_t* ux2b = UT + (size_t)(D + cbn) * S;
        const bf16_t* uva = UT + (size_t)(2 * D + ca) * S; const bf16_t* uvb = UT + (size_t)(2 * D + cbn) * S;
#define BF2F(u16) __uint_as_float(((unsigned)(u16)) << 16)
#define SCONV4(dst, up, ch, t) do { const u32x2 xw_ = *(const u32x2*)((up) + (t)); const f32x4 x_ = {__uint_as_float(xw_.x << 16), __uint_as_float(xw_.x & 0xffff0000u), __uint_as_float(xw_.y << 16), __uint_as_float(xw_.y & 0xffff0000u)}; \
        const float xm_ = ((t) > 0) ? BF2F((up)[(t) - 1]) : 0.f, xp_ = ((t) + 4 < S) ? BF2F((up)[(t) + 4]) : 0.f; \
        const float w0_ = cw[ch], w1_ = cw[6144 + (ch)], w2_ = cw[2 * 6144 + (ch)], bb_ = cb[ch]; \
        dst[0] = xm_ * w0_ + x_[0] * w1_ + x_[1] * w2_ + bb_; dst[1] = x_[0] * w0_ + x_[1] * w1_ + x_[2] * w2_ + bb_; \
        dst[2] = x_[1] * w0_ + x_[2] * w1_ + x_[3] * w2_ + bb_; dst[3] = x_[2] * w0_ + x_[3] * w1_ + xp_ * w2_ + bb_; } while (0)
#pragma unroll 2
        for (int i = 0; i < 4; ++i) { const int t = 4 * (tid + 512 * i);
            f32x4 za, zb; SCONV4(za, uva, 2 * D + ca, t); SCONV4(zb, uvb, 2 * D + cbn, t);
            const f32x4 p01 = {za[0], zb[0], za[1], zb[1]}, p23 = {za[2], zb[2], za[3], zb[3]};
            *(LAS f32x4*)(L + FP(t)) = p01; *(LAS f32x4*)(L + FP(t) + 2) = p23;
            *(LAS f32x4*)(L + FP(S + t)) = (f32x4){0.f, 0.f, 0.f, 0.f}; *(LAS f32x4*)(L + FP(S + t) + 2) = (f32x4){0.f, 0.f, 0.f, 0.f};
            *(f32x4*)(Z1 + t) = p01; *(f32x4*)(Z1 + t + 2) = p23; }
        fft_fwd(L, tid);
        spec_mul(L, SPb0, tid);
        fft_inv(L, tid);
        const float b0a = hb[ca], b0b = hb[cbn], b1a = hb[D + ca], b1b = hb[D + cbn];
        const float invn = 1.0f / (float)FN;
#pragma unroll 2
        for (int i = 0; i < 4; ++i) { const int t = 4 * (tid + 512 * i);
            f32x4 ga, gb; SCONV4(ga, ux1a, ca, t); SCONV4(gb, ux1b, cbn, t);
            const f32x4 c01 = *(const LAS f32x4*)(L + FP(t)), c23 = *(const LAS f32x4*)(L + FP(t) + 2);
            const f32x4 z01 = *(const f32x4*)(Z1 + t), z23 = *(const f32x4*)(Z1 + t + 2);
            const f32x4 n01 = {ga[0] * (c01[0] * invn + z01[0] * b0a), gb[0] * (c01[1] * invn + z01[1] * b0b), ga[1] * (c01[2] * invn + z01[2] * b0a), gb[1] * (c01[3] * invn + z01[3] * b0b)};
            const f32x4 n23 = {ga[2] * (c23[0] * invn + z23[0] * b0a), gb[2] * (c23[1] * invn + z23[1] * b0b), ga[3] * (c23[2] * invn + z23[2] * b0a), gb[3] * (c23[3] * invn + z23[3] * b0b)};
            *(f32x4*)(Z1 + t) = n01; *(f32x4*)(Z1 + t + 2) = n23;
            *(LAS f32x4*)(L + FP(t)) = n01; *(LAS f32x4*)(L + FP(t) + 2) = n23;
            *(LAS f32x4*)(L + FP(S + t)) = (f32x4){0.f, 0.f, 0.f, 0.f}; *(LAS f32x4*)(L + FP(S + t) + 2) = (f32x4){0.f, 0.f, 0.f, 0.f}; }
        fft_fwd(L, tid);
        spec_mul(L, SPb1, tid);
        fft_inv(L, tid);
#pragma unroll 2
        for (int i = 0; i < 4; ++i) { const int t = 4 * (tid + 512 * i);
            f32x4 ga, gb; SCONV4(ga, ux2a, D + ca, t); SCONV4(gb, ux2b, D + cbn, t);
            const f32x4 c01 = *(const LAS f32x4*)(L + FP(t)), c23 = *(const LAS f32x4*)(L + FP(t) + 2);
            const f32x4 z01 = *(const f32x4*)(Z1 + t), z23 = *(const f32x4*)(Z1 + t + 2);
            const float ya0 = ga[0] * (c01[0] * invn + z01[0] * b1a), yb0 = gb[0] * (c01[1] * invn + z01[1] * b1b);
            const float ya1 = ga[1] * (c01[2] * invn + z01[2] * b1a), yb1 = gb[1] * (c01[3] * invn + z01[3] * b1b);
            const float ya2 = ga[2] * (c23[0] * invn + z23[0] * b1a), yb2 = gb[2] * (c23[1] * invn + z23[1] * b1b);
            const float ya3 = ga[3] * (c23[2] * invn + z23[2] * b1a), yb3 = gb[3] * (c23[3] * invn + z23[3] * b1b);
            u32x2 wa, wb; wa.x = cvt_pk_bf16(ya0, ya1); wa.y = cvt_pk_bf16(ya2, ya3); wb.x = cvt_pk_bf16(yb0, yb1); wb.y = cvt_pk_bf16(yb2, yb3);
            *(u32x2*)(YT + (size_t)ca * S + t) = wa; *(u32x2*)(YT + (size_t)cbn * S + t) = wb; }
#undef SCONV4
        __syncthreads();
    }
}

__device__ __forceinline__ void phase_tr(KA& a, LAS unsigned char* lds) {
    unsigned char* ws = a.ws; bf16_t* AO = (bf16_t*)(ws + WS_AO); const bf16_t* YT = (const bf16_t*)(ws + R_YT);
    const int tid = ltid(); const int G = gridDim.x, bx = lbid();
    LAS bf16_t* tl = (LAS bf16_t*)lds;
#pragma unroll 1
    for (int tile = bx; tile < 32 * 128; tile += G) {
        const int c0 = (tile & 31) * 64, t0 = (tile >> 5) * 64;
        __syncthreads();
        { const int i = tid >> 3, j8 = tid & 7;
          const bf16x8 v = *(const bf16x8*)(YT + (size_t)(c0 + i) * S + t0 + j8 * 8);
#pragma unroll
          for (int e = 0; e < 8; ++e) tl[(j8 * 8 + e) * 72 + i] = (bf16_t)v[e]; }
        __syncthreads();
        { const int tt = tid >> 3, c8 = tid & 7;
          const bf16x8 v = *(const LAS bf16x8*)(tl + tt * 72 + c8 * 8);
          *(bf16x8*)(AO + (size_t)(t0 + tt) * D + c0 + c8 * 8) = v; }
    }
    __syncthreads();
}

__device__ __forceinline__ void phase_final(KA& a) {
    const int tid = ltid(), lane = tid & 63, wave = __builtin_amdgcn_readfirstlane(tid >> 6);
    const int gw = lbid() * 8 + wave, NGW = gridDim.x * 8;
    const float* gfin = a.in[53]; const float* ssq = (const float*)(a.ws + WS_SSQ) + (size_t)8 * 8 * S; float* X = a.out;
#pragma unroll 1
    for (int r = gw; r < S; r += NGW) {
        float tsum = 0.f;
#pragma unroll
        for (int p = 0; p < 8; ++p) tsum += ssq[(size_t)p * S + r];
        const float rs = rsqrtf(tsum * (1.f / 2048.f) + RMS_EPS);
        f32x4* xo = (f32x4*)(X + (size_t)r * D) + lane; const f32x4* gg = (const f32x4*)gfin + lane;
        const u32x2* xb = (const u32x2*)((const bf16_t*)(a.ws + WS_XB) + (size_t)r * D) + lane;
#pragma unroll
        for (int j = 0; j < 8; ++j) { const u32x2 w = xb[64 * j];
            const f32x4 v = {__uint_as_float(w.x << 16), __uint_as_float(w.x & 0xffff0000u), __uint_as_float(w.y << 16), __uint_as_float(w.y & 0xffff0000u)};
            xo[64 * j] = v * rs * gg[64 * j]; }
    }
}

template <int TYPE> __device__ __forceinline__ void run_phase(KA& a, int ph, unsigned char* lds_raw) {
    LAS unsigned char* lds = (LAS unsigned char*)lds_raw;
    if constexpr (TYPE == T_P0) phase_p0(a, lds);
    else if constexpr (TYPE == T_GEMM) phase_gemm(a, ph, lds);
    else if constexpr (TYPE == T_AMLA) phase_amla(a, (char*)lds_raw);
    else if constexpr (TYPE == T_ADIFF) phase_adiff(a, (char*)lds_raw);
    else if constexpr (TYPE == T_HY) phase_hyena(a, lds);
    else if constexpr (TYPE == T_TR) phase_tr(a, lds);
    else if constexpr (TYPE == T_FINAL) phase_final(a);
}

template <int TYPE> __global__ void __launch_bounds__(512, 2) phase_kernel(Args a_) {
    extern __shared__ __attribute__((aligned(16))) unsigned char lds_raw[];
    KA& a = *largs();
    run_phase<TYPE>(a, a.ph_lo, lds_raw);
}

#ifndef HY_REP_FFT
#define HY_REP_FFT 0
#endif
#ifndef MK_REPEAT_MASK
#define MK_REPEAT_MASK 0
#endif
#ifndef MK_CUTS
#define MK_CUTS 0, N_PHASES
#endif
#ifndef MEGA_MASK
#define MEGA_MASK 0xff
#endif
#if !MK_MULTI
__global__ void __launch_bounds__(512, 2) mega_fwd(Args a_) {
    extern __shared__ __attribute__((aligned(16))) unsigned char lds_raw[];
    const int ph_lo = a_.ph_lo, ph_hi = a_.ph_hi;
    if (ph_hi < 0) cg::this_grid().sync();
    volatile LAS unsigned* stw = (volatile LAS unsigned*)((LAS unsigned char*)lds_raw + LDS_BYTES - 16);
    if (threadIdx.x == 0) { stw[0] = 0u; stw[1] = 0u; }
    __syncthreads();
    const XcdBarrier bar = xcd_barrier_post((unsigned*)(a_.ws + WS_BAR) + (size_t)a_.li * XCD_BAR_WORDS, stw);
    if (ph_lo == 0) {
#pragma unroll 1
        for (int r0 = 0; r0 < ((MK_REPEAT_MASK & 2) ? 2 : 1); ++r0) {
        { KA& a = *largs(); run_phase<T_P0>(a, 0, lds_raw); }
        if (ph_hi > 1) xcd_barrier(bar);
        }
    }
    const int l0 = ph_lo < 1 ? 1 : ph_lo, l1 = ph_hi < N_PHASES - 1 ? ph_hi : N_PHASES - 1;
    int rep = 0; (void)rep;
#pragma unroll 1
    for (int ph = l0; ph < l1; ++ph) {
        bool sync_after; const int ty = phase_type(ph, sync_after);
        KA& a = *largs();
        switch (ty) {
            case T_GEMM: run_phase<T_GEMM>(a, ph, lds_raw); break;
            case T_AMLA: run_phase<T_AMLA>(a, ph, lds_raw); break;
            case T_ADIFF: run_phase<T_ADIFF>(a, ph, lds_raw); break;
            case T_HY: run_phase<T_HY>(a, ph, lds_raw); break;
            case T_TR: run_phase<T_TR>(a, ph, lds_raw); break;
            default: break;
        }
        if (sync_after && ph + 1 < ph_hi) xcd_barrier(bar);
#if MK_REPEAT_MASK
        if (((MK_REPEAT_MASK >> ty) & 1) && !rep) { rep = 1; --ph; } else rep = 0;
#endif
    }
    if (ph_hi == N_PHASES) { KA& a = *largs(); run_phase<T_FINAL>(a, N_PHASES - 1, lds_raw); }
}
#endif
template <int TYPE> static void launch_phase(int grid, hipStream_t stream, Args a) {
    static bool attr = false;
    if (!attr) { (void)hipFuncSetAttribute((const void*)phase_kernel<TYPE>, hipFuncAttributeMaxDynamicSharedMemorySize, LDS_BYTES); attr = true; }
    hipLaunchKernelGGL(phase_kernel<TYPE>, dim3(grid), dim3(512), LDS_BYTES, stream, a);
}
extern "C" void kernel_launch(void* const* d_in, const int* in_sizes, int n_in, void* d_out, int out_size, void* d_ws, size_t ws_size, hipStream_t stream) {
    static int grid = 0;
    if (grid == 0) {
        if (n_in != 54 || out_size != S * D || ws_size < WS_END) { fprintf(stderr, "kernel_launch: bad shapes n_in %d out %d ws %zu (need %zu)\n", n_in, out_size, ws_size, (size_t)WS_END); grid = -1; return; }
        int dev = 0, cus = 0;
        (void)hipGetDevice(&dev); (void)hipDeviceGetAttribute(&cus, hipDeviceAttributeMultiprocessorCount, dev);
#if !MK_MULTI
        if (hipFuncSetAttribute((const void*)mega_fwd, hipFuncAttributeMaxDynamicSharedMemorySize, LDS_BYTES) != hipSuccess) { fprintf(stderr, "kernel_launch: hipFuncSetAttribute failed\n"); grid = -1; return; }
        int per_cu = 0;
        (void)hipOccupancyMaxActiveBlocksPerMultiprocessor(&per_cu, (const void*)mega_fwd, 512, LDS_BYTES);
        (void)hipGetLastError();
        if (per_cu < 1) fprintf(stderr, "kernel_launch: occupancy query says %d blocks per CU\n", per_cu);
#endif
        grid = cus > 0 ? cus : 256;
    }
    if (grid < 0) return;
    Args a{};
    for (int i = 0; i < 54; ++i) a.in[i] = (const float*)d_in[i];
    a.out = (float*)d_out; a.ws = (unsigned char*)d_ws;
#if MK_MULTI
    for (int p = 0; p < N_PHASES; ++p) {
        bool sa; const int ty = phase_type(p, sa); a.ph_lo = p; a.ph_hi = p + 1;
        switch (ty) {
            case T_P0: launch_phase<T_P0>(grid, stream, a); break;
            case T_GEMM: launch_phase<T_GEMM>(grid, stream, a); break;
            case T_AMLA: launch_phase<T_AMLA>(grid, stream, a); break;
            case T_ADIFF: launch_phase<T_ADIFF>(grid, stream, a); break;
            case T_HY: launch_phase<T_HY>(grid, stream, a); break;
            case T_TR: launch_phase<T_TR>(grid, stream, a); break;
            case T_FINAL: launch_phase<T_FINAL>(grid, stream, a); break;
            default: break;
        }
    }
#else
    {
        const int cuts[] = {MK_CUTS};
        const int ncut = (int)(sizeof(cuts) / sizeof(int));
        (void)hipMemsetAsync((char*)d_ws + WS_BAR, 0, 64 * 1024, stream);
        for (int i = 0; i + 1 < ncut; ++i) {
            a.ph_lo = cuts[i]; a.ph_hi = cuts[i + 1]; a.li = i;
            void* args[] = {&a};
            hipError_t e = hipLaunchCooperativeKernel((const void*)mega_fwd, dim3(grid), dim3(512), args, LDS_BYTES, stream);
            if (e != hipSuccess) fprintf(stderr, "kernel_launch: cooperative launch failed: %s (grid %d)\n", hipGetErrorString(e), grid);
        }
    }
#endif
}
```

```cpp
#include <hip/hip_runtime.h>
#include <hip/hip_bf16.h>
#include <hip/hip_cooperative_groups.h>
#include <cstdio>
#include <cstdint>
namespace cg = cooperative_groups;

#ifndef MK_MULTI
#define MK_MULTI 0
#endif

#ifndef HY_REP_FFT
#define HY_REP_FFT 0
#endif
#ifndef HY_REP_KERN
#define HY_REP_KERN 0
#endif
#define LAS __attribute__((address_space(3)))
typedef unsigned short bf16_t;
typedef short bf16x8 __attribute__((ext_vector_type(8)));
typedef short s16x4 __attribute__((ext_vector_type(4)));
typedef float f32x4 __attribute__((ext_vector_type(4)));
typedef float f32x2 __attribute__((ext_vector_type(2)));
typedef float f32x16 __attribute__((ext_vector_type(16)));
typedef unsigned u32x4 __attribute__((ext_vector_type(4)));
typedef unsigned u32x2 __attribute__((ext_vector_type(2)));

constexpr int S = 8192, D = 2048, FF = 5632, NT512 = 512;
constexpr float RMS_EPS = 1e-6f;
constexpr int LDS_BYTES = 155648;

constexpr size_t MiB = 1u << 20;
constexpr size_t E_IN = (size_t)1536 * 2048, E_UQ = (size_t)3072 * 768, E_UKV = (size_t)4096 * 512, E_O = (size_t)2048 * 2048,
                 E_GU = (size_t)11264 * 2048, E_DN = (size_t)2048 * 5632, E_HY = (size_t)6144 * 2048;
constexpr size_t W0_IN = 0, W0_UQ = W0_IN + E_IN, W0_UKV = W0_UQ + E_UQ, W0_O = W0_UKV + E_UKV, W0_GU = W0_O + E_O, W0_DN = W0_GU + E_GU;
constexpr size_t W1_IN = W0_DN + E_DN, W1_O = W1_IN + E_HY, W1_GU = W1_O + E_O, W1_DN = W1_GU + E_GU;
constexpr size_t W2_IN = W1_DN + E_DN, W2_O = W2_IN + E_HY, W2_GU = W2_O + E_O, W2_DN = W2_GU + E_GU;
constexpr size_t W3_IN = W2_DN + E_DN, W3_UQ = W3_IN + E_IN, W3_UKV = W3_UQ + E_UQ, W3_O = W3_UKV + E_UKV, W3_GU = W3_O + E_O, W3_DN = W3_GU + E_GU;
constexpr size_t W_END_E = W3_DN + E_DN;
constexpr size_t WS_W = 0;
constexpr size_t WS_XB = ((W_END_E * 2 + MiB - 1) / MiB) * MiB;
constexpr size_t WS_AO = WS_XB + 32 * MiB;
constexpr size_t WS_SSQ = WS_AO + 32 * MiB;
constexpr size_t WS_MC = WS_SSQ + 4 * MiB, WS_MS = WS_MC + 1 * MiB;
constexpr size_t WS_DC = WS_MS + 1 * MiB, WS_DS = WS_DC + 2 * MiB;
constexpr size_t WS_H3 = WS_DS + 2 * MiB;
constexpr size_t WS_BAR = WS_H3 + 2 * MiB;
constexpr size_t WS_R = WS_BAR + 1 * MiB;
constexpr size_t R_CQ = WS_R, R_CKV = R_CQ + 12 * MiB, R_Q = R_CKV + 8 * MiB, R_K = R_Q + 48 * MiB, R_V = R_K + 48 * MiB;
constexpr size_t R_UT = WS_R, R_YT = R_UT + 192 * MiB, R_SPEC = R_YT + 32 * MiB, R_Z1 = R_SPEC + 64 * MiB, R_HY_END = R_Z1 + 16 * MiB;
constexpr size_t R_QD = WS_R, R_KD = R_QD + 32 * MiB, R_VD = R_KD + 32 * MiB, R_T = R_VD + 32 * MiB;
constexpr size_t R_H = WS_R;
constexpr size_t WS_END = R_HY_END;

struct Args { const float* in[54]; float* out; unsigned char* ws; int ph_lo, ph_hi, li, pad; };
typedef const __attribute__((address_space(4))) Args KA;
__device__ __forceinline__ KA* largs() { KA* p = (KA*)__builtin_amdgcn_kernarg_segment_ptr(); asm volatile("" : "+s"(p)); return p; }

__device__ __forceinline__ unsigned cvt_pk_bf16(float lo, float hi) { unsigned r; asm volatile("v_cvt_pk_bf16_f32 %0, %1, %2" : "=v"(r) : "v"(lo), "v"(hi)); return r; }
__device__ __forceinline__ float wave_sum(float v) {
#pragma unroll
    for (int o = 1; o < 64; o <<= 1) v += __shfl_xor(v, o);
    return v;
}
__device__ __forceinline__ int ltid() { int t = threadIdx.x; asm volatile("" : "+v"(t)); return t; }
__device__ __forceinline__ int lbid() { int b = blockIdx.x; asm volatile("" : "+s"(b)); return b; }
#define LDS_WAIT() asm volatile("s_waitcnt lgkmcnt(0)" ::: "memory")
__device__ __forceinline__ void sincos_acc(float x, float& s, float& c) {
    const double xd = (double)x; const double q = __builtin_rint(xd * 0.15915494309189533577);
    const float r = (float)(xd - q * 6.283185307179586476925);
    float sgn = 1.f, rr = r;
    if (rr > 1.5707963267948966f) { rr = 3.14159265358979323846f - rr; sgn = -1.f; }
    else if (rr < -1.5707963267948966f) { rr = -3.14159265358979323846f - rr; sgn = -1.f; }
    const float z = rr * rr;
    float ps = -7.6471637318198164759e-13f; ps = fmaf(ps, z, 1.6059043836821614599e-10f); ps = fmaf(ps, z, -2.5052108385441718775e-8f); ps = fmaf(ps, z, 2.7557319223985890653e-6f);
    ps = fmaf(ps, z, -1.9841269841269841270e-4f); ps = fmaf(ps, z, 8.3333333333333333333e-3f); ps = fmaf(ps, z, -1.6666666666666666667e-1f);
    s = fmaf(rr * z, ps, rr);
    float pc = 4.7794773323873852974e-14f; pc = fmaf(pc, z, -1.1470745597729724714e-11f); pc = fmaf(pc, z, 2.0876756987868098979e-9f); pc = fmaf(pc, z, -2.7557319223985890653e-7f);
    pc = fmaf(pc, z, 2.4801587301587301587e-5f); pc = fmaf(pc, z, -1.3888888888888888889e-3f); pc = fmaf(pc, z, 4.1666666666666666667e-2f); pc = fmaf(pc, z, -0.5f);
    c = sgn * fmaf(pc, z, 1.0f);
}
__device__ __forceinline__ float sin_acc(float x) { float s, c; sincos_acc(x, s, c); return s; }

namespace pg8 {
#define PG8_LAS __attribute__((address_space(3)))
constexpr int BM = 256, BK = 64, HALF = 128, HTB = HALF * BK * 2, STAGE_BYTES = 8 * HTB, NXCD = 8, WGM = 8;
__host__ __device__ __forceinline__ int lds_byte(int r, int c) { const int st = (r >> 4) * 2 + (c >> 5), rr = r & 15, cc = c & 31, ob = rr * 64 + cc * 2; return st * 1024 + (ob ^ (((ob >> 9) & 1) << 5)); }
__host__ __device__ __forceinline__ void stage_rc(int b, int& R, int& C) { const int st = b / 1024, sb = b % 1024, swz = sb ^ (((sb >> 9) & 1) << 5); R = (st >> 1) * 16 + swz / 64; C = (st & 1) * 32 + (swz % 64) / 2; }
__host__ __device__ __forceinline__ int perm32(int rho) { const int n = rho >> 4, i = rho & 15; return 8 * (i >> 2) + 4 * n + (i & 3); }
struct Unit { int pm, pn; };
struct Gemm { const bf16_t* A; const bf16_t* Bt; int M, N, K; };
struct StaticOrder {
    int nM, nN, nwg, G, c;
    __host__ __device__ void init(int M, int N, int G_, int c_) { nM = M / BM; nN = N / BM; nwg = nM * nN; G = G_; c = c_; }
    __host__ __device__ bool next(int i, Unit& u) const {
        const long L = (long)i * G + c; if (L >= nwg) return false;
        int wgid = (int)L; { const int q = nwg / NXCD, r = nwg % NXCD, xcd = wgid % NXCD, off = wgid / NXCD; wgid = (xcd < r ? xcd * (q + 1) : r * (q + 1) + (xcd - r) * q) + off; }
        const int nig = WGM * nN, gid = wgid / nig, fm = gid * WGM, gsz = (nM - fm) < WGM ? (nM - fm) : WGM;
        u.pm = fm + ((wgid % nig) % gsz); u.pn = (wgid % nig) / gsz; return true;
    }
};

template <class Epi, class Sched>
__device__ __forceinline__ void gemm_phase(PG8_LAS unsigned char* lds, const Gemm g, const Sched& S, const Epi& E) {
    const int tid = ltid(), wid = __builtin_amdgcn_readfirstlane(tid >> 6), lane = tid & 63, wr = wid >> 2, wc = wid & 3, fr = lane & 15, fq = lane >> 4;
    const int K = g.K, nt = K / BK;
    unsigned voffA[2], voffB[2];
#pragma unroll
    for (int i = 0; i < 2; ++i) { int R, C; stage_rc(tid * 16 + i * 8192, R, C); const int Rb = ((R & ~31) + perm32(R & 31));
        voffA[i] = (unsigned)(R * K + C) * 2u; voffB[i] = (unsigned)(Rb * K + C) * 2u; }
    const size_t kstep = (size_t)(BK * 2);
    const size_t hstep = (size_t)HALF * K * 2;
    const size_t tstep = 2 * hstep;
    const unsigned ldsw = (unsigned)wid * 1024u;
    const int aoff = lds_byte(wr * 64 + fr, fq * 8), boff = lds_byte(wc * 32 + fr, fq * 8);
#define PG8_SA(b, h) (((b) * 2 + (h)) * HTB)
#define PG8_SB(b, h) ((4 + (b) * 2 + (h)) * HTB)
#define PG8_STAGE(bufoff, gbase, voff) do { _Pragma("unroll") for (int _i = 0; _i < 2; ++_i) \
        __builtin_amdgcn_global_load_lds((const unsigned*)((const char*)(gbase) + (voff)[_i]), (PG8_LAS unsigned*)(lds + (bufoff) + ldsw + _i * 8192), 16, 0, 0); } while (0)
#define PG8_LDA(dst, b, h) do { _Pragma("unroll") for (int m = 0; m < 4; ++m) _Pragma("unroll") for (int k = 0; k < 2; ++k) dst[m][k] = *(const PG8_LAS bf16x8*)(lds + PG8_SA(b, h) + aoff + m * 2048 + k * 1024); } while (0)
#define PG8_LDB(dst, b, h) do { _Pragma("unroll") for (int n = 0; n < 2; ++n) _Pragma("unroll") for (int k = 0; k < 2; ++k) dst[n][k] = *(const PG8_LAS bf16x8*)(lds + PG8_SB(b, h) + boff + n * 2048 + k * 1024); } while (0)
#define PG8_MMA(ai, bj, At, Bt) do { __builtin_amdgcn_s_setprio(1); _Pragma("unroll") for (int m = 0; m < 4; ++m) _Pragma("unroll") for (int n = 0; n < 2; ++n) _Pragma("unroll") for (int k = 0; k < 2; ++k) \
        acc[ai][bj][m][n] = __builtin_amdgcn_mfma_f32_16x16x32_bf16(Bt[n][k], At[m][k], acc[ai][bj][m][n], 0, 0, 0); __builtin_amdgcn_s_setprio(0); } while (0)
#define PG8_WAIT_V(n) asm volatile("s_waitcnt vmcnt(" #n ")" ::: "memory")
#define PG8_WAIT_L(n) asm volatile("s_waitcnt lgkmcnt(" #n ")" ::: "memory")
#define PG8_BAR __builtin_amdgcn_s_barrier()
#define PG8_SCHED __builtin_amdgcn_sched_barrier(0)
    Unit cur, nxt; int ui = 0;
    if (!S.next(0, cur)) return;
    f32x4 acc[2][2][4][2];
#pragma unroll
    for (int a = 0; a < 2; ++a)
#pragma unroll
        for (int b = 0; b < 2; ++b)
#pragma unroll
            for (int m = 0; m < 4; ++m)
#pragma unroll
                for (int n = 0; n < 2; ++n) acc[a][b][m][n] = (f32x4){0.f, 0.f, 0.f, 0.f};
    bf16x8 At[4][2], B0[2][2], B1[2][2];
    const char* cA = (const char*)g.A + (size_t)cur.pm * tstep; const char* cB = (const char*)g.Bt + (size_t)cur.pn * tstep;
    PG8_STAGE(PG8_SB(0, 0), cB, voffB); PG8_STAGE(PG8_SB(0, 1), cB + hstep, voffB); PG8_STAGE(PG8_SA(0, 0), cA, voffA); PG8_STAGE(PG8_SA(0, 1), cA + hstep, voffA);
    if (wr == 1) PG8_BAR;
    PG8_WAIT_V(2); PG8_BAR;
    PG8_STAGE(PG8_SB(1, 0), cB + kstep, voffB); PG8_STAGE(PG8_SA(1, 0), cA + kstep, voffA); PG8_STAGE(PG8_SB(1, 1), cB + hstep + kstep, voffB);
    PG8_WAIT_V(6); PG8_BAR;
    for (;;) {
        const bool has_next = S.next(ui + 1, nxt);
        const char* nA = has_next ? (const char*)g.A + (size_t)nxt.pm * tstep : cA; const char* nB = has_next ? (const char*)g.Bt + (size_t)nxt.pn * tstep : cB;
        for (int t = 0; t < nt; t += 2) {
            const bool last = (t == nt - 2);
            const char* a1 = cA + (size_t)(t + 1) * kstep;
            const char* a2 = last ? nA : cA + (size_t)(t + 2) * kstep; const char* b2 = last ? nB : cB + (size_t)(t + 2) * kstep;
            const char* a3 = a2 + kstep; const char* b3 = b2 + kstep;
            PG8_LDB(B0, 0, 0); PG8_LDB(B1, 0, 1); PG8_SCHED; PG8_LDA(At, 0, 0); PG8_STAGE(PG8_SA(1, 1), a1 + hstep, voffA);
            PG8_WAIT_V(8); PG8_WAIT_L(0); PG8_BAR; PG8_MMA(0, 0, At, B0); PG8_MMA(0, 1, At, B1); PG8_BAR; PG8_SCHED;
            PG8_LDA(At, 0, 1); PG8_STAGE(PG8_SB(0, 0), b2, voffB); PG8_STAGE(PG8_SB(0, 1), b2 + hstep, voffB); PG8_STAGE(PG8_SA(0, 0), a2, voffA);
            PG8_WAIT_V(8); PG8_WAIT_L(0); PG8_BAR; PG8_MMA(1, 0, At, B0); PG8_MMA(1, 1, At, B1); PG8_BAR; PG8_SCHED;
            PG8_LDB(B0, 1, 0); PG8_LDB(B1, 1, 1); PG8_SCHED; PG8_LDA(At, 1, 0); PG8_STAGE(PG8_SA(0, 1), a2 + hstep, voffA);
            PG8_WAIT_V(8); PG8_WAIT_L(0); PG8_BAR; PG8_MMA(0, 0, At, B0); PG8_MMA(0, 1, At, B1); PG8_BAR; PG8_SCHED;
            PG8_LDA(At, 1, 1); PG8_STAGE(PG8_SB(1, 0), b3, voffB); PG8_STAGE(PG8_SB(1, 1), b3 + hstep, voffB); PG8_STAGE(PG8_SA(1, 0), a3, voffA);
            PG8_WAIT_V(8); PG8_WAIT_L(0); PG8_BAR; PG8_MMA(1, 0, At, B0); PG8_MMA(1, 1, At, B1); PG8_BAR; PG8_SCHED;
        }
        if (wr == 0) PG8_BAR;
        E(acc, cur, wr, wc, fr, fq);
        if (!has_next) break;
#pragma unroll
        for (int a = 0; a < 2; ++a)
#pragma unroll
            for (int b = 0; b < 2; ++b)
#pragma unroll
                for (int m = 0; m < 4; ++m)
#pragma unroll
                    for (int n = 0; n < 2; ++n) acc[a][b][m][n] = (f32x4){0.f, 0.f, 0.f, 0.f};
        cur = nxt; cA = nA; cB = nB; ++ui;
        if (wr == 1) PG8_BAR;
    }
    PG8_WAIT_V(0);
    PG8_BAR;
#undef PG8_SA
#undef PG8_SB
#undef PG8_STAGE
#undef PG8_LDA
#undef PG8_LDB
#undef PG8_MMA
#undef PG8_WAIT_V
#undef PG8_WAIT_L
#undef PG8_BAR
#undef PG8_SCHED
}
}

enum { EM_MLA_IN = 0, EM_MLA_UQ = 1, EM_MLA_UKV = 2, EM_RES = 3, EM_HY_IN = 4, EM_DIFF_QKV = 5, EM_GU = 6 };
struct Epi {
    static constexpr bool PERM = true;
    int mode;
    const float* ssq_in; float inv_k;
    float* ssq_out; float* ssq_out2;
    bf16_t* o0; bf16_t* o1; bf16_t* o2;
    float* xf; const float* xr;
    const float* cs; const float* sn;
    LAS float* exch;
    __device__ __forceinline__ static void st8(bf16_t* p, f32x4 a, f32x4 b) {
        u32x4 w; w.x = cvt_pk_bf16(a[0], a[1]); w.y = cvt_pk_bf16(a[2], a[3]); w.z = cvt_pk_bf16(b[0], b[1]); w.w = cvt_pk_bf16(b[2], b[3]); *(u32x4*)p = w; }
    __device__ __forceinline__ static void st4(bf16_t* p, f32x4 a) { u32x2 w; w.x = cvt_pk_bf16(a[0], a[1]); w.y = cvt_pk_bf16(a[2], a[3]); *(u32x2*)p = w; }
    __device__ __forceinline__ static float dot8(f32x4 a, f32x4 b) { return (a[0] * a[0] + a[1] * a[1]) + (a[2] * a[2] + a[3] * a[3]) + (b[0] * b[0] + b[1] * b[1]) + (b[2] * b[2] + b[3] * b[3]); }
    __device__ __forceinline__ void operator()(const f32x4 (&acc)[2][2][4][2], const pg8::Unit& u, int wr, int wc, int fr_, int fq_) const {
        int fr = fr_, fq = fq_; asm volatile("" : "+v"(fr), "+v"(fq));
        const int cw = wc * 32 + 8 * fq;
#pragma unroll
        for (int ai = 0; ai < 2; ++ai)
#pragma unroll
        for (int m = 0; m < 4; ++m) {
            const int r = u.pm * 256 + ai * 128 + wr * 64 + m * 16 + fr;
            float rs = 1.f;
            if (mode != EM_RES) { float t = 0.f;
#pragma unroll
                for (int p = 0; p < 8; ++p) t += ssq_in[(size_t)p * S + r];
                rs = rsqrtf(t * inv_k + RMS_EPS); }
            if (mode == EM_MLA_IN) {
                if (u.pn < 5) {
                    bf16_t* dst = (u.pn < 3) ? (o0 + (size_t)r * 768 + u.pn * 256) : (o1 + (size_t)r * 512 + (u.pn - 3) * 256);
                    float part = 0.f;
#pragma unroll
                    for (int bj = 0; bj < 2; ++bj) { const f32x4 v0 = acc[ai][bj][m][0] * rs, v1 = acc[ai][bj][m][1] * rs; part += dot8(v0, v1); st8(dst + bj * 128 + cw, v0, v1); }
                    part += __shfl_xor(part, 16); part += __shfl_xor(part, 32);
                    if (fq == 0) exch[(ai * 128 + wr * 64 + m * 16 + fr) * 4 + wc] = part;
                } else if (wc == 0) {
#pragma unroll
                    for (int n = 0; n < 2; ++n) { const int i0 = 8 * fq + 4 * n;
                        const f32x4 c = *(const f32x4*)(cs + (size_t)r * 32 + i0), s = *(const f32x4*)(sn + (size_t)r * 32 + i0);
                        const f32x4 x1 = acc[ai][0][m][n] * rs, x2 = acc[ai][1][m][n] * rs;
                        const f32x4 y1 = x1 * c - x2 * s, y2 = x1 * s + x2 * c;
                        u32x2 w1, w2; w1.x = cvt_pk_bf16(y1[0], y1[1]); w1.y = cvt_pk_bf16(y1[2], y1[3]); w2.x = cvt_pk_bf16(y2[0], y2[1]); w2.y = cvt_pk_bf16(y2[2], y2[3]);
                        bf16_t* kp = o2 + (size_t)r * 192 + 128 + i0;
#pragma unroll
                        for (int h = 0; h < 16; ++h) { *(u32x2*)(kp + (size_t)h * S * 192) = w1; *(u32x2*)(kp + (size_t)h * S * 192 + 32) = w2; } }
                }
            } else if (mode == EM_MLA_UQ) {
                if (u.pn < 8) {
#pragma unroll
                    for (int bj = 0; bj < 2; ++bj) { const int c = u.pn * 256 + bj * 128 + cw; st8(o0 + ((size_t)(c >> 7) * S + r) * 192 + (c & 127), acc[ai][bj][m][0] * rs, acc[ai][bj][m][1] * rs); }
                } else { const int head = 4 * (u.pn - 8) + wc;
#pragma unroll
                    for (int n = 0; n < 2; ++n) { const int i0 = 8 * fq + 4 * n;
                        const f32x4 c = *(const f32x4*)(cs + (size_t)r * 32 + i0), s = *(const f32x4*)(sn + (size_t)r * 32 + i0);
                        const f32x4 x1 = acc[ai][0][m][n] * rs, x2 = acc[ai][1][m][n] * rs;
                        bf16_t* qp = o0 + ((size_t)head * S + r) * 192 + 128 + i0;
                        st4(qp, x1 * c - x2 * s); st4(qp + 32, x1 * s + x2 * c); }
                }
            } else if (mode == EM_MLA_UKV) {
                st8(o0 + ((size_t)u.pn * S + r) * 192 + cw, acc[ai][0][m][0] * rs, acc[ai][0][m][1] * rs);
                st8(o1 + ((size_t)u.pn * S + r) * 128 + cw, acc[ai][1][m][0] * rs, acc[ai][1][m][1] * rs);
            } else if (mode == EM_RES) {
                float part = 0.f;
#pragma unroll
                for (int bj = 0; bj < 2; ++bj) { const int c = u.pn * 256 + bj * 128 + cw; bf16_t* bp = o0 + (size_t)r * 2048 + c;
                    f32x4 p0, p1;
                    if (xr) { const float* xq = xr + (size_t)r * 2048 + c; p0 = *(const f32x4*)xq; p1 = *(const f32x4*)(xq + 4); }
                    else { const u32x4 w = *(const u32x4*)bp;
                        p0 = (f32x4){__uint_as_float(w.x << 16), __uint_as_float(w.x & 0xffff0000u), __uint_as_float(w.y << 16), __uint_as_float(w.y & 0xffff0000u)};
                        p1 = (f32x4){__uint_as_float(w.z << 16), __uint_as_float(w.z & 0xffff0000u), __uint_as_float(w.w << 16), __uint_as_float(w.w & 0xffff0000u)}; }
                    const f32x4 x0 = p0 + acc[ai][bj][m][0], x1 = p1 + acc[ai][bj][m][1];
                    part += dot8(x0, x1); st8(bp, x0, x1); }
                part += __shfl_xor(part, 16); part += __shfl_xor(part, 32);
                if (fq == 0) exch[(ai * 128 + wr * 64 + m * 16 + fr) * 4 + wc] = part;
            } else if (mode == EM_HY_IN) {
#pragma unroll
                for (int bj = 0; bj < 2; ++bj)
#pragma unroll
                for (int n = 0; n < 2; ++n)
#pragma unroll
                for (int e = 0; e < 4; ++e) { const int c = u.pn * 256 + bj * 128 + cw + 4 * n + e; const float v = acc[ai][bj][m][n][e] * rs; o0[(size_t)c * S + r] = (bf16_t)(cvt_pk_bf16(v, v) & 0xffffu); }
            } else if (mode == EM_DIFF_QKV) {
                if (u.pn < 16) { bf16_t* dst = (u.pn < 8) ? o0 : o1; const int hc = 2 * (u.pn & 7) + (wc >> 1), ib = 32 * (wc & 1) + 8 * fq;
#pragma unroll
                    for (int n = 0; n < 2; ++n) { const int i0 = ib + 4 * n;
                        const f32x4 c = *(const f32x4*)(cs + (size_t)r * 64 + i0), s = *(const f32x4*)(sn + (size_t)r * 64 + i0);
                        const f32x4 x1 = acc[ai][0][m][n] * rs, x2 = acc[ai][1][m][n] * rs;
                        bf16_t* qp = dst + ((size_t)hc * S + r) * 128 + i0;
                        st4(qp, x1 * c - x2 * s); st4(qp + 64, x1 * s + x2 * c); }
                } else {
#pragma unroll
                    for (int bj = 0; bj < 2; ++bj) st8(o2 + ((size_t)(u.pn - 16) * S + r) * 256 + bj * 128 + cw, acc[ai][bj][m][0] * rs, acc[ai][bj][m][1] * rs);
                }
            } else {
                f32x4 hv[2];
#pragma unroll
                for (int n = 0; n < 2; ++n) { const f32x4 gg = acc[ai][0][m][n] * rs, uu = acc[ai][1][m][n] * rs;
#pragma unroll
                    for (int e = 0; e < 4; ++e) hv[n][e] = gg[e] * __builtin_amdgcn_rcpf(1.f + __expf(-gg[e])) * uu[e]; }
                st8(o0 + (size_t)r * FF + u.pn * 128 + cw, hv[0], hv[1]);
            }
        }
        if (mode == EM_RES || (mode == EM_MLA_IN && u.pn < 5)) {
            asm volatile("s_waitcnt lgkmcnt(0)" ::: "memory"); __builtin_amdgcn_s_barrier();
            const int t = ltid();
            if (t < 256) { const f32x4 p4 = *(const LAS f32x4*)(exch + t * 4); const float tot = (p4[0] + p4[1]) + (p4[2] + p4[3]);
                float* dst = (mode == EM_RES) ? (ssq_out + (size_t)u.pn * S) : ((u.pn < 3) ? (ssq_out + (size_t)u.pn * S) : (ssq_out2 + (size_t)(u.pn - 3) * S));
                dst[u.pm * 256 + t] = tot; }
        }
    }
};

#ifndef ATT192FN
#define ATT192FN attn_body192p
#endif
namespace att {
using bf16 = __hip_bfloat16;
constexpr int   D = 128, NW = 8, QBLK = 32, KVBLK = 64;
constexpr float THR = 8.f;
constexpr int SDEPTH = 2;
constexpr size_t SHM_V = KVBLK * D * 2, SHM_K = KVBLK * D * 2, SHM_ATTN = 2 * SHM_V + 2 * SHM_K + NW * 64 * 4;
using bf16x8 = __attribute__((ext_vector_type(8))) short;
using s16x4  = __attribute__((ext_vector_type(4))) short;
using f32x16 = __attribute__((ext_vector_type(16))) float;
using f32x8  = __attribute__((ext_vector_type(8))) float;
using u32x4  = __attribute__((ext_vector_type(4))) unsigned;
#define KSWZ(row, colB) ((row) * 256 + ((colB) ^ (((row) & 7) << 4)))
#define SBAR() __builtin_amdgcn_sched_barrier(0)
__device__ __forceinline__ int crow(int r, int hi) { return (r & 3) + 8 * (r >> 2) + 4 * hi; }
__device__ __forceinline__ unsigned cvtpk(float lo, float hi) {
  unsigned r; asm volatile("v_cvt_pk_bf16_f32 %0, %1, %2" : "=v"(r) : "v"(lo), "v"(hi)); return r;
}
template <typename TIn> struct Stage;
template <> struct Stage<bf16>  { using T = bf16x8;
  __device__ static __forceinline__ T ld8(const bf16* p) { return *reinterpret_cast<const bf16x8*>(p); }
  __device__ static __forceinline__ bf16x8 tobf(T x) { return x; } };
template <> struct Stage<float> { using T = f32x8;
  __device__ static __forceinline__ T ld8(const float* p) { return *reinterpret_cast<const f32x8*>(p); }
  __device__ static __forceinline__ bf16x8 tobf(T x) {
    u32x4 w = {cvtpk(x[0], x[1]), cvtpk(x[2], x[3]), cvtpk(x[4], x[5]), cvtpk(x[6], x[7])}; return *reinterpret_cast<bf16x8*>(&w); } };

template <int DK> __device__ __forceinline__ void partialSM(f32x16& p0, f32x16& p1, float& m_reg, float& mn, float& alpha) {
  constexpr float SCALE = (DK == 192) ? 0.07216878364870322f : 0.08838834764831845f;
  constexpr float C = SCALE * 1.4426950408889634f;
  float pmax = p0[0]; for (int r = 1; r < 16; ++r) pmax = fmaxf(pmax, p0[r]); for (int r = 0; r < 16; ++r) pmax = fmaxf(pmax, p1[r]);
  { auto rr = __builtin_amdgcn_permlane32_swap(__float_as_uint(pmax), __float_as_uint(pmax), false, false);
    pmax = fmaxf(__uint_as_float(rr[0]), __uint_as_float(rr[1])); }
  if (__builtin_expect(__all(pmax - m_reg <= THR / SCALE), 1)) { mn = m_reg; alpha = 1.f; }
  else { mn = fmaxf(m_reg, pmax); alpha = __builtin_amdgcn_exp2f((m_reg - mn) * C); m_reg = mn; }
  float mnC = -mn * C;
  for (int r = 0; r < 16; ++r) p0[r] = fmaf(p0[r], C, mnC); for (int r = 0; r < 16; ++r) p1[r] = fmaf(p1[r], C, mnC);
  for (int r = 0; r < 16; ++r) p0[r] = __builtin_amdgcn_exp2f(p0[r]);
}
__device__ __forceinline__ void finishSM(f32x16& p0, f32x16& p1, float alpha, float& l_reg, bf16x8& pa0, bf16x8& pa1, bf16x8& pa2, bf16x8& pa3) {
  for (int r = 0; r < 16; ++r) p1[r] = __builtin_amdgcn_exp2f(p1[r]);
  float ps = 0; for (int r = 0; r < 16; ++r) ps += p0[r]; for (int r = 0; r < 16; ++r) ps += p1[r];
  { auto rr = __builtin_amdgcn_permlane32_swap(__float_as_uint(ps), __float_as_uint(ps), false, false);
    ps = __uint_as_float(rr[0]) + __uint_as_float(rr[1]); }
  l_reg = l_reg * alpha + ps;
#define PK4(P, BASE, OUT) do { unsigned a0 = cvtpk(P[BASE + 0], P[BASE + 1]), a1 = cvtpk(P[BASE + 2], P[BASE + 3]);   \
    unsigned b0 = cvtpk(P[BASE + 4], P[BASE + 5]), b1 = cvtpk(P[BASE + 6], P[BASE + 7]);                              \
    auto r0 = __builtin_amdgcn_permlane32_swap(a0, b0, false, false); auto r1 = __builtin_amdgcn_permlane32_swap(a1, b1, false, false); \
    u32x4 w = {r0[0], r1[0], r0[1], r1[1]}; OUT = *reinterpret_cast<bf16x8*>(&w); } while (0)
  PK4(p0, 0, pa0); PK4(p0, 8, pa1); PK4(p1, 0, pa2); PK4(p1, 8, pa3);
#undef PK4
}
__device__ __forceinline__ void qkt(f32x16& p0, f32x16& p1, const bf16* Ks, const bf16x8* qr, int r32, int hi) {
  p0 = f32x16{}; p1 = f32x16{};
  for (int d0 = 0; d0 < 8; ++d0) { int cb = (d0 * 16 + hi * 8) * 2;
    bf16x8 b0 = *reinterpret_cast<const bf16x8*>((const char*)Ks + KSWZ(r32, cb));
    bf16x8 b1 = *reinterpret_cast<const bf16x8*>((const char*)Ks + KSWZ(32 + r32, cb));
    p0 = __builtin_amdgcn_mfma_f32_32x32x16_bf16(b0, qr[d0], p0, 0, 0, 0);
    p1 = __builtin_amdgcn_mfma_f32_32x32x16_bf16(b1, qr[d0], p1, 0, 0, 0); }
}
__device__ __forceinline__ int v_st(int k, int c) { const int kk = (k & ~0xC) | ((k & 4) << 1) | ((k & 8) >> 1); return ((kk >> 3) * 4 + (c >> 5)) * 512 + ((kk & 7) * 32 + (c & 31)) * 2; }
__device__ __forceinline__ int v_rd_base(int lane) { return ((lane & 3) << 3) | (((lane >> 2) & 3) << 6) | (((lane >> 4) & 1) << 5) | (((lane >> 5) & 1) << 8); }
constexpr int v_rd_off(int d0, int ks, int half) { return d0 * 512 + ks * 4096 + half * 2048; }
template <int OFF> __device__ __forceinline__ s16x4 tr_read(int vb) {
  s16x4 r; asm volatile("ds_read_b64_tr_b16 %0, %1 offset:%2" : "=&v"(r) : "v"(vb), "i"(OFF) : "memory"); return r;
}
template <int D0> __device__ __forceinline__ void pv_one(f32x16& od, int vb, bf16x8 pa0, bf16x8 pa1, bf16x8 pa2, bf16x8 pa3) {
  const s16x4 l0 = tr_read<v_rd_off(D0, 0, 0)>(vb), h0 = tr_read<v_rd_off(D0, 0, 1)>(vb), l1 = tr_read<v_rd_off(D0, 1, 0)>(vb), h1 = tr_read<v_rd_off(D0, 1, 1)>(vb);
  const s16x4 l2 = tr_read<v_rd_off(D0, 2, 0)>(vb), h2 = tr_read<v_rd_off(D0, 2, 1)>(vb), l3 = tr_read<v_rd_off(D0, 3, 0)>(vb), h3 = tr_read<v_rd_off(D0, 3, 1)>(vb);
  asm volatile("s_waitcnt lgkmcnt(0)" ::: "memory"); SBAR();
#define PK(L, H) (bf16x8){L[0], L[1], L[2], L[3], H[0], H[1], H[2], H[3]}
  od = __builtin_amdgcn_mfma_f32_32x32x16_bf16(pa0, PK(l0, h0), od, 0, 0, 0);
  od = __builtin_amdgcn_mfma_f32_32x32x16_bf16(pa1, PK(l1, h1), od, 0, 0, 0);
  od = __builtin_amdgcn_mfma_f32_32x32x16_bf16(pa2, PK(l2, h2), od, 0, 0, 0);
  od = __builtin_amdgcn_mfma_f32_32x32x16_bf16(pa3, PK(l3, h3), od, 0, 0, 0);
#undef PK
}
__device__ __forceinline__ void pv_d0(f32x16* o, int vb, bf16x8 pa0, bf16x8 pa1, bf16x8 pa2, bf16x8 pa3) {
  pv_one<0>(o[0], vb, pa0, pa1, pa2, pa3); pv_one<1>(o[1], vb, pa0, pa1, pa2, pa3); pv_one<2>(o[2], vb, pa0, pa1, pa2, pa3); pv_one<3>(o[3], vb, pa0, pa1, pa2, pa3);
}

template <typename TQ, int LDQ, int LDK, int LDV, int LDO>
__device__ __forceinline__ void attn_dense_body(const TQ* __restrict__ Qb, const bf16* __restrict__ Kh, const bf16* __restrict__ Vh,
                                                float* __restrict__ Ob, int seq, char* lds) {
  using St = Stage<bf16>; using SQ = Stage<TQ>;
  int tid_ = threadIdx.x; asm volatile("" : "+v"(tid_)); const int tid = tid_, wid = tid >> 6, lane = tid & 63, r32 = lane & 31, hi = lane >> 5;
  bf16* V_lds = (bf16*)lds; bf16* K_lds = (bf16*)(lds + 2 * SHM_V);
  float* ws = (float*)(lds + 2 * SHM_V + 2 * SHM_K) + wid * 64; float* li_l = ws; float* al_l = ws + 32;
  float m_reg = -1e30f, l_reg = 0; f32x16 o[4] = {}; bf16x8 qr[8];
  const TQ* Qw = Qb + (long)(wid * QBLK + r32) * LDQ + hi * 8;
#pragma unroll
  for (int d0 = 0; d0 < 8; ++d0) qr[d0] = SQ::tobf(SQ::ld8(Qw + d0 * 16));
  const int sr = tid >> 4, sc = (tid & 15) * 8, vst0 = v_st(sr, sc), vst1 = v_st(32 + sr, sc);
  const int vb0 = (int)(uintptr_t)V_lds + v_rd_base(lane);
  struct { typename St::T vs0, vs1, ks0, ks1; } sr_[SDEPTH];
#define SLOAD(i, k0) do { sr_[i].vs0 = St::ld8(&Vh[(long)((k0) + sr) * LDV + sc]); sr_[i].vs1 = St::ld8(&Vh[(long)((k0) + 32 + sr) * LDV + sc]); \
    sr_[i].ks0 = St::ld8(&Kh[(long)((k0) + sr) * LDK + sc]); sr_[i].ks1 = St::ld8(&Kh[(long)((k0) + 32 + sr) * LDK + sc]); } while (0)
#define SWRITE(b, i) do { *(bf16x8*)((char*)V_lds + (b) * SHM_V + vst0) = St::tobf(sr_[i].vs0);          \
    *(bf16x8*)((char*)V_lds + (b) * SHM_V + vst1) = St::tobf(sr_[i].vs1); int kc = sc * 2;               \
    *(bf16x8*)((char*)K_lds + (b) * SHM_K + KSWZ(sr, kc)) = St::tobf(sr_[i].ks0);                       \
    *(bf16x8*)((char*)K_lds + (b) * SHM_K + KSWZ(32 + sr, kc)) = St::tobf(sr_[i].ks1); } while (0)
#define SWAIT() do { if constexpr (SDEPTH == 2) asm volatile("s_waitcnt vmcnt(4)" ::: "memory"); else asm volatile("s_waitcnt vmcnt(0)" ::: "memory"); } while (0)
#define RESC(a) do { if (__any((a) < 1.f)) { if (hi == 0) al_l[r32] = (a); asm volatile("s_waitcnt lgkmcnt(0)" ::: "memory"); \
    for (int d = 0; d < 4; ++d) for (int r = 0; r < 16; ++r) o[d][r] *= al_l[crow(r, hi)]; } } while (0)
  f32x16 pA0, pA1, pB0, pB1; float mnA, mnB, alA, alB; bf16x8 pa0, pa1, pa2, pa3; const int NT = seq / KVBLK;
  constexpr int SE = 0, SO = SDEPTH - 1;
  SLOAD(SE, 0); asm volatile("s_waitcnt vmcnt(0)" ::: "memory"); SWRITE(0, SE); __syncthreads();
  qkt(pA0, pA1, K_lds, qr, r32, hi); partialSM<128>(pA0, pA1, m_reg, mnA, alA);
  SLOAD(SO, KVBLK); if constexpr (SDEPTH == 2) { if (2 < NT) SLOAD(SE, 2 * KVBLK); }
  SWAIT(); SWRITE(1, SO); __syncthreads();
  for (int j = 1; j + 1 < NT; j += 2) {
    SBAR(); qkt(pB0, pB1, (bf16*)((char*)K_lds + SHM_K), qr, r32, hi);
    finishSM(pA0, pA1, alA, l_reg, pa0, pa1, pa2, pa3); SBAR();
    SLOAD(SO, (j + SDEPTH) * KVBLK); SBAR();
    pv_d0(o, vb0, pa0, pa1, pa2, pa3); partialSM<128>(pB0, pB1, m_reg, mnB, alB);
    __syncthreads(); SWAIT(); SWRITE(0, SE);
    RESC(alB); __syncthreads();
    SBAR(); qkt(pA0, pA1, K_lds, qr, r32, hi);
    finishSM(pB0, pB1, alB, l_reg, pa0, pa1, pa2, pa3); SBAR();
    if (SDEPTH == 1 || j + 3 < NT) SLOAD(SE, (j + 1 + SDEPTH) * KVBLK); SBAR();
    pv_d0(o, vb0 + (int)SHM_V, pa0, pa1, pa2, pa3); partialSM<128>(pA0, pA1, m_reg, mnA, alA);
    __syncthreads(); SWAIT(); SWRITE(1, SO);
    RESC(alA); __syncthreads();
  }
  SBAR(); qkt(pB0, pB1, (bf16*)((char*)K_lds + SHM_K), qr, r32, hi);
  finishSM(pA0, pA1, alA, l_reg, pa0, pa1, pa2, pa3); SBAR();
  pv_d0(o, vb0, pa0, pa1, pa2, pa3); partialSM<128>(pB0, pB1, m_reg, mnB, alB);
  __syncthreads(); RESC(alB);
  finishSM(pB0, pB1, alB, l_reg, pa0, pa1, pa2, pa3); SBAR();
  pv_d0(o, vb0 + (int)SHM_V, pa0, pa1, pa2, pa3);
  if (hi == 0) li_l[r32] = l_reg; asm volatile("s_waitcnt lgkmcnt(0)" ::: "memory");
  float rli[16];
#pragma unroll
  for (int r = 0; r < 16; ++r) rli[r] = __builtin_amdgcn_rcpf(li_l[crow(r, hi)]);
  float* Ow = Ob + (long)(wid * QBLK) * LDO;
#pragma unroll
  for (int r = 0; r < 16; ++r) { int orow = crow(r, hi);
    for (int d0 = 0; d0 < 4; ++d0) Ow[(long)orow * LDO + d0 * 32 + r32] = o[d0][r] * rli[r]; }
#undef SLOAD
#undef SWRITE
#undef SWAIT
#undef RESC
}


#define KSWZ192(row, colB) ((row) * 384 + ((colB) ^ (((row) & 7) << 4)))
__device__ __forceinline__ void qkt192(f32x16& p0, f32x16& p1, const char* Ks, const bf16x8* qr, int r32, int hi) {
  p0 = f32x16{}; p1 = f32x16{};
#pragma unroll
  for (int d0 = 0; d0 < 12; ++d0) { const int cb = (d0 * 16 + hi * 8) * 2;
    bf16x8 b0 = *reinterpret_cast<const bf16x8*>(Ks + KSWZ192(r32, cb));
    bf16x8 b1 = *reinterpret_cast<const bf16x8*>(Ks + KSWZ192(32 + r32, cb));
    p0 = __builtin_amdgcn_mfma_f32_32x32x16_bf16(b0, qr[d0], p0, 0, 0, 0);
    p1 = __builtin_amdgcn_mfma_f32_32x32x16_bf16(b1, qr[d0], p1, 0, 0, 0); }
}
template <int LDQ, int LDK, int LDV, int LDO>
__device__ __forceinline__ void attn_body192(const unsigned short* __restrict__ Qb, const unsigned short* __restrict__ Kh, const unsigned short* __restrict__ Vh,
                                             unsigned short* __restrict__ Ob, int seq, char* lds) {
  constexpr size_t SV = 16384, SK = 24576;
  int tid_ = threadIdx.x; asm volatile("" : "+v"(tid_)); const int tid = tid_, wid = tid >> 6, lane = tid & 63, r32 = lane & 31, hi = lane >> 5;
  char* V_lds = lds; char* K_lds = lds + 2 * SV;
  float* ws = (float*)(lds + 2 * SV + 2 * SK) + wid * 64; float* li_l = ws; float* al_l = ws + 32;
  float m_reg = -1e30f, l_reg = 0; f32x16 o[4] = {}; bf16x8 qr[12];
  const unsigned short* Qw = Qb + (long)(wid * QBLK + r32) * LDQ + hi * 8;
#pragma unroll
  for (int d0 = 0; d0 < 12; ++d0) qr[d0] = *reinterpret_cast<const bf16x8*>(Qw + d0 * 16);
  const int sr = tid >> 4, sc = (tid & 15) * 8, vst0 = v_st(sr, sc), vst1 = v_st(32 + sr, sc);
  const unsigned voff0 = (unsigned)(sr * LDV + sc), voff1 = (unsigned)((32 + sr) * LDV + sc);
  unsigned koff[3]; int kst[3];
#pragma unroll
  for (int i = 0; i < 3; ++i) { const int q = tid + 512 * i; const int krow = q / 24, kcol = (q % 24) * 8; koff[i] = (unsigned)(krow * LDK + kcol); kst[i] = KSWZ192(krow, kcol * 2); }
  const int vb0 = (int)(uintptr_t)V_lds + v_rd_base(lane);
  bf16x8 vs0, vs1, ks[3];
#define LD192(k0) do { const unsigned short* vp_ = Vh + (size_t)(k0) * LDV; const unsigned short* kp_ = Kh + (size_t)(k0) * LDK; vs0 = *(const bf16x8*)(vp_ + voff0); vs1 = *(const bf16x8*)(vp_ + voff1); \
    _Pragma("unroll") for (int i_ = 0; i_ < 3; ++i_) ks[i_] = *(const bf16x8*)(kp_ + koff[i_]); } while (0)
#define WR192(b) do { *(bf16x8*)(V_lds + (b) * SV + vst0) = vs0; *(bf16x8*)(V_lds + (b) * SV + vst1) = vs1; \
    _Pragma("unroll") for (int i_ = 0; i_ < 3; ++i_) *(bf16x8*)(K_lds + (b) * SK + kst[i_]) = ks[i_]; } while (0)
  const int NT = seq / KVBLK;
  LD192(0); WR192(0); __syncthreads();
#pragma unroll 1
  for (int j = 0; j < NT; ++j) {
    const int b = j & 1;
    if (j + 1 < NT) LD192((j + 1) * KVBLK);
    f32x16 p0, p1; float mn, al; bf16x8 pa0, pa1, pa2, pa3;
    qkt192(p0, p1, K_lds + b * SK, qr, r32, hi);
    partialSM<192>(p0, p1, m_reg, mn, al);
    if (__any(al < 1.f)) { if (hi == 0) al_l[r32] = al; asm volatile("s_waitcnt lgkmcnt(0)" ::: "memory");
#pragma unroll
      for (int d = 0; d < 4; ++d)
#pragma unroll
        for (int r = 0; r < 16; ++r) o[d][r] *= al_l[crow(r, hi)]; }
    finishSM(p0, p1, al, l_reg, pa0, pa1, pa2, pa3); SBAR();
    pv_d0(o, vb0 + b * (int)SV, pa0, pa1, pa2, pa3);
    if (j + 1 < NT) WR192(b ^ 1);
    __syncthreads();
  }
  if (hi == 0) li_l[r32] = l_reg; asm volatile("s_waitcnt lgkmcnt(0)" ::: "memory");
  float rli[16];
#pragma unroll
  for (int r = 0; r < 16; ++r) rli[r] = __builtin_amdgcn_rcpf(li_l[crow(r, hi)]);
  unsigned short* Ow = Ob + (long)(wid * QBLK) * LDO;
#pragma unroll
  for (int r = 0; r < 16; ++r) { const int orow = crow(r, hi);
#pragma unroll
    for (int d0 = 0; d0 < 4; ++d0) { const float v = o[d0][r] * rli[r]; Ow[(long)orow * LDO + d0 * 32 + r32] = (unsigned short)(cvtpk(v, v) & 0xffffu); } }
  __syncthreads();
#undef LD192
#undef WR192
}
constexpr int NQR = 6;
__device__ __forceinline__ void qkt192p(f32x16& p0, f32x16& p1, const char* Ks, const bf16x8* qr, const char* Qr_lds, int r32, int hi) {
  p0 = f32x16{}; p1 = f32x16{};
#pragma unroll
  for (int d0 = 0; d0 < NQR; ++d0) { const int cb = (d0 * 16 + hi * 8) * 2;
    bf16x8 b0 = *reinterpret_cast<const bf16x8*>(Ks + KSWZ192(r32, cb));
    bf16x8 b1 = *reinterpret_cast<const bf16x8*>(Ks + KSWZ192(32 + r32, cb));
    p0 = __builtin_amdgcn_mfma_f32_32x32x16_bf16(b0, qr[d0], p0, 0, 0, 0);
    p1 = __builtin_amdgcn_mfma_f32_32x32x16_bf16(b1, qr[d0], p1, 0, 0, 0); }
#pragma unroll
  for (int d0 = NQR; d0 < 12; ++d0) { const int cb = (d0 * 16 + hi * 8) * 2;
    bf16x8 q = *reinterpret_cast<const bf16x8*>(Qr_lds + (d0 - NQR) * 1024);
    bf16x8 b0 = *reinterpret_cast<const bf16x8*>(Ks + KSWZ192(r32, cb));
    bf16x8 b1 = *reinterpret_cast<const bf16x8*>(Ks + KSWZ192(32 + r32, cb));
    p0 = __builtin_amdgcn_mfma_f32_32x32x16_bf16(b0, q, p0, 0, 0, 0);
    p1 = __builtin_amdgcn_mfma_f32_32x32x16_bf16(b1, q, p1, 0, 0, 0); }
}
template <int LDQ, int LDK, int LDV, int LDO>
__device__ __forceinline__ void attn_body192p(const unsigned short* __restrict__ Qb, const unsigned short* __restrict__ Kh, const unsigned short* __restrict__ Vh,
                                              unsigned short* __restrict__ Ob, int seq, char* lds) {
  constexpr size_t SV = 16384, SK = 24576;
  int tid_ = threadIdx.x; asm volatile("" : "+v"(tid_)); const int tid = tid_, wid = tid >> 6, lane = tid & 63, r32 = lane & 31, hi = lane >> 5;
  char* V_lds = lds; char* K_lds = lds + 2 * SV; const char* Qr_lds = lds + 2 * SV + 2 * SK + wid * ((12 - NQR) * 1024) + lane * 16;
  float* ws = (float*)(lds + 2 * SV + 2 * SK + 8 * (12 - NQR) * 1024) + wid * 64; float* li_l = ws; float* al_l = ws + 32;
  float m_reg = -1e30f, l_reg = 0; f32x16 o[4] = {}; bf16x8 qr[NQR];
  const unsigned short* Qw = Qb + (long)(wid * QBLK + r32) * LDQ + hi * 8;
#pragma unroll
  for (int d0 = 0; d0 < NQR; ++d0) qr[d0] = *reinterpret_cast<const bf16x8*>(Qw + d0 * 16);
#pragma unroll
  for (int d0 = NQR; d0 < 12; ++d0) *(bf16x8*)(const_cast<char*>(Qr_lds) + (d0 - NQR) * 1024) = *reinterpret_cast<const bf16x8*>(Qw + d0 * 16);
  const int sr = tid >> 4, sc = (tid & 15) * 8, vst0 = v_st(sr, sc), vst1 = v_st(32 + sr, sc);
  const unsigned voff0 = (unsigned)(sr * LDV + sc), voff1 = (unsigned)((32 + sr) * LDV + sc);
  const int kr0 = tid / 24, kc0 = (tid % 24) * 8, kr1 = (tid + 512) / 24, kc1 = ((tid + 512) % 24) * 8, kr2 = (tid + 1024) / 24, kc2 = ((tid + 1024) % 24) * 8;
  const unsigned koff0 = (unsigned)(kr0 * LDK + kc0), koff1 = (unsigned)(kr1 * LDK + kc1), koff2 = (unsigned)(kr2 * LDK + kc2);
  const int kst0 = KSWZ192(kr0, kc0 * 2), kst1 = KSWZ192(kr1, kc1 * 2), kst2 = KSWZ192(kr2, kc2 * 2);
  const int vb0 = (int)(uintptr_t)V_lds + v_rd_base(lane);
  struct { bf16x8 vs0, vs1, ks0, ks1, ks2; } sr_[1];
#define SLOADP(i, k0) do { const unsigned short* vp_ = Vh + (size_t)(k0) * LDV; const unsigned short* kp_ = Kh + (size_t)(k0) * LDK; \
    sr_[i].vs0 = *(const bf16x8*)(vp_ + voff0); sr_[i].vs1 = *(const bf16x8*)(vp_ + voff1); \
    sr_[i].ks0 = *(const bf16x8*)(kp_ + koff0); sr_[i].ks1 = *(const bf16x8*)(kp_ + koff1); sr_[i].ks2 = *(const bf16x8*)(kp_ + koff2); } while (0)
#define SWRITEP(b, i) do { *(bf16x8*)(V_lds + (b) * SV + vst0) = sr_[i].vs0; *(bf16x8*)(V_lds + (b) * SV + vst1) = sr_[i].vs1; \
    *(bf16x8*)(K_lds + (b) * SK + kst0) = sr_[i].ks0; *(bf16x8*)(K_lds + (b) * SK + kst1) = sr_[i].ks1; *(bf16x8*)(K_lds + (b) * SK + kst2) = sr_[i].ks2; } while (0)
#define SWAITP() asm volatile("s_waitcnt vmcnt(0)" ::: "memory")
#define RESCP(a) do { if (__any((a) < 1.f)) { if (hi == 0) al_l[r32] = (a); asm volatile("s_waitcnt lgkmcnt(0)" ::: "memory"); \
    _Pragma("unroll") for (int d = 0; d < 4; ++d) _Pragma("unroll") for (int r = 0; r < 16; ++r) o[d][r] *= al_l[crow(r, hi)]; } } while (0)
  f32x16 pA0, pA1, pB0, pB1; float mnA, mnB, alA, alB; bf16x8 pa0, pa1, pa2, pa3; const int NT = seq / KVBLK;
  constexpr int SE = 0, SO = 0;
  SLOADP(SE, 0); asm volatile("s_waitcnt vmcnt(0)" ::: "memory"); SWRITEP(0, SE); __syncthreads();
  qkt192p(pA0, pA1, K_lds, qr, Qr_lds, r32, hi); partialSM<192>(pA0, pA1, m_reg, mnA, alA);
  SLOADP(SO, KVBLK);
  SWAITP(); SWRITEP(1, SO); __syncthreads();
  for (int j = 1; j + 1 < NT; j += 2) {
    SBAR(); qkt192p(pB0, pB1, K_lds + SK, qr, Qr_lds, r32, hi);
    finishSM(pA0, pA1, alA, l_reg, pa0, pa1, pa2, pa3); SBAR();
    SLOADP(SO, (j + 1) * KVBLK); SBAR();
    pv_d0(o, vb0, pa0, pa1, pa2, pa3); partialSM<192>(pB0, pB1, m_reg, mnB, alB);
    __syncthreads(); SWAITP(); SWRITEP(0, SE);
    RESCP(alB); __syncthreads();
    SBAR(); qkt192p(pA0, pA1, K_lds, qr, Qr_lds, r32, hi);
    finishSM(pB0, pB1, alB, l_reg, pa0, pa1, pa2, pa3); SBAR();
    SLOADP(SE, (j + 2) * KVBLK); SBAR();
    pv_d0(o, vb0 + (int)SV, pa0, pa1, pa2, pa3); partialSM<192>(pA0, pA1, m_reg, mnA, alA);
    __syncthreads(); SWAITP(); SWRITEP(1, SO);
    RESCP(alA); __syncthreads();
  }
  SBAR(); qkt192p(pB0, pB1, K_lds + SK, qr, Qr_lds, r32, hi);
  finishSM(pA0, pA1, alA, l_reg, pa0, pa1, pa2, pa3); SBAR();
  pv_d0(o, vb0, pa0, pa1, pa2, pa3); partialSM<192>(pB0, pB1, m_reg, mnB, alB);
  __syncthreads(); RESCP(alB);
  finishSM(pB0, pB1, alB, l_reg, pa0, pa1, pa2, pa3); SBAR();
  pv_d0(o, vb0 + (int)SV, pa0, pa1, pa2, pa3);
  if (hi == 0) li_l[r32] = l_reg; asm volatile("s_waitcnt lgkmcnt(0)" ::: "memory");
  float rli[16];
#pragma unroll
  for (int r = 0; r < 16; ++r) rli[r] = __builtin_amdgcn_rcpf(li_l[crow(r, hi)]);
  unsigned short* Ow = Ob + (long)(wid * QBLK) * LDO;
#pragma unroll
  for (int r = 0; r < 16; ++r) { const int orow = crow(r, hi);
#pragma unroll
    for (int d0 = 0; d0 < 4; ++d0) { const float v = o[d0][r] * rli[r]; Ow[(long)orow * LDO + d0 * 32 + r32] = (unsigned short)(cvtpk(v, v) & 0xffffu); } }
  __syncthreads();
#undef SLOADP
#undef SWRITEP
#undef SWAITP
#undef RESCP
}
constexpr int NQR2 = 4;
__device__ __forceinline__ int v_st256(int k, int c) { const int kk = (k & ~0xC) | ((k & 4) << 1) | ((k & 8) >> 1); return ((kk >> 3) * 8 + (c >> 5)) * 512 + ((kk & 7) * 32 + (c & 31)) * 2; }
constexpr int v_rd_off256(int d0, int ks, int half) { return d0 * 512 + ks * 8192 + half * 4096; }
template <int D0> __device__ __forceinline__ void pv_one256(f32x16& od, int vb, bf16x8 pa0, bf16x8 pa1, bf16x8 pa2, bf16x8 pa3) {
  const s16x4 l0 = tr_read<v_rd_off256(D0, 0, 0)>(vb), h0 = tr_read<v_rd_off256(D0, 0, 1)>(vb), l1 = tr_read<v_rd_off256(D0, 1, 0)>(vb), h1 = tr_read<v_rd_off256(D0, 1, 1)>(vb);
  const s16x4 l2 = tr_read<v_rd_off256(D0, 2, 0)>(vb), h2 = tr_read<v_rd_off256(D0, 2, 1)>(vb), l3 = tr_read<v_rd_off256(D0, 3, 0)>(vb), h3 = tr_read<v_rd_off256(D0, 3, 1)>(vb);
  asm volatile("s_waitcnt lgkmcnt(0)" ::: "memory"); SBAR();
#define PK(L, H) (bf16x8){L[0], L[1], L[2], L[3], H[0], H[1], H[2], H[3]}
  od = __builtin_amdgcn_mfma_f32_32x32x16_bf16(pa0, PK(l0, h0), od, 0, 0, 0);
  od = __builtin_amdgcn_mfma_f32_32x32x16_bf16(pa1, PK(l1, h1), od, 0, 0, 0);
  od = __builtin_amdgcn_mfma_f32_32x32x16_bf16(pa2, PK(l2, h2), od, 0, 0, 0);
  od = __builtin_amdgcn_mfma_f32_32x32x16_bf16(pa3, PK(l3, h3), od, 0, 0, 0);
#undef PK
}
__device__ __forceinline__ void qkt128q(f32x16& p0, f32x16& p1, const char* Ks, const bf16x8* qr, const char* Qr_lds, int r32, int hi) {
  p0 = f32x16{}; p1 = f32x16{};
#pragma unroll
  for (int d0 = 0; d0 < 8; ++d0) { const int cb = (d0 * 16 + hi * 8) * 2;
    bf16x8 q; if (d0 < NQR2) q = qr[d0 < NQR2 ? d0 : 0]; else q = *reinterpret_cast<const bf16x8*>(Qr_lds + (d0 - NQR2) * 1024);
    bf16x8 b0 = *reinterpret_cast<const bf16x8*>(Ks + KSWZ(r32, cb));
    bf16x8 b1 = *reinterpret_cast<const bf16x8*>(Ks + KSWZ(32 + r32, cb));
    p0 = __builtin_amdgcn_mfma_f32_32x32x16_bf16(b0, q, p0, 0, 0, 0);
    p1 = __builtin_amdgcn_mfma_f32_32x32x16_bf16(b1, q, p1, 0, 0, 0); }
}
template <int LDQ, int LDK, int LDV, int LDO>
__device__ __forceinline__ void attn_body_dv256(const unsigned short* __restrict__ Qb, const unsigned short* __restrict__ Kh, const unsigned short* __restrict__ Vh,
                                                unsigned short* __restrict__ Of, int seq, char* lds) {
  constexpr size_t SV = 32768, SK = 16384;
  int tid_ = threadIdx.x; asm volatile("" : "+v"(tid_)); const int tid = tid_, wid = tid >> 6, lane = tid & 63, r32 = lane & 31, hi = lane >> 5;
  char* V_lds = lds; char* K_lds = lds + 2 * SV; const char* Qr_lds = lds + 2 * SV + 2 * SK + wid * ((8 - NQR2) * 1024) + lane * 16;
  float* ws = (float*)(lds + 2 * SV + 2 * SK + 8 * (8 - NQR2) * 1024) + wid * 64; float* li_l = ws; float* al_l = ws + 32;
  float m_reg = -1e30f, l_reg = 0; f32x16 o[8] = {}; bf16x8 qr[NQR2];
  const unsigned short* Qw = Qb + (long)(wid * QBLK + r32) * LDQ + hi * 8;
#pragma unroll
  for (int d0 = 0; d0 < NQR2; ++d0) qr[d0] = *reinterpret_cast<const bf16x8*>(Qw + d0 * 16);
#pragma unroll
  for (int d0 = NQR2; d0 < 8; ++d0) *(bf16x8*)(const_cast<char*>(Qr_lds) + (d0 - NQR2) * 1024) = *reinterpret_cast<const bf16x8*>(Qw + d0 * 16);
  const int sr = tid >> 4, sc = (tid & 15) * 8; const int kst0 = KSWZ(sr, sc * 2), kst1 = KSWZ(32 + sr, sc * 2);
  const unsigned koff0 = (unsigned)(sr * LDK + sc), koff1 = (unsigned)((32 + sr) * LDK + sc);
  const int vr = tid >> 5, vc = (tid & 31) * 8;
  const unsigned voff = (unsigned)(vr * LDV + vc);
  const int vst0 = v_st256(vr, vc);
  const int vb0 = (int)(uintptr_t)V_lds + v_rd_base(lane);
  bf16x8 vs[4], ks0, ks1;
#define LD256(k0) do { const unsigned short* vp_ = Vh + (size_t)(k0) * LDV; const unsigned short* kp_ = Kh + (size_t)(k0) * LDK; \
    _Pragma("unroll") for (int i_ = 0; i_ < 4; ++i_) vs[i_] = *(const bf16x8*)(vp_ + voff + (unsigned)(16 * i_ * LDV)); \
    ks0 = *(const bf16x8*)(kp_ + koff0); ks1 = *(const bf16x8*)(kp_ + koff1); } while (0)
#define WR256(b) do { _Pragma("unroll") for (int i_ = 0; i_ < 4; ++i_) *(bf16x8*)(V_lds + (b) * SV + vst0 + i_ * 8192) = vs[i_]; \
    *(bf16x8*)(K_lds + (b) * SK + kst0) = ks0; *(bf16x8*)(K_lds + (b) * SK + kst1) = ks1; } while (0)
  const int NT = seq / KVBLK;
  LD256(0); WR256(0); __syncthreads();
#pragma unroll 1
  for (int j = 0; j < NT; ++j) {
    const int b = j & 1;
    if (j + 1 < NT) LD256((j + 1) * KVBLK);
    f32x16 p0, p1; float mn, al; bf16x8 pa0, pa1, pa2, pa3;
    qkt128q(p0, p1, K_lds + b * SK, qr, Qr_lds, r32, hi);
    partialSM<128>(p0, p1, m_reg, mn, al);
    if (__any(al < 1.f)) { if (hi == 0) al_l[r32] = al; asm volatile("s_waitcnt lgkmcnt(0)" ::: "memory");
#pragma unroll
      for (int d = 0; d < 8; ++d)
#pragma unroll
        for (int r = 0; r < 16; ++r) o[d][r] *= al_l[crow(r, hi)]; }
    finishSM(p0, p1, al, l_reg, pa0, pa1, pa2, pa3); SBAR();
    const int vb = vb0 + b * (int)SV;
    pv_one256<0>(o[0], vb, pa0, pa1, pa2, pa3); pv_one256<1>(o[1], vb, pa0, pa1, pa2, pa3); pv_one256<2>(o[2], vb, pa0, pa1, pa2, pa3); pv_one256<3>(o[3], vb, pa0, pa1, pa2, pa3);
    pv_one256<4>(o[4], vb, pa0, pa1, pa2, pa3); pv_one256<5>(o[5], vb, pa0, pa1, pa2, pa3); pv_one256<6>(o[6], vb, pa0, pa1, pa2, pa3); pv_one256<7>(o[7], vb, pa0, pa1, pa2, pa3);
    if (j + 1 < NT) WR256(b ^ 1);
    __syncthreads();
  }
  if (hi == 0) li_l[r32] = l_reg; asm volatile("s_waitcnt lgkmcnt(0)" ::: "memory");
  float rli[16];
#pragma unroll
  for (int r = 0; r < 16; ++r) rli[r] = __builtin_amdgcn_rcpf(li_l[crow(r, hi)]);
  unsigned short* Ow = Of + (long)(wid * QBLK) * LDO;
#pragma unroll
  for (int r = 0; r < 16; ++r) { const int orow = crow(r, hi);
#pragma unroll
    for (int d0 = 0; d0 < 8; ++d0) { const float v = o[d0][r] * rli[r]; Ow[(long)orow * LDO + d0 * 32 + r32] = (unsigned short)(cvtpk(v, v) & 0xffffu); } }
  __syncthreads();
#undef LD256
#undef WR256
}
}

enum { MAP_ID = 0, MAP_MLA_IN = 1, MAP_UQ = 2, MAP_DQKV = 3, MAP_GATE = 4, MAP_UP = 5 };
__device__ __forceinline__ int dmap(int kind, int n) {
    switch (kind) {
        case MAP_MLA_IN: return (n < 1312) ? n : (1408 + (n - 1312));
        case MAP_UQ: { const int head = n / 192, d = n % 192; if (d < 128) return head * 128 + d; const int r = d - 128, bj = r >> 5, i = r & 31; return 2048 + (head >> 2) * 256 + bj * 128 + (head & 3) * 32 + i; }
        case MAP_DQKV: { if (n >= 4096) return n; const int base = n & ~255, r = n & 255, blk = r >> 7, d = r & 127, bj = d >> 6, i = d & 63; return base + bj * 128 + blk * 64 + i; }
        case MAP_GATE: return (n >> 7) * 256 + (n & 127);
        case MAP_UP: return (n >> 7) * 256 + 128 + (n & 127);
        default: return n;
    }
}
__device__ __forceinline__ void cvt_item(const float* W, int K, int N, const float* g, bf16_t* WT, int kind, LAS float* scr, int item, int lane) {
    const int nblk = N / 32, kb = item / nblk, nb = item % nblk, k0 = 64 * kb, n0 = 32 * nb;
#pragma unroll 8
    for (int i = 0; i < 32; ++i) { const int kk = 2 * i + (lane >> 5); scr[kk * 33 + (lane & 31)] = W[(size_t)(k0 + kk) * N + n0 + (lane & 31)]; }
    LDS_WAIT(); asm volatile("" ::: "memory");
    const int c = lane & 7; const int drow0 = dmap(kind, n0);
    float gv[8];
#pragma unroll
    for (int e = 0; e < 8; ++e) gv[e] = g ? g[k0 + 8 * c + e] : 1.f;
#pragma unroll
    for (int j = 0; j < 4; ++j) { const int n = (lane >> 3) + 8 * j; const LAS float* s = scr + (8 * c) * 33 + n;
        u32x4 o; o.x = cvt_pk_bf16(s[0 * 33] * gv[0], s[1 * 33] * gv[1]); o.y = cvt_pk_bf16(s[2 * 33] * gv[2], s[3 * 33] * gv[3]);
        o.z = cvt_pk_bf16(s[4 * 33] * gv[4], s[5 * 33] * gv[5]); o.w = cvt_pk_bf16(s[6 * 33] * gv[6], s[7 * 33] * gv[7]);
        *(u32x4*)(WT + (size_t)(drow0 + n) * K + k0 + 8 * c) = o; }
    LDS_WAIT(); asm volatile("" ::: "memory");
}

__device__ __forceinline__ void cvt_gate_tail(const float* Wg, const float* g, bf16_t* WT, LAS float* scr, int gw, int NGW, int lane) {
    constexpr int NIT = (2048 / 64) * (5632 / 32);
#pragma unroll 1
    for (int it = gw; it < NIT; it += NGW) cvt_item(Wg, 2048, 5632, g, WT, MAP_GATE, scr, it, lane);
}

constexpr int FN = 16384, FNLOG = 14;
#define FP(i) ((i) + (((i) >> 5) << 2))
__device__ __forceinline__ f32x2 cmul(f32x2 a, f32x2 b) { return (f32x2){a.x * b.x - a.y * b.y, a.x * b.y + a.y * b.x}; }
__device__ __forceinline__ f32x2 twiddle(int idx, int M, float sign) {
    const float rev = (float)idx / (float)M;
    return (f32x2){__builtin_amdgcn_cosf(rev), sign * __builtin_amdgcn_sinf(rev)};
}
__device__ __forceinline__ f32x2 rot16(f32x2 v, int jj, float sgn) {
    const float h = 0.70710678118654752f, c1 = 0.92387953251128674f, s1 = 0.38268343236508977f;
    float c, s;
    switch (jj & 7) {
        case 0: return v;
        case 1: c = c1; s = s1; break;
        case 2: c = h; s = h; break;
        case 3: c = s1; s = c1; break;
        case 4: return (f32x2){-sgn * v.y, sgn * v.x};
        case 5: c = -s1; s = c1; break;
        case 6: c = -h; s = h; break;
        default: c = -c1; s = s1; break;
    }
    s *= sgn;
    return (f32x2){v.x * c - v.y * s, v.x * s + v.y * c};
}
#define FADDR(j) ((ls >= 5) ? (a0 + (j) * ps) : (a0 + (j) * s + (((low + (j) * s) >> 5) << 2)))
template <int R> __device__ __forceinline__ void fft_dif_pass(LAS f32x2* L, int ls  , int tid) {
    const int s = 1 << ls; const int ps = (ls >= 5) ? FP(s) : s;
#pragma unroll 1
    for (int g = tid; g < (FN >> R); g += 512) {
        const int low = g & (s - 1); const int i0 = ((g - low) << R) | low; const int a0 = FP(i0);
        f32x2 e[1 << R];
#pragma unroll
        for (int j = 0; j < (1 << R); ++j) e[j] = L[FADDR(j)];
        f32x2 wq[4];
        if (R == 4) { wq[3] = twiddle(low, 16 * s, -1.f); wq[2] = cmul(wq[3], wq[3]); wq[1] = cmul(wq[2], wq[2]); wq[0] = cmul(wq[1], wq[1]); }
#pragma unroll
        for (int q = R - 1; q >= 0; --q) {
            const int sp = 1 << q;
#pragma unroll
            for (int j = 0; j < (1 << R); ++j) if ((j & sp) == 0) {
                const f32x2 a = e[j], b = e[j + sp];
                e[j] = a + b;
                f32x2 d = a - b; const int jj = j & (sp - 1);
                if (R == 4) d = cmul(d, wq[q]);
                e[j + sp] = rot16(d, jj * (8 >> q), -1.f);
            }
        }
#pragma unroll
        for (int j = 0; j < (1 << R); ++j) L[FADDR(j)] = e[j];
    }
}
template <int R> __device__ __forceinline__ void fft_dit_pass(LAS f32x2* L, int ls, int tid) {
    const int s = 1 << ls; const int ps = (ls >= 5) ? FP(s) : s;
#pragma unroll 1
    for (int g = tid; g < (FN >> R); g += 512) {
        const int low = g & (s - 1); const int i0 = ((g - low) << R) | low; const int a0 = FP(i0);
        f32x2 e[1 << R];
#pragma unroll
        for (int j = 0; j < (1 << R); ++j) e[j] = L[FADDR(j)];
        f32x2 wq[4];
        if (R == 4) { wq[3] = twiddle(low, 16 * s, 1.f); wq[2] = cmul(wq[3], wq[3]); wq[1] = cmul(wq[2], wq[2]); wq[0] = cmul(wq[1], wq[1]); }
#pragma unroll
        for (int q = 0; q < R; ++q) {
            const int sp = 1 << q;
#pragma unroll
            for (int j = 0; j < (1 << R); ++j) if ((j & sp) == 0) {
                const int jj = j & (sp - 1);
                f32x2 b = e[j + sp];
                if (R == 4) b = cmul(b, wq[q]);
                b = rot16(b, jj * (8 >> q), 1.f);
                const f32x2 a = e[j];
                e[j] = a + b; e[j + sp] = a - b;
            }
        }
#pragma unroll
        for (int j = 0; j < (1 << R); ++j) L[FADDR(j)] = e[j];
    }
}
__device__ __forceinline__ void fft_fwd(LAS f32x2* L, int tid) {
    __syncthreads();
    fft_dif_pass<4>(L, 10, tid); __syncthreads();
    fft_dif_pass<4>(L, 6, tid); __syncthreads();
    fft_dif_pass<4>(L, 2, tid); __syncthreads();
    fft_dif_pass<2>(L, 0, tid); __syncthreads();
}
__device__ __forceinline__ void fft_inv(LAS f32x2* L, int tid) {
    __syncthreads();
    fft_dit_pass<2>(L, 0, tid); __syncthreads();
    fft_dit_pass<4>(L, 2, tid); __syncthreads();
    fft_dit_pass<4>(L, 6, tid); __syncthreads();
    fft_dit_pass<4>(L, 10, tid); __syncthreads();
}
__device__ __forceinline__ int brev14(int p) { return (int)(__builtin_bitreverse32((unsigned)p) >> 18); }
__device__ __forceinline__ float block_sum(float v, LAS float* red, int tid) {
    v = wave_sum(v);
    __syncthreads();
    if ((tid & 63) == 0) red[tid >> 6] = v;
    __syncthreads();
    float t = 0.f;
#pragma unroll
    for (int i = 0; i < 8; ++i) t += red[i];
    return t;
}
__device__ __forceinline__ f32x2 unpk_bf2(unsigned w) { return (f32x2){__uint_as_float(w << 16), __uint_as_float(w & 0xffff0000u)}; }
__device__ __forceinline__ void spec_mul(LAS f32x2* L, const unsigned* Kp, int tid) {
#pragma unroll 2
    for (int p = tid; p < FN; p += 512) {
        const int k = brev14(p), k2 = (FN - k) & (FN - 1), p2 = brev14(k2);
        if (p > p2) continue;
        const f32x2 z1 = L[FP(p)], z2 = L[FP(p2)], g1 = unpk_bf2(Kp[p]), g2 = unpk_bf2(Kp[p2]);
        const f32x2 ka = (f32x2){0.5f * (g1.x + g2.x), 0.5f * (g1.y - g2.y)};
        const f32x2 kb = (f32x2){0.5f * (g1.y + g2.y), -0.5f * (g1.x - g2.x)};
        const f32x2 P = (ka + kb) * 0.5f, M = (ka - kb) * 0.5f;
        const f32x2 z2c = (f32x2){z2.x, -z2.y}, z1c = (f32x2){z1.x, -z1.y};
        const f32x2 y1 = cmul(z1, P) + cmul(z2c, M);
        const f32x2 Pc = (f32x2){P.x, -P.y}, Mc = (f32x2){M.x, -M.y};
        const f32x2 y2 = cmul(z2, Pc) + cmul(z1c, Mc);
        L[FP(p)] = y1; if (p2 != p) L[FP(p2)] = y2;
    }
}

#define XB_TMO      128
#define XB_XCNT(j)  (256  + 64 * (j))
#define XB_XSUB(j)  (1280 + 64 * (j))
#define XB_XGEN(j)  (2304 + 64 * (j))
#define XB_TOP      3328
#define XB_TOPGEN   3392
#define XCD_BAR_WORDS 3456
#define XB_SPIN_CAP (1u << 18)
__device__ __forceinline__ unsigned xb_ld(unsigned* p)              { return __hip_atomic_load(p, __ATOMIC_RELAXED, __HIP_MEMORY_SCOPE_AGENT); }
__device__ __forceinline__ unsigned xb_add(unsigned* p, unsigned v) { return __hip_atomic_fetch_add(p, v, __ATOMIC_RELAXED, __HIP_MEMORY_SCOPE_AGENT); }
__device__ __forceinline__ unsigned xb_xcc_id() { return (unsigned)__builtin_amdgcn_s_getreg((3 << 11) | 20) & 0xFu; }
#define XB_SPIN(cond, bar) do { unsigned _sp = 0; while (cond) { __builtin_amdgcn_s_sleep(1); \
    if ((++_sp & 255u) == 0u) { if (xb_ld(&(bar)[XB_TMO])) break; if (_sp > XB_SPIN_CAP) { atomicAdd(&(bar)[XB_TMO], 1u); break; } } } } while (0)
struct XcdBarrier { unsigned* bar; unsigned x; volatile LAS unsigned* st; };
__device__ __forceinline__ XcdBarrier xcd_barrier_post(unsigned* bar, volatile LAS unsigned* st) {
    XcdBarrier b; b.bar = bar; b.x = xb_xcc_id(); b.st = st;
    if (threadIdx.x == 0) (void)xb_add(&bar[XB_XCNT(b.x)], 1u);
    return b;
}
__device__ __forceinline__ void xcd_barrier_complete(unsigned* bar, unsigned x, unsigned& nloc, unsigned& nx) {
    const unsigned G = gridDim.x * gridDim.y * gridDim.z;
    unsigned sum, cnt, mine, sp = 0u;
    for (;;) {
        sum = 0u; cnt = 0u; mine = 0u;
#pragma unroll
        for (unsigned j = 0; j < 16; ++j) { const unsigned c = xb_ld(&bar[XB_XCNT(j)]); sum += c; cnt += (c > 0u) ? 1u : 0u; mine = (j == x) ? c : mine; }
        if (sum == G) break;
        __builtin_amdgcn_s_sleep(1);
        if ((++sp & 255u) == 0u) { if (xb_ld(&bar[XB_TMO])) break; if (sp > XB_SPIN_CAP) { atomicAdd(&bar[XB_TMO], 1u); break; } }
    }
    nloc = mine > 0u ? mine : 1u; nx = cnt > 0u ? cnt : 1u;
}
__device__ __forceinline__ void xcd_barrier(const XcdBarrier& b) {
    asm volatile("s_waitcnt vmcnt(0)" ::: "memory");
    __syncthreads();
    if (threadIdx.x == 0) {
        unsigned* bar = b.bar;
        __builtin_amdgcn_s_waitcnt(0);
        unsigned nloc = b.st[0], nx = b.st[1];
        if (nloc == 0u) { xcd_barrier_complete(bar, b.x, nloc, nx); b.st[0] = nloc; b.st[1] = nx; }
        const unsigned old = xb_add(&bar[XB_XSUB(b.x)], 1u);
        const unsigned gen = old / nloc;
        if (old + 1u == (gen + 1u) * nloc) {
            __builtin_amdgcn_fence(__ATOMIC_RELEASE, "agent");
            asm volatile("s_waitcnt vmcnt(0)" ::: "memory");
            const unsigned og = xb_add(&bar[XB_TOP], 1u);
            const unsigned tg = og / nx;
            if (og + 1u == (tg + 1u) * nx) xb_add(&bar[XB_TOPGEN], 1u);
            else XB_SPIN(xb_ld(&bar[XB_TOPGEN]) == tg, bar);
            __builtin_amdgcn_fence(__ATOMIC_ACQUIRE, "agent");
            xb_add(&bar[XB_XGEN(b.x)], 1u);
            asm volatile("s_waitcnt vmcnt(0)" ::: "memory");
        } else {
            XB_SPIN(xb_ld(&bar[XB_XGEN(b.x)]) == gen, bar);
            __builtin_amdgcn_fence(__ATOMIC_ACQUIRE, "agent");
            asm volatile("s_waitcnt vmcnt(0)" ::: "memory");
        }
    }
    __syncthreads();
}

#define T_NONE 0
#define T_P0 1
#define T_GEMM 2
#define T_AMLA 3
#define T_ADIFF 4
#define T_HY 5
#define T_TR 6
#define T_FINAL 7
constexpr int N_PHASES = 1 + 4 * 7 + 1;
__host__ __device__ __forceinline__ int layer_kind(int layer) { return layer == 1 ? 1 : (layer == 2 ? 2 : 0); }
__host__ __device__ __forceinline__ int phase_type(int ph, bool& sync_after) {
    sync_after = true;
    if (ph == 0) return T_P0;
    if (ph == N_PHASES - 1) { sync_after = false; return T_FINAL; }
    const int layer = (ph - 1) / 7, slot = (ph - 1) % 7, kind = layer_kind(layer);
    if (slot == 0 || slot >= 4) return T_GEMM;
    if (kind == 0) { if (slot == 1) { sync_after = false; return T_GEMM; } if (slot == 2) return T_GEMM; return T_AMLA; }
    if (kind == 1) { if (slot == 1) return T_HY; if (slot == 2) return T_TR; sync_after = false; return T_NONE; }
    if (slot == 1) return T_ADIFF; sync_after = false; return T_NONE;
}

struct Ctx {
    unsigned char* ws; bf16_t* WB; bf16_t* XB; bf16_t* AO; float* SSQ; float* MC; float* MS; float* DC; float* DS; float* H3; float* X;
};
__device__ __forceinline__ Ctx make_ctx(KA& a) {
    Ctx c; c.ws = a.ws; c.WB = (bf16_t*)(a.ws + WS_W); c.XB = (bf16_t*)(a.ws + WS_XB); c.AO = (bf16_t*)(a.ws + WS_AO); c.SSQ = (float*)(a.ws + WS_SSQ);
    c.MC = (float*)(a.ws + WS_MC); c.MS = (float*)(a.ws + WS_MS); c.DC = (float*)(a.ws + WS_DC); c.DS = (float*)(a.ws + WS_DS); c.H3 = (float*)(a.ws + WS_H3); c.X = a.out; return c;
}

__device__ __forceinline__ void phase_p0(KA& a, LAS unsigned char* lds) {
    const Ctx c = make_ctx(a);
    const int tid = ltid(), lane = tid & 63, wave = __builtin_amdgcn_readfirstlane(tid >> 6);
    const int G = gridDim.x, bx = lbid(), gw = bx * 8 + wave, NGW = G * 8, gt = bx * 512 + tid, NGT = G * 512;
    bf16_t* WB = c.WB; float* SSQ = c.SSQ;
    for (int i = gt; i < 13 * 8 * S - S; i += NGT) SSQ[S + i] = 0.f;
    LAS float* scr = (LAS float*)(lds + wave * 16384);
#define CJ(src, K_, N_, gptr, off_, kind_) do { const float* W = a.in[src]; const float* g = gptr; const int nitems = ((K_) / 64) * ((N_) / 32); \
        _Pragma("unroll 1") for (int it = gw; it < nitems; it += NGW) cvt_item(W, K_, N_, g, WB + (off_), kind_, scr, it, lane); } while (0)
    CJ(2, 2048, 1344, a.in[1], W0_IN, MAP_MLA_IN); CJ(4, 768, 3072, a.in[3], W0_UQ, MAP_UQ); CJ(6, 512, 4096, a.in[5], W0_UKV, MAP_ID); CJ(7, 2048, 2048, nullptr, W0_O, MAP_ID);
    CJ(9, 2048, 5632, a.in[8], W0_GU, MAP_GATE); CJ(10, 2048, 5632, a.in[8], W0_GU, MAP_UP); CJ(11, 5632, 2048, nullptr, W0_DN, MAP_ID);
    CJ(13, 2048, 6144, a.in[12], W1_IN, MAP_ID); CJ(25, 2048, 2048, nullptr, W1_O, MAP_ID);
    CJ(28, 2048, 5632, a.in[26], W1_GU, MAP_UP); CJ(29, 5632, 2048, nullptr, W1_DN, MAP_ID);
    CJ(31, 2048, 6144, a.in[30], W2_IN, MAP_DQKV); CJ(37, 2048, 2048, nullptr, W2_O, MAP_ID);
    CJ(40, 2048, 5632, a.in[38], W2_GU, MAP_UP); CJ(41, 5632, 2048, nullptr, W2_DN, MAP_ID);
    CJ(43, 2048, 1344, a.in[42], W3_IN, MAP_MLA_IN); CJ(45, 768, 3072, a.in[44], W3_UQ, MAP_UQ); CJ(47, 512, 4096, a.in[46], W3_UKV, MAP_ID); CJ(48, 2048, 2048, nullptr, W3_O, MAP_ID);
    CJ(51, 2048, 5632, a.in[49], W3_GU, MAP_UP); CJ(52, 5632, 2048, nullptr, W3_DN, MAP_ID);
#undef CJ
    for (int i = gt; i < 2 * 192 * 256; i += NGT) {
        const int mtx = i / (192 * 256), rem = i % (192 * 256), rr = rem / 256, ch = rem % 256;
        const int row = rr < 96 ? 1312 + rr : 1440 + (rr - 96);
        *(u32x4*)(WB + (mtx ? W3_IN : W0_IN) + (size_t)row * 2048 + ch * 8) = (u32x4){0u, 0u, 0u, 0u};
    }
#pragma unroll 1
    for (int r = gw; r < S; r += NGW) {
        const f32x4* xr = (const f32x4*)(a.in[0] + (size_t)r * D) + lane; f32x4* xo = (f32x4*)(c.X + (size_t)r * D) + lane;
        u32x2* xb = (u32x2*)(c.XB + (size_t)r * D) + lane; float s2 = 0.f;
#pragma unroll
        for (int j = 0; j < 8; ++j) { const f32x4 v = xr[64 * j]; s2 += (v.x * v.x + v.y * v.y) + (v.z * v.z + v.w * v.w);
            u32x2 w; w.x = cvt_pk_bf16(v.x, v.y); w.y = cvt_pk_bf16(v.z, v.w); xb[64 * j] = w; }
        s2 = wave_sum(s2); if (lane == 0) SSQ[r] = s2;
    }
#pragma unroll 1
    for (int i = gt; i < S * 32; i += NGT) { const int pos = i >> 5, f = i & 31;
        const float inv = (float)exp(-9.210340371976184 * ((double)(2 * f) / 64.0)); const float ang = (float)pos * inv;
        float s, cc; sincos_acc(ang, s, cc); c.MC[i] = cc; c.MS[i] = s; }
#pragma unroll 1
    for (int i = gt; i < S * 64; i += NGT) { const int pos = i >> 6, f = i & 63;
        const float inv = (float)exp(-9.210340371976184 * ((double)(2 * f) / 128.0)); const float ang = (float)pos * inv;
        float s, cc; sincos_acc(ang, s, cc); c.DC[i] = cc; c.DS[i] = s; }
    {
        LAS float* hs = (LAS float*)(lds + 131072 + wave * 1024);
        const float* W1 = a.in[16]; const float* b1 = a.in[17]; const float* fr = a.in[18]; const float* W2 = a.in[19]; const float* b2 = a.in[20];
        const float* W3 = a.in[21]; const float* b3 = a.in[22];
#pragma unroll 1
        for (int l = gw; l < S; l += NGW) {
            asm volatile("" ::: "memory");
            const float fq = fr[lane];
            const float t = (float)l * (1.0f / 8191.0f); const float w = 6.283185307179586f * (float)l / 8192.0f;
            if (lane < 33) { float z;
                if (lane == 0) z = t;
                else { const int k = (lane - 1) & 15; const float f = 1e-4f + (float)k * ((15.0f - 1e-4f) / 15.0f); float s, cc; sincos_acc(f * w, s, cc); z = (lane <= 16) ? cc : -s; }
                hs[lane] = z; }
            LDS_WAIT();
            float acc = 0.f;
#pragma unroll 3
            for (int k = 0; k < 33; ++k) acc = fmaf(hs[k], W1[k * 64 + lane], acc);
            float h = sin_acc(fq * (acc + b1[lane])); hs[64 + lane] = h; LDS_WAIT();
            acc = 0.f;
#pragma unroll 4
            for (int k = 0; k < 64; ++k) acc = fmaf(hs[64 + k], W2[k * 64 + lane], acc);
            h = sin_acc(fq * (acc + b2[lane])); hs[128 + lane] = h; LDS_WAIT();
            acc = 0.f;
#pragma unroll 4
            for (int k = 0; k < 64; ++k) acc = fmaf(hs[128 + k], W3[k * 64 + lane], acc);
            h = sin_acc(fq * (acc + b3[lane])); c.H3[(((size_t)(lane >> 2) * S) + l) * 4 + (lane & 3)] = h;
            LDS_WAIT();
        }
    }
    __syncthreads();
}

__device__ __forceinline__ void phase_gemm(KA& a, int ph, LAS unsigned char* lds) {
    const Ctx c = make_ctx(a); unsigned char* ws = c.ws;
    const int layer = (ph - 1) / 7, slot = (ph - 1) % 7, kind = layer_kind(layer);
    const size_t w_in = layer == 0 ? W0_IN : layer == 1 ? W1_IN : layer == 2 ? W2_IN : W3_IN;
    const size_t w_o = layer == 0 ? W0_O : layer == 1 ? W1_O : layer == 2 ? W2_O : W3_O;
    const size_t w_gu = layer == 0 ? W0_GU : layer == 1 ? W1_GU : layer == 2 ? W2_GU : W3_GU;
    const size_t w_dn = layer == 0 ? W0_DN : layer == 1 ? W1_DN : layer == 2 ? W2_DN : W3_DN;
    const size_t w_uq = layer == 0 ? W0_UQ : W3_UQ, w_ukv = layer == 0 ? W0_UKV : W3_UKV;
    float* ssq_mix = c.SSQ + (size_t)(2 * layer) * 8 * S; float* ssq_ffn = c.SSQ + (size_t)(2 * layer + 1) * 8 * S; float* ssq_nxt = c.SSQ + (size_t)(2 * layer + 2) * 8 * S;
    float* ssq_cq = c.SSQ + (size_t)(9 + (layer ? 2 : 0)) * 8 * S; float* ssq_ckv = ssq_cq + 8 * S;
    Epi E{}; E.exch = (LAS float*)(lds + 131072); const bf16_t* A = c.XB; const bf16_t* Bt = c.WB; int N = 2048, K = 2048;
    if (slot == 0) {
        E.ssq_in = ssq_mix; E.inv_k = 1.f / 2048.f; Bt = c.WB + w_in;
        if (kind == 0) { E.mode = EM_MLA_IN; E.o0 = (bf16_t*)(ws + R_CQ); E.o1 = (bf16_t*)(ws + R_CKV); E.o2 = (bf16_t*)(ws + R_K); E.ssq_out = ssq_cq; E.ssq_out2 = ssq_ckv; E.cs = c.MC; E.sn = c.MS; N = 1536; }
        else if (kind == 1) { E.mode = EM_HY_IN; E.o0 = (bf16_t*)(ws + R_UT); N = 6144; }
        else { E.mode = EM_DIFF_QKV; E.o0 = (bf16_t*)(ws + R_QD); E.o1 = (bf16_t*)(ws + R_KD); E.o2 = (bf16_t*)(ws + R_VD); E.cs = c.DC; E.sn = c.DS; N = 6144; }
    } else if (slot == 1) { E.mode = EM_MLA_UQ; E.ssq_in = ssq_cq; E.inv_k = 1.f / 768.f; E.o0 = (bf16_t*)(ws + R_Q); E.cs = c.MC; E.sn = c.MS; A = (const bf16_t*)(ws + R_CQ); Bt = c.WB + w_uq; N = 3072; K = 768; }
    else if (slot == 2) { E.mode = EM_MLA_UKV; E.ssq_in = ssq_ckv; E.inv_k = 1.f / 512.f; E.o0 = (bf16_t*)(ws + R_K); E.o1 = (bf16_t*)(ws + R_V); A = (const bf16_t*)(ws + R_CKV); Bt = c.WB + w_ukv; N = 4096; K = 512; }
    else if (slot == 4) { E.mode = EM_RES; E.xr = (layer == 0) ? a.in[0] : nullptr; E.o0 = c.XB; E.ssq_out = ssq_ffn; A = c.AO; Bt = c.WB + w_o; }
    else if (slot == 5) { E.mode = EM_GU; E.ssq_in = ssq_ffn; E.inv_k = 1.f / 2048.f; E.o0 = (bf16_t*)(ws + R_H); Bt = c.WB + w_gu; N = 11264; }
    else { E.mode = EM_RES; E.xr = nullptr; E.o0 = c.XB; E.ssq_out = ssq_nxt; A = (const bf16_t*)(ws + R_H); Bt = c.WB + w_dn; K = 5632; }
    pg8::Gemm g{A, Bt, S, N, K}; pg8::StaticOrder so; so.init(S, N, (int)gridDim.x, lbid());
    pg8::gemm_phase<Epi, pg8::StaticOrder>(lds, g, so, E);
    if (slot == 5 && layer < 3) {
        const int G = gridDim.x, bx = lbid(), first = (32 * 44) % G, nconv = G - first;
        if (bx >= first) { const int tid = ltid(), lane = tid & 63, wave = __builtin_amdgcn_readfirstlane(tid >> 6);
            const float* Wg = layer == 0 ? a.in[27] : layer == 1 ? a.in[39] : a.in[50];
            const float* gn = layer == 0 ? a.in[26] : layer == 1 ? a.in[38] : a.in[49];
            const size_t wo = layer == 0 ? W1_GU : layer == 1 ? W2_GU : W3_GU;
            cvt_gate_tail(Wg, gn, c.WB + wo, (LAS float*)(lds + wave * 16384), (bx - first) * 8 + wave, nconv * 8, lane); }
    }
}

__device__ __forceinline__ void phase_amla(KA& a, char* lds) {
    unsigned char* ws = a.ws; bf16_t* AO = (bf16_t*)(ws + WS_AO);
    const bf16_t* Q = (const bf16_t*)(ws + R_Q); const bf16_t* Kk = (const bf16_t*)(ws + R_K); const bf16_t* V = (const bf16_t*)(ws + R_V);
    const int G = gridDim.x, bx = lbid();
#pragma unroll 1
    for (int it = bx; it < 512; it += G) {
        const int h = (it & 7) + 8 * (it >> 8), qb = (it >> 3) & 31; const size_t q0 = (size_t)qb * 256;
        att::ATT192FN<192, 192, 128, 2048>(Q + ((size_t)h * S + q0) * 192, Kk + (size_t)h * S * 192, V + (size_t)h * S * 128, AO + q0 * 2048 + h * 128, S, lds);
    }
}

__device__ __forceinline__ void phase_adiff(KA& a, char* lds) {
    unsigned char* ws = a.ws; bf16_t* AO = (bf16_t*)(ws + WS_AO);
    const int G = gridDim.x, bx = lbid();
    const bf16_t* Qd = (const bf16_t*)(ws + R_QD); const bf16_t* Kd = (const bf16_t*)(ws + R_KD); const bf16_t* Vd = (const bf16_t*)(ws + R_VD);
    bf16_t* T = (bf16_t*)(ws + R_T) + (size_t)bx * (2 * 256 * 256);
#pragma unroll 1
    for (int it = bx; it < 256; it += G) {
        const int h = it & 7, qb = it >> 3; const size_t q0 = (size_t)qb * 256;
#pragma unroll 1
        for (int comp = 0; comp < 2; ++comp) {
            att::attn_body_dv256<128, 128, 256, 256>(Qd + ((size_t)(2 * h + comp) * S + q0) * 128, Kd + (size_t)(2 * h + comp) * S * 128, Vd + (size_t)h * S * 256,
                                                     T + comp * (256 * 256), S, lds);
        }
        __syncthreads();
        const int tid = ltid(), lane = tid & 63, wave = __builtin_amdgcn_readfirstlane(tid >> 6);
        float lam; { const float* lq1 = a.in[32]; const float* lk1 = a.in[33]; const float* lq2 = a.in[34]; const float* lk2 = a.in[35];
            float s1 = lq1[lane] * lk1[lane] + lq1[lane + 64] * lk1[lane + 64], s2 = lq2[lane] * lk2[lane] + lq2[lane + 64] * lk2[lane + 64];
            s1 = wave_sum(s1); s2 = wave_sum(s2); lam = __expf(s1) - __expf(s2) + 0.470713018f; }
        const float* subln = a.in[36];
        const f32x4 gsub = *(const f32x4*)(subln + 4 * lane);
#pragma unroll 1
        for (int rr = 0; rr < 32; ++rr) { const int row = wave * 32 + rr;
            const u32x2 w0 = *(const u32x2*)(T + (size_t)row * 256 + 4 * lane), w1 = *(const u32x2*)(T + 256 * 256 + (size_t)row * 256 + 4 * lane);
            const f32x4 t0 = {__uint_as_float(w0.x << 16), __uint_as_float(w0.x & 0xffff0000u), __uint_as_float(w0.y << 16), __uint_as_float(w0.y & 0xffff0000u)};
            const f32x4 t1 = {__uint_as_float(w1.x << 16), __uint_as_float(w1.x & 0xffff0000u), __uint_as_float(w1.y << 16), __uint_as_float(w1.y & 0xffff0000u)};
            const f32x4 d = t0 - t1 * lam;
            float s2 = (d.x * d.x + d.y * d.y) + (d.z * d.z + d.w * d.w); s2 = wave_sum(s2);
            const float rn = rsqrtf(s2 * (1.f / 256.f) + 1e-5f) * (1.f - 0.470713018f);
            const f32x4 ov = d * rn * gsub;
            u32x2 w; w.x = cvt_pk_bf16(ov.x, ov.y); w.y = cvt_pk_bf16(ov.z, ov.w);
            *(u32x2*)(AO + (q0 + row) * 2048 + h * 256 + 4 * lane) = w;
        }
        __syncthreads();
    }
}

__device__ __forceinline__ void phase_hyena(KA& a, LAS unsigned char* lds) {
    unsigned char* ws = a.ws; const float* H3 = (const float*)(ws + WS_H3);
    const int tid = ltid(); const int G = gridDim.x, bx = lbid();
    LAS f32x2* L = (LAS f32x2*)lds;
    LAS float* w8s = (LAS float*)(lds + 147456);
    LAS float* red = (LAS float*)(lds + 147456 + 2048);
    const bf16_t* UT = (const bf16_t*)(ws + R_UT);
    bf16_t* YT = (bf16_t*)(ws + R_YT);
    f32x2* SP0 = (f32x2*)(ws + R_SPEC) + (size_t)bx * 2 * FN; f32x2* SP1 = SP0 + FN;
    unsigned* SPb0 = (unsigned*)SP0; unsigned* SPb1 = SPb0 + FN;
    f32x2* Z1 = (f32x2*)(ws + R_Z1) + (size_t)bx * S;
    const float* cw = a.in[14]; const float* cb = a.in[15]; const float* W4 = a.in[23]; const float* hb = a.in[24];
#pragma unroll 1
    for (int pp = bx; pp < 1024; pp += G) {
        const int ca = 2 * pp, cbn = 2 * pp + 1;
        const float dla = fabsf(-3.0701134573253944f + (float)ca * ((-15.350567286626972f + 3.0701134573253944f) / 2047.0f));
        const float dlb = fabsf(-3.0701134573253944f + (float)cbn * ((-15.350567286626972f + 3.0701134573253944f) / 2047.0f));
#pragma unroll 1
        for (int rk = 0; rk < 1 + HY_REP_KERN; ++rk) {
        __syncthreads();
        { const int k = tid >> 3, j = tid & 7, o = j >> 2, jj = j & 3;
          w8s[tid] = W4[(size_t)k * 8192 + (jj >> 1) * 4096 + o * 2048 + ((jj & 1) ? cbn : ca)]; }
        __syncthreads();
        float sa0 = 0.f, sb0 = 0.f, sa1 = 0.f, sb1 = 0.f;
#pragma unroll 1
        for (int g = 0; g < 4; ++g) {
            const int lbase = tid + 2048 * g;
            f32x4 acc0[4], acc1[4];
#pragma unroll
            for (int li = 0; li < 4; ++li) { acc0[li] = (f32x4){0.f, 0.f, 0.f, 0.f}; acc1[li] = (f32x4){0.f, 0.f, 0.f, 0.f}; }
#pragma unroll 2
            for (int k4 = 0; k4 < 16; ++k4) {
                f32x4 hv[4];
#pragma unroll
                for (int li = 0; li < 4; ++li) hv[li] = *(const f32x4*)(H3 + ((size_t)k4 * S + (lbase + 512 * li)) * 4);
#pragma unroll
                for (int e = 0; e < 4; ++e) { const f32x4 wA = *(const LAS f32x4*)(w8s + (k4 * 4 + e) * 8), wB = *(const LAS f32x4*)(w8s + (k4 * 4 + e) * 8 + 4);
#pragma unroll
                    for (int li = 0; li < 4; ++li) { acc0[li] += wA * hv[li][e]; acc1[li] += wB * hv[li][e]; } }
            }
#pragma unroll
            for (int li = 0; li < 4; ++li) { const int l = lbase + 512 * li;
                const float t = (float)l * (1.0f / 8191.0f);
                const float da = __expf(-t * dla), db = __expf(-t * dlb);
                const f32x2 f0 = (f32x2){acc0[li][0] * da, acc0[li][1] * db}, b0 = (f32x2){acc0[li][2] * da, acc0[li][3] * db};
                const f32x2 f1 = (f32x2){acc1[li][0] * da, acc1[li][1] * db}, b1 = (f32x2){acc1[li][2] * da, acc1[li][3] * db};
                L[FP(l)] = f0; SP1[l] = f1; sa0 += fabsf(f0.x); sb0 += fabsf(f0.y); sa1 += fabsf(f1.x); sb1 += fabsf(f1.y);
                if (l == 0) { L[FP(S)] = (f32x2){0.f, 0.f}; SP1[S] = (f32x2){0.f, 0.f}; }
                else { L[FP(FN - l)] = b0; SP1[FN - l] = b1; sa0 += fabsf(b0.x); sb0 += fabsf(b0.y); sa1 += fabsf(b1.x); sb1 += fabsf(b1.y); }
            }
        }
        const float ta0 = block_sum(sa0, red, tid); const float tb0 = block_sum(sb0, red, tid);
        const float ta1 = block_sum(sa1, red, tid); const float tb1 = block_sum(sb1, red, tid);
        { const float ia = 1.f / ta0, ib = 1.f / tb0;
#pragma unroll 1
          for (int p = tid; p < FN; p += 512) { f32x2 v = L[FP(p)]; v.x *= ia; v.y *= ib; L[FP(p)] = v; } }
        fft_fwd(L, tid);
#pragma unroll 4
        for (int i = 0; i < 16; ++i) { const int p = 2 * (tid + 512 * i); const f32x4 v = *(const LAS f32x4*)(L + FP(p)); u32x2 w; w.x = cvt_pk_bf16(v[0], v[1]); w.y = cvt_pk_bf16(v[2], v[3]); *(u32x2*)(SPb0 + p) = w; }
        __syncthreads();
        { const float ia = 1.f / ta1, ib = 1.f / tb1;
#pragma unroll 4
          for (int i = 0; i < 16; ++i) { const int p = 2 * (tid + 512 * i); f32x4 v = *(const f32x4*)(SP1 + p); v[0] *= ia; v[1] *= ib; v[2] *= ia; v[3] *= ib; *(LAS f32x4*)(L + FP(p)) = v; } }
        fft_fwd(L, tid);
#pragma unroll 4
        for (int i = 0; i < 16; ++i) { const int p = 2 * (tid + 512 * i); const f32x4 v = *(const LAS f32x4*)(L + FP(p)); u32x2 w; w.x = cvt_pk_bf16(v[0], v[1]); w.y = cvt_pk_bf16(v[2], v[3]); *(u32x2*)(SPb1 + p) = w; }
        __syncthreads();
        }
        const bf16_t* ux1a = UT + (size_t)ca * S; const bf16_t* ux1b = UT + (size_t)cbn * S;
        const bf16_t* ux2a = UT + (size_t)(D + ca) * S; const bf16_t* ux2b = UT + (size_t)(D + cbn) * S;
        const bf16_t* uva = UT + (size_t)(2 * D + ca) * S; const bf16_t* uvb = UT + (size_t)(2 * D + cbn) * S;
#define BF2F(u16) __uint_as_float(((unsigned)(u16)) << 16)
#define SCONV4(dst, up, ch, t) do { const u32x2 xw_ = *(const u32x2*)((up) + (t)); const f32x4 x_ = {__uint_as_float(xw_.x << 16), __uint_as_float(xw_.x & 0xffff0000u), __uint_as_float(xw_.y << 16), __uint_as_float(xw_.y & 0xffff0000u)}; \
        const float xm_ = ((t) > 0) ? BF2F((up)[(t) - 1]) : 0.f, xp_ = ((t) + 4 < S) ? BF2F((up)[(t) + 4]) : 0.f; \
        const float w0_ = cw[ch], w1_ = cw[6144 + (ch)], w2_ = cw[2 * 6144 + (ch)], bb_ = cb[ch]; \
        dst[0] = xm_ * w0_ + x_[0] * w1_ + x_[1] * w2_ + bb_; dst[1] = x_[0] * w0_ + x_[1] * w1_ + x_[2] * w2_ + bb_; \
        dst[2] = x_[1] * w0_ + x_[2] * w1_ + x_[3] * w2_ + bb_; dst[3] = x_[2] * w0_ + x_[3] * w1_ + xp_ * w2_ + bb_; } while (0)
#pragma unroll 2
        for (int i = 0; i < 4; ++i) { const int t = 4 * (tid + 512 * i);
            f32x4 za, zb; SCONV4(za, uva, 2 * D + ca, t); SCONV4(zb, uvb, 2 * D + cbn, t);
            const f32x4 p01 = {za[0], zb[0], za[1], zb[1]}, p23 = {za[2], zb[2], za[3], zb[3]};
            *(LAS f32x4*)(L + FP(t)) = p01; *(LAS f32x4*)(L + FP(t) + 2) = p23;
            *(LAS f32x4*)(L + FP(S + t)) = (f32x4){0.f, 0.f, 0.f, 0.f}; *(LAS f32x4*)(L + FP(S + t) + 2) = (f32x4){0.f, 0.f, 0.f, 0.f};
            *(f32x4*)(Z1 + t) = p01; *(f32x4*)(Z1 + t + 2) = p23; }
        fft_fwd(L, tid);
        spec_mul(L, SPb0, tid);
        fft_inv(L, tid);
        const float b0a = hb[ca], b0b = hb[cbn], b1a = hb[D + ca], b1b = hb[D + cbn];
        const float invn = 1.0f / (float)FN;
#pragma unroll 2
        for (int i = 0; i < 4; ++i) { const int t = 4 * (tid + 512 * i);
            f32x4 ga, gb; SCONV4(ga, ux1a, ca, t); SCONV4(gb, ux1b, cbn, t);
            const f32x4 c01 = *(const LAS f32x4*)(L + FP(t)), c23 = *(const LAS f32x4*)(L + FP(t) + 2);
            const f32x4 z01 = *(const f32x4*)(Z1 + t), z23 = *(const f32x4*)(Z1 + t + 2);
            const f32x4 n01 = {ga[0] * (c01[0] * invn + z01[0] * b0a), gb[0] * (c01[1] * invn + z01[1] * b0b), ga[1] * (c01[2] * invn + z01[2] * b0a), gb[1] * (c01[3] * invn + z01[3] * b0b)};
            const f32x4 n23 = {ga[2] * (c23[0] * invn + z23[0] * b0a), gb[2] * (c23[1] * invn + z23[1] * b0b), ga[3] * (c23[2] * invn + z23[2] * b0a), gb[3] * (c23[3] * invn + z23[3] * b0b)};
            *(f32x4*)(Z1 + t) = n01; *(f32x4*)(Z1 + t + 2) = n23;
            *(LAS f32x4*)(L + FP(t)) = n01; *(LAS f32x4*)(L + FP(t) + 2) = n23;
            *(LAS f32x4*)(L + FP(S + t)) = (f32x4){0.f, 0.f, 0.f, 0.f}; *(LAS f32x4*)(L + FP(S + t) + 2) = (f32x4){0.f, 0.f, 0.f, 0.f}; }
        fft_fwd(L, tid);
        spec_mul(L, SPb1, tid);
        fft_inv(L, tid);
#pragma unroll 2
        for (int i = 0; i < 4; ++i) { const int t = 4 * (tid + 512 * i);
            f32x4 ga, gb; SCONV4(ga, ux2a, D + ca, t); SCONV4(gb, ux2b, D + cbn, t);
            const f32x4 c01 = *(const LAS f32x4*)(L + FP(t)), c23 = *(const LAS f32x4*)(L + FP(t) + 2);
            const f32x4 z01 = *(const f32x4*)(Z1 + t), z23 = *(const f32x4*)(Z1 + t + 2);
            const float ya0 = ga[0] * (c01[0] * invn + z01[0] * b1a), yb0 = gb[0] * (c01[1] * invn + z01[1] * b1b);
            const float ya1 = ga[1] * (c01[2] * invn + z01[2] * b1a), yb1 = gb[1] * (c01[3] * invn + z01[3] * b1b);
            const float ya2 = ga[2] * (c23[0] * invn + z23[0] * b1a), yb2 = gb[2] * (c23[1] * invn + z23[1] * b1b);
            const float ya3 = ga[3] * (c23[2] * invn + z23[2] * b1a), yb3 = gb[3] * (c23[3] * invn + z23[3] * b1b);
            u32x2 wa, wb; wa.x = cvt_pk_bf16(ya0, ya1); wa.y = cvt_pk_bf16(ya2, ya3); wb.x = cvt_pk_bf16(yb0, yb1); wb.y = cvt_pk_bf16(yb2, yb3);
            *(u32x2*)(YT + (size_t)ca * S + t) = wa; *(u32x2*)(YT + (size_t)cbn * S + t) = wb; }
#undef SCONV4
        __syncthreads();
    }
}

__device__ __forceinline__ void phase_tr(KA& a, LAS unsigned char* lds) {
    unsigned char* ws = a.ws; bf16_t* AO = (bf16_t*)(ws + WS_AO); const bf16_t* YT = (const bf16_t*)(ws + R_YT);
    const int tid = ltid(); const int G = gridDim.x, bx = lbid();
    LAS bf16_t* tl = (LAS bf16_t*)lds;
#pragma unroll 1
    for (int tile = bx; tile < 32 * 128; tile += G) {
        const int c0 = (tile & 31) * 64, t0 = (tile >> 5) * 64;
        __syncthreads();
        { const int i = tid >> 3, j8 = tid & 7;
          const bf16x8 v = *(const bf16x8*)(YT + (size_t)(c0 + i) * S + t0 + j8 * 8);
#pragma unroll
          for (int e = 0; e < 8; ++e) tl[(j8 * 8 + e) * 72 + i] = (bf16_t)v[e]; }
        __syncthreads();
        { const int tt = tid >> 3, c8 = tid & 7;
          const bf16x8 v = *(const LAS bf16x8*)(tl + tt * 72 + c8 * 8);
          *(bf16x8*)(AO + (size_t)(t0 + tt) * D + c0 + c8 * 8) = v; }
    }
    __syncthreads();
}

__device__ __forceinline__ void phase_final(KA& a) {
    const int tid = ltid(), lane = tid & 63, wave = __builtin_amdgcn_readfirstlane(tid >> 6);
    const int gw = lbid() * 8 + wave, NGW = gridDim.x * 8;
    const float* gfin = a.in[53]; const float* ssq = (const float*)(a.ws + WS_SSQ) + (size_t)8 * 8 * S; float* X = a.out;
#pragma unroll 1
    for (int r = gw; r < S; r += NGW) {
        float tsum = 0.f;
#pragma unroll
        for (int p = 0; p < 8; ++p) tsum += ssq[(size_t)p * S + r];
        const float rs = rsqrtf(tsum * (1.f / 2048.f) + RMS_EPS);
        f32x4* xo = (f32x4*)(X + (size_t)r * D) + lane; const f32x4* gg = (const f32x4*)gfin + lane;
        const u32x2* xb = (const u32x2*)((const bf16_t*)(a.ws + WS_XB) + (size_t)r * D) + lane;
#pragma unroll
        for (int j = 0; j < 8; ++j) { const u32x2 w = xb[64 * j];
            const f32x4 v = {__uint_as_float(w.x << 16), __uint_as_float(w.x & 0xffff0000u), __uint_as_float(w.y << 16), __uint_as_float(w.y & 0xffff0000u)};
            xo[64 * j] = v * rs * gg[64 * j]; }
    }
}

template <int TYPE> __device__ __forceinline__ void run_phase(KA& a, int ph, unsigned char* lds_raw) {
    LAS unsigned char* lds = (LAS unsigned char*)lds_raw;
    if constexpr (TYPE == T_P0) phase_p0(a, lds);
    else if constexpr (TYPE == T_GEMM) phase_gemm(a, ph, lds);
    else if constexpr (TYPE == T_AMLA) phase_amla(a, (char*)lds_raw);
    else if constexpr (TYPE == T_ADIFF) phase_adiff(a, (char*)lds_raw);
    else if constexpr (TYPE == T_HY) phase_hyena(a, lds);
    else if constexpr (TYPE == T_TR) phase_tr(a, lds);
    else if constexpr (TYPE == T_FINAL) phase_final(a);
}

template <int TYPE> __global__ void __launch_bounds__(512, 2) phase_kernel(Args a_) {
    extern __shared__ __attribute__((aligned(16))) unsigned char lds_raw[];
    KA& a = *largs();
    run_phase<TYPE>(a, a.ph_lo, lds_raw);
}

#ifndef HY_REP_FFT
#define HY_REP_FFT 0
#endif
#ifndef MK_REPEAT_MASK
#define MK_REPEAT_MASK 0
#endif
#ifndef MK_CUTS
#define MK_CUTS 0, N_PHASES
#endif
#ifndef MEGA_MASK
#define MEGA_MASK 0xff
#endif
#if !MK_MULTI
__global__ void __launch_bounds__(512, 2) mega_fwd(Args a_) {
    extern __shared__ __attribute__((aligned(16))) unsigned char lds_raw[];
    const int ph_lo = a_.ph_lo, ph_hi = a_.ph_hi;
    if (ph_hi < 0) cg::this_grid().sync();
    volatile LAS unsigned* stw = (volatile LAS unsigned*)((LAS unsigned char*)lds_raw + LDS_BYTES - 16);
    if (threadIdx.x == 0) { stw[0] = 0u; stw[1] = 0u; }
    __syncthreads();
    const XcdBarrier bar = xcd_barrier_post((unsigned*)(a_.ws + WS_BAR) + (size_t)a_.li * XCD_BAR_WORDS, stw);
    if (ph_lo == 0) {
#pragma unroll 1
        for (int r0 = 0; r0 < ((MK_REPEAT_MASK & 2) ? 2 : 1); ++r0) {
        { KA& a = *largs(); run_phase<T_P0>(a, 0, lds_raw); }
        if (ph_hi > 1) xcd_barrier(bar);
        }
    }
    const int l0 = ph_lo < 1 ? 1 : ph_lo, l1 = ph_hi < N_PHASES - 1 ? ph_hi : N_PHASES - 1;
    int rep = 0; (void)rep;
#pragma unroll 1
    for (int ph = l0; ph < l1; ++ph) {
        bool sync_after; const int ty = phase_type(ph, sync_after);
        KA& a = *largs();
        switch (ty) {
            case T_GEMM: run_phase<T_GEMM>(a, ph, lds_raw); break;
            case T_AMLA: run_phase<T_AMLA>(a, ph, lds_raw); break;
            case T_ADIFF: run_phase<T_ADIFF>(a, ph, lds_raw); break;
            case T_HY: run_phase<T_HY>(a, ph, lds_raw); break;
            case T_TR: run_phase<T_TR>(a, ph, lds_raw); break;
            default: break;
        }
        if (sync_after && ph + 1 < ph_hi) xcd_barrier(bar);
#if MK_REPEAT_MASK
        if (((MK_REPEAT_MASK >> ty) & 1) && !rep) { rep = 1; --ph; } else rep = 0;
#endif
    }
    if (ph_hi == N_PHASES) { KA& a = *largs(); run_phase<T_FINAL>(a, N_PHASES - 1, lds_raw); }
}
#endif
template <int TYPE> static void launch_phase(int grid, hipStream_t stream, Args a) {
    static bool attr = false;
    if (!attr) { (void)hipFuncSetAttribute((const void*)phase_kernel<TYPE>, hipFuncAttributeMaxDynamicSharedMemorySize, LDS_BYTES); attr = true; }
    hipLaunchKernelGGL(phase_kernel<TYPE>, dim3(grid), dim3(512), LDS_BYTES, stream, a);
}
extern "C" void kernel_launch(void* const* d_in, const int* in_sizes, int n_in, void* d_out, int out_size, void* d_ws, size_t ws_size, hipStream_t stream) {
    static int grid = 0;
    if (grid == 0) {
        if (n_in != 54 || out_size != S * D || ws_size < WS_END) { fprintf(stderr, "kernel_launch: bad shapes n_in %d out %d ws %zu (need %zu)\n", n_in, out_size, ws_size, (size_t)WS_END); grid = -1; return; }
        int dev = 0, cus = 0;
        (void)hipGetDevice(&dev); (void)hipDeviceGetAttribute(&cus, hipDeviceAttributeMultiprocessorCount, dev);
#if !MK_MULTI
        if (hipFuncSetAttribute((const void*)mega_fwd, hipFuncAttributeMaxDynamicSharedMemorySize, LDS_BYTES) != hipSuccess) { fprintf(stderr, "kernel_launch: hipFuncSetAttribute failed\n"); grid = -1; return; }
        int per_cu = 0;
        (void)hipOccupancyMaxActiveBlocksPerMultiprocessor(&per_cu, (const void*)mega_fwd, 512, LDS_BYTES);
        (void)hipGetLastError();
        if (per_cu < 1) fprintf(stderr, "kernel_launch: occupancy query says %d blocks per CU\n", per_cu);
#endif
        grid = cus > 0 ? cus : 256;
    }
    if (grid < 0) return;
    Args a{};
    for (int i = 0; i < 54; ++i) a.in[i] = (const float*)d_in[i];
    a.out = (float*)d_out; a.ws = (unsigned char*)d_ws;
#if MK_MULTI
    for (int p = 0; p < N_PHASES; ++p) {
        bool sa; const int ty = phase_type(p, sa); a.ph_lo = p; a.ph_hi = p + 1;
        switch (ty) {
            case T_P0: launch_phase<T_P0>(grid, stream, a); break;
            case T_GEMM: launch_phase<T_GEMM>(grid, stream, a); break;
            case T_AMLA: launch_phase<T_AMLA>(grid, stream, a); break;
            case T_ADIFF: launch_phase<T_ADIFF>(grid, stream, a); break;
            case T_HY: launch_phase<T_HY>(grid, stream, a); break;
            case T_TR: launch_phase<T_TR>(grid, stream, a); break;
            case T_FINAL: launch_phase<T_FINAL>(grid, stream, a); break;
            default: break;
        }
    }
#else
    {
        const int cuts[] = {MK_CUTS};
        const int ncut = (int)(sizeof(cuts) / sizeof(int));
        (void)hipMemsetAsync((char*)d_ws + WS_BAR, 0, 64 * 1024, stream);
        for (int i = 0; i + 1 < ncut; ++i) {
            a.ph_lo = cuts[i]; a.ph_hi = cuts[i + 1]; a.li = i;
            void* args[] = {&a};
            hipError_t e = hipLaunchCooperativeKernel((const void*)mega_fwd, dim3(grid), dim3(512), args, LDS_BYTES, stream);
            if (e != hipSuccess) fprintf(stderr, "kernel_launch: cooperative launch failed: %s (grid %d)\n", hipGetErrorString(e), grid);
        }
    }
#endif
}
```

```cpp
#include <hip/hip_runtime.h>
#include <hip/hip_bf16.h>
#include <hip/hip_cooperative_groups.h>
#include <cstdio>
#include <cstdint>
namespace cg = cooperative_groups;

#ifndef MK_MULTI
#define MK_MULTI 0
#endif

#ifndef HY_REP_FFT
#define HY_REP_FFT 0
#endif
#ifndef HY_REP_KERN
#define HY_REP_KERN 0
#endif
#define LAS __attribute__((address_space(3)))
typedef unsigned short bf16_t;
typedef short bf16x8 __attribute__((ext_vector_type(8)));
typedef short s16x4 __attribute__((ext_vector_type(4)));
typedef float f32x4 __attribute__((ext_vector_type(4)));
typedef float f32x2 __attribute__((ext_vector_type(2)));
typedef float f32x16 __attribute__((ext_vector_type(16)));
typedef unsigned u32x4 __attribute__((ext_vector_type(4)));
typedef unsigned u32x2 __attribute__((ext_vector_type(2)));

constexpr int S = 8192, D = 2048, FF = 5632, NT512 = 512;
constexpr float RMS_EPS = 1e-6f;
constexpr int LDS_BYTES = 155648;

constexpr size_t MiB = 1u << 20;
constexpr size_t E_IN = (size_t)1536 * 2048, E_UQ = (size_t)3072 * 768, E_UKV = (size_t)4096 * 512, E_O = (size_t)2048 * 2048,
                 E_GU = (size_t)11264 * 2048, E_DN = (size_t)2048 * 5632, E_HY = (size_t)6144 * 2048;
constexpr size_t W0_IN = 0, W0_UQ = W0_IN + E_IN, W0_UKV = W0_UQ + E_UQ, W0_O = W0_UKV + E_UKV, W0_GU = W0_O + E_O, W0_DN = W0_GU + E_GU;
constexpr size_t W1_IN = W0_DN + E_DN, W1_O = W1_IN + E_HY, W1_GU = W1_O + E_O, W1_DN = W1_GU + E_GU;
constexpr size_t W2_IN = W1_DN + E_DN, W2_O = W2_IN + E_HY, W2_GU = W2_O + E_O, W2_DN = W2_GU + E_GU;
constexpr size_t W3_IN = W2_DN + E_DN, W3_UQ = W3_IN + E_IN, W3_UKV = W3_UQ + E_UQ, W3_O = W3_UKV + E_UKV, W3_GU = W3_O + E_O, W3_DN = W3_GU + E_GU;
constexpr size_t W_END_E = W3_DN + E_DN;
constexpr size_t WS_W = 0;
constexpr size_t WS_XB = ((W_END_E * 2 + MiB - 1) / MiB) * MiB;
constexpr size_t WS_AO = WS_XB + 32 * MiB;
constexpr size_t WS_SSQ = WS_AO + 32 * MiB;
constexpr size_t WS_MC = WS_SSQ + 4 * MiB, WS_MS = WS_MC + 1 * MiB;
constexpr size_t WS_DC = WS_MS + 1 * MiB, WS_DS = WS_DC + 2 * MiB;
constexpr size_t WS_H3 = WS_DS + 2 * MiB;
constexpr size_t WS_BAR = WS_H3 + 2 * MiB;
constexpr size_t WS_R = WS_BAR + 1 * MiB;
constexpr size_t R_CQ = WS_R, R_CKV = R_CQ + 12 * MiB, R_Q = R_CKV + 8 * MiB, R_K = R_Q + 48 * MiB, R_V = R_K + 48 * MiB;
constexpr size_t R_UT = WS_R, R_YT = R_UT + 192 * MiB, R_SPEC = R_YT + 32 * MiB, R_Z1 = R_SPEC + 64 * MiB, R_HY_END = R_Z1 + 16 * MiB;
constexpr size_t R_QD = WS_R, R_KD = R_QD + 32 * MiB, R_VD = R_KD + 32 * MiB, R_T = R_VD + 32 * MiB;
constexpr size_t R_H = WS_R;
constexpr size_t WS_END = R_HY_END;

struct Args { const float* in[54]; float* out; unsigned char* ws; int ph_lo, ph_hi, li, pad; };
typedef const __attribute__((address_space(4))) Args KA;
__device__ __forceinline__ KA* largs() { KA* p = (KA*)__builtin_amdgcn_kernarg_segment_ptr(); asm volatile("" : "+s"(p)); return p; }

__device__ __forceinline__ unsigned cvt_pk_bf16(float lo, float hi) { unsigned r; asm volatile("v_cvt_pk_bf16_f32 %0, %1, %2" : "=v"(r) : "v"(lo), "v"(hi)); return r; }
__device__ __forceinline__ float wave_sum(float v) {
#pragma unroll
    for (int o = 1; o < 64; o <<= 1) v += __shfl_xor(v, o);
    return v;
}
__device__ __forceinline__ int ltid() { int t = threadIdx.x; asm volatile("" : "+v"(t)); return t; }
__device__ __forceinline__ int lbid() { int b = blockIdx.x; asm volatile("" : "+s"(b)); return b; }
#define LDS_WAIT() asm volatile("s_waitcnt lgkmcnt(0)" ::: "memory")
__device__ __forceinline__ void sincos_acc(float x, float& s, float& c) {
    const double xd = (double)x; const double q = __builtin_rint(xd * 0.15915494309189533577);
    const float r = (float)(xd - q * 6.283185307179586476925);
    float sgn = 1.f, rr = r;
    if (rr > 1.5707963267948966f) { rr = 3.14159265358979323846f - rr; sgn = -1.f; }
    else if (rr < -1.5707963267948966f) { rr = -3.14159265358979323846f - rr; sgn = -1.f; }
    const float z = rr * rr;
    float ps = -7.6471637318198164759e-13f; ps = fmaf(ps, z, 1.6059043836821614599e-10f); ps = fmaf(ps, z, -2.5052108385441718775e-8f); ps = fmaf(ps, z, 2.7557319223985890653e-6f);
    ps = fmaf(ps, z, -1.9841269841269841270e-4f); ps = fmaf(ps, z, 8.3333333333333333333e-3f); ps = fmaf(ps, z, -1.6666666666666666667e-1f);
    s = fmaf(rr * z, ps, rr);
    float pc = 4.7794773323873852974e-14f; pc = fmaf(pc, z, -1.1470745597729724714e-11f); pc = fmaf(pc, z, 2.0876756987868098979e-9f); pc = fmaf(pc, z, -2.7557319223985890653e-7f);
    pc = fmaf(pc, z, 2.4801587301587301587e-5f); pc = fmaf(pc, z, -1.3888888888888888889e-3f); pc = fmaf(pc, z, 4.1666666666666666667e-2f); pc = fmaf(pc, z, -0.5f);
    c = sgn * fmaf(pc, z, 1.0f);
}
__device__ __forceinline__ float sin_acc(float x) { float s, c; sincos_acc(x, s, c); return s; }

namespace pg8 {
#define PG8_LAS __attribute__((address_space(3)))
constexpr int BM = 256, BK = 64, HALF = 128, HTB = HALF * BK * 2, STAGE_BYTES = 8 * HTB, NXCD = 8, WGM = 8;
__host__ __device__ __forceinline__ int lds_byte(int r, int c) { const int st = (r >> 4) * 2 + (c >> 5), rr = r & 15, cc = c & 31, ob = rr * 64 + cc * 2; return st * 1024 + (ob ^ (((ob >> 9) & 1) << 5)); }
__host__ __device__ __forceinline__ void stage_rc(int b, int& R, int& C) { const int st = b / 1024, sb = b % 1024, swz = sb ^ (((sb >> 9) & 1) << 5); R = (st >> 1) * 16 + swz / 64; C = (st & 1) * 32 + (swz % 64) / 2; }
__host__ __device__ __forceinline__ int perm32(int rho) { const int n = rho >> 4, i = rho & 15; return 8 * (i >> 2) + 4 * n + (i & 3); }
struct Unit { int pm, pn; };
struct Gemm { const bf16_t* A; const bf16_t* Bt; int M, N, K; };
struct StaticOrder {
    int nM, nN, nwg, G, c;
    __host__ __device__ void init(int M, int N, int G_, int c_) { nM = M / BM; nN = N / BM; nwg = nM * nN; G = G_; c = c_; }
    __host__ __device__ bool next(int i, Unit& u) const {
        const long L = (long)i * G + c; if (L >= nwg) return false;
        int wgid = (int)L; { const int q = nwg / NXCD, r = nwg % NXCD, xcd = wgid % NXCD, off = wgid / NXCD; wgid = (xcd < r ? xcd * (q + 1) : r * (q + 1) + (xcd - r) * q) + off; }
        const int nig = WGM * nN, gid = wgid / nig, fm = gid * WGM, gsz = (nM - fm) < WGM ? (nM - fm) : WGM;
        u.pm = fm + ((wgid % nig) % gsz); u.pn = (wgid % nig) / gsz; return true;
    }
};

template <class Epi, class Sched>
__device__ __forceinline__ void gemm_phase(PG8_LAS unsigned char* lds, const Gemm g, const Sched& S, const Epi& E) {
    const int tid = ltid(), wid = __builtin_amdgcn_readfirstlane(tid >> 6), lane = tid & 63, wr = wid >> 2, wc = wid & 3, fr = lane & 15, fq = lane >> 4;
    const int K = g.K, nt = K / BK;
    unsigned voffA[2], voffB[2];
#pragma unroll
    for (int i = 0; i < 2; ++i) { int R, C; stage_rc(tid * 16 + i * 8192, R, C); const int Rb = ((R & ~31) + perm32(R & 31));
        voffA[i] = (unsigned)(R * K + C) * 2u; voffB[i] = (unsigned)(Rb * K + C) * 2u; }
    const size_t kstep = (size_t)(BK * 2);
    const size_t hstep = (size_t)HALF * K * 2;
    const size_t tstep = 2 * hstep;
    const unsigned ldsw = (unsigned)wid * 1024u;
    const int aoff = lds_byte(wr * 64 + fr, fq * 8), boff = lds_byte(wc * 32 + fr, fq * 8);
#define PG8_SA(b, h) (((b) * 2 + (h)) * HTB)
#define PG8_SB(b, h) ((4 + (b) * 2 + (h)) * HTB)
#define PG8_STAGE(bufoff, gbase, voff) do { _Pragma("unroll") for (int _i = 0; _i < 2; ++_i) \
        __builtin_amdgcn_global_load_lds((const unsigned*)((const char*)(gbase) + (voff)[_i]), (PG8_LAS unsigned*)(lds + (bufoff) + ldsw + _i * 8192), 16, 0, 0); } while (0)
#define PG8_LDA(dst, b, h) do { _Pragma("unroll") for (int m = 0; m < 4; ++m) _Pragma("unroll") for (int k = 0; k < 2; ++k) dst[m][k] = *(const PG8_LAS bf16x8*)(lds + PG8_SA(b, h) + aoff + m * 2048 + k * 1024); } while (0)
#define PG8_LDB(dst, b, h) do { _Pragma("unroll") for (int n = 0; n < 2; ++n) _Pragma("unroll") for (int k = 0; k < 2; ++k) dst[n][k] = *(const PG8_LAS bf16x8*)(lds + PG8_SB(b, h) + boff + n * 2048 + k * 1024); } while (0)
#define PG8_MMA(ai, bj, At, Bt) do { __builtin_amdgcn_s_setprio(1); _Pragma("unroll") for (int m = 0; m < 4; ++m) _Pragma("unroll") for (int n = 0; n < 2; ++n) _Pragma("unroll") for (int k = 0; k < 2; ++k) \
        acc[ai][bj][m][n] = __builtin_amdgcn_mfma_f32_16x16x32_bf16(Bt[n][k], At[m][k], acc[ai][bj][m][n], 0, 0, 0); __builtin_amdgcn_s_setprio(0); } while (0)
#define PG8_WAIT_V(n) asm volatile("s_waitcnt vmcnt(" #n ")" ::: "memory")
#define PG8_WAIT_L(n) asm volatile("s_waitcnt lgkmcnt(" #n ")" ::: "memory")
#define PG8_BAR __builtin_amdgcn_s_barrier()
#define PG8_SCHED __builtin_amdgcn_sched_barrier(0)
    Unit cur, nxt; int ui = 0;
    if (!S.next(0, cur)) return;
    f32x4 acc[2][2][4][2];
#pragma unroll
    for (int a = 0; a < 2; ++a)
#pragma unroll
        for (int b = 0; b < 2; ++b)
#pragma unroll
            for (int m = 0; m < 4; ++m)
#pragma unroll
                for (int n = 0; n < 2; ++n) acc[a][b][m][n] = (f32x4){0.f, 0.f, 0.f, 0.f};
    bf16x8 At[4][2], B0[2][2], B1[2][2];
    const char* cA = (const char*)g.A + (size_t)cur.pm * tstep; const char* cB = (const char*)g.Bt + (size_t)cur.pn * tstep;
    PG8_STAGE(PG8_SB(0, 0), cB, voffB); PG8_STAGE(PG8_SB(0, 1), cB + hstep, voffB); PG8_STAGE(PG8_SA(0, 0), cA, voffA); PG8_STAGE(PG8_SA(0, 1), cA + hstep, voffA);
    if (wr == 1) PG8_BAR;
    PG8_WAIT_V(2); PG8_BAR;
    PG8_STAGE(PG8_SB(1, 0), cB + kstep, voffB); PG8_STAGE(PG8_SA(1, 0), cA + kstep, voffA); PG8_STAGE(PG8_SB(1, 1), cB + hstep + kstep, voffB);
    PG8_WAIT_V(6); PG8_BAR;
    for (;;) {
        const bool has_next = S.next(ui + 1, nxt);
        const char* nA = has_next ? (const char*)g.A + (size_t)nxt.pm * tstep : cA; const char* nB = has_next ? (const char*)g.Bt + (size_t)nxt.pn * tstep : cB;
        for (int t = 0; t < nt; t += 2) {
            const bool last = (t == nt - 2);
            const char* a1 = cA + (size_t)(t + 1) * kstep;
            const char* a2 = last ? nA : cA + (size_t)(t + 2) * kstep; const char* b2 = last ? nB : cB + (size_t)(t + 2) * kstep;
            const char* a3 = a2 + kstep; const char* b3 = b2 + kstep;
            PG8_LDB(B0, 0, 0); PG8_LDB(B1, 0, 1); PG8_SCHED; PG8_LDA(At, 0, 0); PG8_STAGE(PG8_SA(1, 1), a1 + hstep, voffA);
            PG8_WAIT_V(8); PG8_WAIT_L(0); PG8_BAR; PG8_MMA(0, 0, At, B0); PG8_MMA(0, 1, At, B1); PG8_BAR; PG8_SCHED;
            PG8_LDA(At, 0, 1); PG8_STAGE(PG8_SB(0, 0), b2, voffB); PG8_STAGE(PG8_SB(0, 1), b2 + hstep, voffB); PG8_STAGE(PG8_SA(0, 0), a2, voffA);
            PG8_WAIT_V(8); PG8_WAIT_L(0); PG8_BAR; PG8_MMA(1, 0, At, B0); PG8_MMA(1, 1, At, B1); PG8_BAR; PG8_SCHED;
            PG8_LDB(B0, 1, 0); PG8_LDB(B1, 1, 1); PG8_SCHED; PG8_LDA(At, 1, 0); PG8_STAGE(PG8_SA(0, 1), a2 + hstep, voffA);
            PG8_WAIT_V(8); PG8_WAIT_L(0); PG8_BAR; PG8_MMA(0, 0, At, B0); PG8_MMA(0, 1, At, B1); PG8_BAR; PG8_SCHED;
            PG8_LDA(At, 1, 1); PG8_STAGE(PG8_SB(1, 0), b3, voffB); PG8_STAGE(PG8_SB(1, 1), b3 + hstep, voffB); PG8_STAGE(PG8_SA(1, 0), a3, voffA);
            PG8_WAIT_V(8); PG8_WAIT_L(0); PG8_BAR; PG8_MMA(1, 0, At, B0); PG8_MMA(1, 1, At, B1); PG8_BAR; PG8_SCHED;
        }
        if (wr == 0) PG8_BAR;
        E(acc, cur, wr, wc, fr, fq);
        if (!has_next) break;
#pragma unroll
        for (int a = 0; a < 2; ++a)
#pragma unroll
            for (int b = 0; b < 2; ++b)
#pragma unroll
                for (int m = 0; m < 4; ++m)
#pragma unroll
                    for (int n = 0; n < 2; ++n) acc[a][b][m][n] = (f32x4){0.f, 0.f, 0.f, 0.f};
        cur = nxt; cA = nA; cB = nB; ++ui;
        if (wr == 1) PG8_BAR;
    }
    PG8_WAIT_V(0);
    PG8_BAR;
#undef PG8_SA
#undef PG8_SB
#undef PG8_STAGE
#undef PG8_LDA
#undef PG8_LDB
#undef PG8_MMA
#undef PG8_WAIT_V
#undef PG8_WAIT_L
#undef PG8_BAR
#undef PG8_SCHED
}
}

enum { EM_MLA_IN = 0, EM_MLA_UQ = 1, EM_MLA_UKV = 2, EM_RES = 3, EM_HY_IN = 4, EM_DIFF_QKV = 5, EM_GU = 6 };
struct Epi {
    static constexpr bool PERM = true;
    int mode;
    const float* ssq_in; float inv_k;
    float* ssq_out; float* ssq_out2;
    bf16_t* o0; bf16_t* o1; bf16_t* o2;
    float* xf; const float* xr;
    const float* cs; const float* sn;
    LAS float* exch;
    __device__ __forceinline__ static void st8(bf16_t* p, f32x4 a, f32x4 b) {
        u32x4 w; w.x = cvt_pk_bf16(a[0], a[1]); w.y = cvt_pk_bf16(a[2], a[3]); w.z = cvt_pk_bf16(b[0], b[1]); w.w = cvt_pk_bf16(b[2], b[3]); *(u32x4*)p = w; }
    __device__ __forceinline__ static void st4(bf16_t* p, f32x4 a) { u32x2 w; w.x = cvt_pk_bf16(a[0], a[1]); w.y = cvt_pk_bf16(a[2], a[3]); *(u32x2*)p = w; }
    __device__ __forceinline__ static float dot8(f32x4 a, f32x4 b) { return (a[0] * a[0] + a[1] * a[1]) + (a[2] * a[2] + a[3] * a[3]) + (b[0] * b[0] + b[1] * b[1]) + (b[2] * b[2] + b[3] * b[3]); }
    __device__ __forceinline__ void operator()(const f32x4 (&acc)[2][2][4][2], const pg8::Unit& u, int wr, int wc, int fr_, int fq_) const {
        int fr = fr_, fq = fq_; asm volatile("" : "+v"(fr), "+v"(fq));
        const int cw = wc * 32 + 8 * fq;
#pragma unroll
        for (int ai = 0; ai < 2; ++ai)
#pragma unroll
        for (int m = 0; m < 4; ++m) {
            const int r = u.pm * 256 + ai * 128 + wr * 64 + m * 16 + fr;
            float rs = 1.f;
            if (mode != EM_RES) { float t = 0.f;
#pragma unroll
                for (int p = 0; p < 8; ++p) t += ssq_in[(size_t)p * S + r];
                rs = rsqrtf(t * inv_k + RMS_EPS); }
            if (mode == EM_MLA_IN) {
                if (u.pn < 5) {
                    bf16_t* dst = (u.pn < 3) ? (o0 + (size_t)r * 768 + u.pn * 256) : (o1 + (size_t)r * 512 + (u.pn - 3) * 256);
                    float part = 0.f;
#pragma unroll
                    for (int bj = 0; bj < 2; ++bj) { const f32x4 v0 = acc[ai][bj][m][0] * rs, v1 = acc[ai][bj][m][1] * rs; part += dot8(v0, v1); st8(dst + bj * 128 + cw, v0, v1); }
                    part += __shfl_xor(part, 16); part += __shfl_xor(part, 32);
                    if (fq == 0) exch[(ai * 128 + wr * 64 + m * 16 + fr) * 4 + wc] = part;
                } else if (wc == 0) {
#pragma unroll
                    for (int n = 0; n < 2; ++n) { const int i0 = 8 * fq + 4 * n;
                        const f32x4 c = *(const f32x4*)(cs + (size_t)r * 32 + i0), s = *(const f32x4*)(sn + (size_t)r * 32 + i0);
                        const f32x4 x1 = acc[ai][0][m][n] * rs, x2 = acc[ai][1][m][n] * rs;
                        const f32x4 y1 = x1 * c - x2 * s, y2 = x1 * s + x2 * c;
                        u32x2 w1, w2; w1.x = cvt_pk_bf16(y1[0], y1[1]); w1.y = cvt_pk_bf16(y1[2], y1[3]); w2.x = cvt_pk_bf16(y2[0], y2[1]); w2.y = cvt_pk_bf16(y2[2], y2[3]);
                        bf16_t* kp = o2 + (size_t)r * 192 + 128 + i0;
#pragma unroll
                        for (int h = 0; h < 16; ++h) { *(u32x2*)(kp + (size_t)h * S * 192) = w1; *(u32x2*)(kp + (size_t)h * S * 192 + 32) = w2; } }
                }
            } else if (mode == EM_MLA_UQ) {
                if (u.pn < 8) {
#pragma unroll
                    for (int bj = 0; bj < 2; ++bj) { const int c = u.pn * 256 + bj * 128 + cw; st8(o0 + ((size_t)(c >> 7) * S + r) * 192 + (c & 127), acc[ai][bj][m][0] * rs, acc[ai][bj][m][1] * rs); }
                } else { const int head = 4 * (u.pn - 8) + wc;
#pragma unroll
                    for (int n = 0; n < 2; ++n) { const int i0 = 8 * fq + 4 * n;
                        const f32x4 c = *(const f32x4*)(cs + (size_t)r * 32 + i0), s = *(const f32x4*)(sn + (size_t)r * 32 + i0);
                        const f32x4 x1 = acc[ai][0][m][n] * rs, x2 = acc[ai][1][m][n] * rs;
                        bf16_t* qp = o0 + ((size_t)head * S + r) * 192 + 128 + i0;
                        st4(qp, x1 * c - x2 * s); st4(qp + 32, x1 * s + x2 * c); }
                }
            } else if (mode == EM_MLA_UKV) {
                st8(o0 + ((size_t)u.pn * S + r) * 192 + cw, acc[ai][0][m][0] * rs, acc[ai][0][m][1] * rs);
                st8(o1 + ((size_t)u.pn * S + r) * 128 + cw, acc[ai][1][m][0] * rs, acc[ai][1][m][1] * rs);
            } else if (mode == EM_RES) {
                float part = 0.f;
#pragma unroll
                for (int bj = 0; bj < 2; ++bj) { const int c = u.pn * 256 + bj * 128 + cw; bf16_t* bp = o0 + (size_t)r * 2048 + c;
                    f32x4 p0, p1;
                    if (xr) { const float* xq = xr + (size_t)r * 2048 + c; p0 = *(const f32x4*)xq; p1 = *(const f32x4*)(xq + 4); }
                    else { const u32x4 w = *(const u32x4*)bp;
                        p0 = (f32x4){__uint_as_float(w.x << 16), __uint_as_float(w.x & 0xffff0000u), __uint_as_float(w.y << 16), __uint_as_float(w.y & 0xffff0000u)};
                        p1 = (f32x4){__uint_as_float(w.z << 16), __uint_as_float(w.z & 0xffff0000u), __uint_as_float(w.w << 16), __uint_as_float(w.w & 0xffff0000u)}; }
                    const f32x4 x0 = p0 + acc[ai][bj][m][0], x1 = p1 + acc[ai][bj][m][1];
                    part += dot8(x0, x1); st8(bp, x0, x1); }
                part += __shfl_xor(part, 16); part += __shfl_xor(part, 32);
                if (fq == 0) exch[(ai * 128 + wr * 64 + m * 16 + fr) * 4 + wc] = part;
            } else if (mode == EM_HY_IN) {
#pragma unroll
                for (int bj = 0; bj < 2; ++bj)
#pragma unroll
                for (int n = 0; n < 2; ++n)
#pragma unroll
                for (int e = 0; e < 4; ++e) { const int c = u.pn * 256 + bj * 128 + cw + 4 * n + e; const float v = acc[ai][bj][m][n][e] * rs; o0[(size_t)c * S + r] = (bf16_t)(cvt_pk_bf16(v, v) & 0xffffu); }
            } else if (mode == EM_DIFF_QKV) {
                if (u.pn < 16) { bf16_t* dst = (u.pn < 8) ? o0 : o1; const int hc = 2 * (u.pn & 7) + (wc >> 1), ib = 32 * (wc & 1) + 8 * fq;
#pragma unroll
                    for (int n = 0; n < 2; ++n) { const int i0 = ib + 4 * n;
                        const f32x4 c = *(const f32x4*)(cs + (size_t)r * 64 + i0), s = *(const f32x4*)(sn + (size_t)r * 64 + i0);
                        const f32x4 x1 = acc[ai][0][m][n] * rs, x2 = acc[ai][1][m][n] * rs;
                        bf16_t* qp = dst + ((size_t)hc * S + r) * 128 + i0;
                        st4(qp, x1 * c - x2 * s); st4(qp + 64, x1 * s + x2 * c); }
                } else {
#pragma unroll
                    for (int bj = 0; bj < 2; ++bj) st8(o2 + ((size_t)(u.pn - 16) * S + r) * 256 + bj * 128 + cw, acc[ai][bj][m][0] * rs, acc[ai][bj][m][1] * rs);
                }
            } else {
                f32x4 hv[2];
#pragma unroll
                for (int n = 0; n < 2; ++n) { const f32x4 gg = acc[ai][0][m][n] * rs, uu = acc[ai][1][m][n] * rs;
#pragma unroll
                    for (int e = 0; e < 4; ++e) hv[n][e] = gg[e] * __builtin_amdgcn_rcpf(1.f + __expf(-gg[e])) * uu[e]; }
                st8(o0 + (size_t)r * FF + u.pn * 128 + cw, hv[0], hv[1]);
            }
        }
        if (mode == EM_RES || (mode == EM_MLA_IN && u.pn < 5)) {
            asm volatile("s_waitcnt lgkmcnt(0)" ::: "memory"); __builtin_amdgcn_s_barrier();
            const int t = ltid();
            if (t < 256) { const f32x4 p4 = *(const LAS f32x4*)(exch + t * 4); const float tot = (p4[0] + p4[1]) + (p4[2] + p4[3]);
                float* dst = (mode == EM_RES) ? (ssq_out + (size_t)u.pn * S) : ((u.pn < 3) ? (ssq_out + (size_t)u.pn * S) : (ssq_out2 + (size_t)(u.pn - 3) * S));
                dst[u.pm * 256 + t] = tot; }
        }
    }
};

#ifndef ATT192FN
#define ATT192FN attn_body192p
#endif
namespace att {
using bf16 = __hip_bfloat16;
constexpr int   D = 128, NW = 8, QBLK = 32, KVBLK = 64;
constexpr float THR = 8.f;
constexpr int SDEPTH = 2;
constexpr size_t SHM_V = KVBLK * D * 2, SHM_K = KVBLK * D * 2, SHM_ATTN = 2 * SHM_V + 2 * SHM_K + NW * 64 * 4;
using bf16x8 = __attribute__((ext_vector_type(8))) short;
using s16x4  = __attribute__((ext_vector_type(4))) short;
using f32x16 = __attribute__((ext_vector_type(16))) float;
using f32x8  = __attribute__((ext_vector_type(8))) float;
using u32x4  = __attribute__((ext_vector_type(4))) unsigned;
#define KSWZ(row, colB) ((row) * 256 + ((colB) ^ (((row) & 7) << 4)))
#define SBAR() __builtin_amdgcn_sched_barrier(0)
__device__ __forceinline__ int crow(int r, int hi) { return (r & 3) + 8 * (r >> 2) + 4 * hi; }
__device__ __forceinline__ unsigned cvtpk(float lo, float hi) {
  unsigned r; asm volatile("v_cvt_pk_bf16_f32 %0, %1, %2" : "=v"(r) : "v"(lo), "v"(hi)); return r;
}
template <typename TIn> struct Stage;
template <> struct Stage<bf16>  { using T = bf16x8;
  __device__ static __forceinline__ T ld8(const bf16* p) { return *reinterpret_cast<const bf16x8*>(p); }
  __device__ static __forceinline__ bf16x8 tobf(T x) { return x; } };
template <> struct Stage<float> { using T = f32x8;
  __device__ static __forceinline__ T ld8(const float* p) { return *reinterpret_cast<const f32x8*>(p); }
  __device__ static __forceinline__ bf16x8 tobf(T x) {
    u32x4 w = {cvtpk(x[0], x[1]), cvtpk(x[2], x[3]), cvtpk(x[4], x[5]), cvtpk(x[6], x[7])}; return *reinterpret_cast<bf16x8*>(&w); } };

template <int DK> __device__ __forceinline__ void partialSM(f32x16& p0, f32x16& p1, float& m_reg, float& mn, float& alpha) {
  constexpr float SCALE = (DK == 192) ? 0.07216878364870322f : 0.08838834764831845f;
  constexpr float C = SCALE * 1.4426950408889634f;
  float pmax = p0[0]; for (int r = 1; r < 16; ++r) pmax = fmaxf(pmax, p0[r]); for (int r = 0; r < 16; ++r) pmax = fmaxf(pmax, p1[r]);
  { auto rr = __builtin_amdgcn_permlane32_swap(__float_as_uint(pmax), __float_as_uint(pmax), false, false);
    pmax = fmaxf(__uint_as_float(rr[0]), __uint_as_float(rr[1])); }
  if (__builtin_expect(__all(pmax - m_reg <= THR / SCALE), 1)) { mn = m_reg; alpha = 1.f; }
  else { mn = fmaxf(m_reg, pmax); alpha = __builtin_amdgcn_exp2f((m_reg - mn) * C); m_reg = mn; }
  float mnC = -mn * C;
  for (int r = 0; r < 16; ++r) p0[r] = fmaf(p0[r], C, mnC); for (int r = 0; r < 16; ++r) p1[r] = fmaf(p1[r], C, mnC);
  for (int r = 0; r < 16; ++r) p0[r] = __builtin_amdgcn_exp2f(p0[r]);
}
__device__ __forceinline__ void finishSM(f32x16& p0, f32x16& p1, float alpha, float& l_reg, bf16x8& pa0, bf16x8& pa1, bf16x8& pa2, bf16x8& pa3) {
  for (int r = 0; r < 16; ++r) p1[r] = __builtin_amdgcn_exp2f(p1[r]);
  float ps = 0; for (int r = 0; r < 16; ++r) ps += p0[r]; for (int r = 0; r < 16; ++r) ps += p1[r];
  { auto rr = __builtin_amdgcn_permlane32_swap(__float_as_uint(ps), __float_as_uint(ps), false, false);
    ps = __uint_as_float(rr[0]) + __uint_as_float(rr[1]); }
  l_reg = l_reg * alpha + ps;
#define PK4(P, BASE, OUT) do { unsigned a0 = cvtpk(P[BASE + 0], P[BASE + 1]), a1 = cvtpk(P[BASE + 2], P[BASE + 3]);   \
    unsigned b0 = cvtpk(P[BASE + 4], P[BASE + 5]), b1 = cvtpk(P[BASE + 6], P[BASE + 7]);                              \
    auto r0 = __builtin_amdgcn_permlane32_swap(a0, b0, false, false); auto r1 = __builtin_amdgcn_permlane32_swap(a1, b1, false, false); \
    u32x4 w = {r0[0], r1[0], r0[1], r1[1]}; OUT = *reinterpret_cast<bf16x8*>(&w); } while (0)
  PK4(p0, 0, pa0); PK4(p0, 8, pa1); PK4(p1, 0, pa2); PK4(p1, 8, pa3);
#undef PK4
}
__device__ __forceinline__ void qkt(f32x16& p0, f32x16& p1, const bf16* Ks, const bf16x8* qr, int r32, int hi) {
  p0 = f32x16{}; p1 = f32x16{};
  for (int d0 = 0; d0 < 8; ++d0) { int cb = (d0 * 16 + hi * 8) * 2;
    bf16x8 b0 = *reinterpret_cast<const bf16x8*>((const char*)Ks + KSWZ(r32, cb));
    bf16x8 b1 = *reinterpret_cast<const bf16x8*>((const char*)Ks + KSWZ(32 + r32, cb));
    p0 = __builtin_amdgcn_mfma_f32_32x32x16_bf16(b0, qr[d0], p0, 0, 0, 0);
    p1 = __builtin_amdgcn_mfma_f32_32x32x16_bf16(b1, qr[d0], p1, 0, 0, 0); }
}
__device__ __forceinline__ int v_st(int k, int c) { const int kk = (k & ~0xC) | ((k & 4) << 1) | ((k & 8) >> 1); return ((kk >> 3) * 4 + (c >> 5)) * 512 + ((kk & 7) * 32 + (c & 31)) * 2; }
__device__ __forceinline__ int v_rd_base(int lane) { return ((lane & 3) << 3) | (((lane >> 2) & 3) << 6) | (((lane >> 4) & 1) << 5) | (((lane >> 5) & 1) << 8); }
constexpr int v_rd_off(int d0, int ks, int half) { return d0 * 512 + ks * 4096 + half * 2048; }
template <int OFF> __device__ __forceinline__ s16x4 tr_read(int vb) {
  s16x4 r; asm volatile("ds_read_b64_tr_b16 %0, %1 offset:%2" : "=&v"(r) : "v"(vb), "i"(OFF) : "memory"); return r;
}
template <int D0> __device__ __forceinline__ void pv_one(f32x16& od, int vb, bf16x8 pa0, bf16x8 pa1, bf16x8 pa2, bf16x8 pa3) {
  const s16x4 l0 = tr_read<v_rd_off(D0, 0, 0)>(vb), h0 = tr_read<v_rd_off(D0, 0, 1)>(vb), l1 = tr_read<v_rd_off(D0, 1, 0)>(vb), h1 = tr_read<v_rd_off(D0, 1, 1)>(vb);
  const s16x4 l2 = tr_read<v_rd_off(D0, 2, 0)>(vb), h2 = tr_read<v_rd_off(D0, 2, 1)>(vb), l3 = tr_read<v_rd_off(D0, 3, 0)>(vb), h3 = tr_read<v_rd_off(D0, 3, 1)>(vb);
  asm volatile("s_waitcnt lgkmcnt(0)" ::: "memory"); SBAR();
#define PK(L, H) (bf16x8){L[0], L[1], L[2], L[3], H[0], H[1], H[2], H[3]}
  od = __builtin_amdgcn_mfma_f32_32x32x16_bf16(pa0, PK(l0, h0), od, 0, 0, 0);
  od = __builtin_amdgcn_mfma_f32_32x32x16_bf16(pa1, PK(l1, h1), od, 0, 0, 0);
  od = __builtin_amdgcn_mfma_f32_32x32x16_bf16(pa2, PK(l2, h2), od, 0, 0, 0);
  od = __builtin_amdgcn_mfma_f32_32x32x16_bf16(pa3, PK(l3, h3), od, 0, 0, 0);
#undef PK
}
__device__ __forceinline__ void pv_d0(f32x16* o, int vb, bf16x8 pa0, bf16x8 pa1, bf16x8 pa2, bf16x8 pa3) {
  pv_one<0>(o[0], vb, pa0, pa1, pa2, pa3); pv_one<1>(o[1], vb, pa0, pa1, pa2, pa3); pv_one<2>(o[2], vb, pa0, pa1, pa2, pa3); pv_one<3>(o[3], vb, pa0, pa1, pa2, pa3);
}

template <typename TQ, int LDQ, int LDK, int LDV, int LDO>
__device__ __forceinline__ void attn_dense_body(const TQ* __restrict__ Qb, const bf16* __restrict__ Kh, const bf16* __restrict__ Vh,
                                                float* __restrict__ Ob, int seq, char* lds) {
  using St = Stage<bf16>; using SQ = Stage<TQ>;
  int tid_ = threadIdx.x; asm volatile("" : "+v"(tid_)); const int tid = tid_, wid = tid >> 6, lane = tid & 63, r32 = lane & 31, hi = lane >> 5;
  bf16* V_lds = (bf16*)lds; bf16* K_lds = (bf16*)(lds + 2 * SHM_V);
  float* ws = (float*)(lds + 2 * SHM_V + 2 * SHM_K) + wid * 64; float* li_l = ws; float* al_l = ws + 32;
  float m_reg = -1e30f, l_reg = 0; f32x16 o[4] = {}; bf16x8 qr[8];
  const TQ* Qw = Qb + (long)(wid * QBLK + r32) * LDQ + hi * 8;
#pragma unroll
  for (int d0 = 0; d0 < 8; ++d0) qr[d0] = SQ::tobf(SQ::ld8(Qw + d0 * 16));
  const int sr = tid >> 4, sc = (tid & 15) * 8, vst0 = v_st(sr, sc), vst1 = v_st(32 + sr, sc);
  const int vb0 = (int)(uintptr_t)V_lds + v_rd_base(lane);
  struct { typename St::T vs0, vs1, ks0, ks1; } sr_[SDEPTH];
#define SLOAD(i, k0) do { sr_[i].vs0 = St::ld8(&Vh[(long)((k0) + sr) * LDV + sc]); sr_[i].vs1 = St::ld8(&Vh[(long)((k0) + 32 + sr) * LDV + sc]); \
    sr_[i].ks0 = St::ld8(&Kh[(long)((k0) + sr) * LDK + sc]); sr_[i].ks1 = St::ld8(&Kh[(long)((k0) + 32 + sr) * LDK + sc]); } while (0)
#define SWRITE(b, i) do { *(bf16x8*)((char*)V_lds + (b) * SHM_V + vst0) = St::tobf(sr_[i].vs0);          \
    *(bf16x8*)((char*)V_lds + (b) * SHM_V + vst1) = St::tobf(sr_[i].vs1); int kc = sc * 2;               \
    *(bf16x8*)((char*)K_lds + (b) * SHM_K + KSWZ(sr, kc)) = St::tobf(sr_[i].ks0);                       \
    *(bf16x8*)((char*)K_lds + (b) * SHM_K + KSWZ(32 + sr, kc)) = St::tobf(sr_[i].ks1); } while (0)
#define SWAIT() do { if constexpr (SDEPTH == 2) asm volatile("s_waitcnt vmcnt(4)" ::: "memory"); else asm volatile("s_waitcnt vmcnt(0)" ::: "memory"); } while (0)
#define RESC(a) do { if (__any((a) < 1.f)) { if (hi == 0) al_l[r32] = (a); asm volatile("s_waitcnt lgkmcnt(0)" ::: "memory"); \
    for (int d = 0; d < 4; ++d) for (int r = 0; r < 16; ++r) o[d][r] *= al_l[crow(r, hi)]; } } while (0)
  f32x16 pA0, pA1, pB0, pB1; float mnA, mnB, alA, alB; bf16x8 pa0, pa1, pa2, pa3; const int NT = seq / KVBLK;
  constexpr int SE = 0, SO = SDEPTH - 1;
  SLOAD(SE, 0); asm volatile("s_waitcnt vmcnt(0)" ::: "memory"); SWRITE(0, SE); __syncthreads();
  qkt(pA0, pA1, K_lds, qr, r32, hi); partialSM<128>(pA0, pA1, m_reg, mnA, alA);
  SLOAD(SO, KVBLK); if constexpr (SDEPTH == 2) { if (2 < NT) SLOAD(SE, 2 * KVBLK); }
  SWAIT(); SWRITE(1, SO); __syncthreads();
  for (int j = 1; j + 1 < NT; j += 2) {
    SBAR(); qkt(pB0, pB1, (bf16*)((char*)K_lds + SHM_K), qr, r32, hi);
    finishSM(pA0, pA1, alA, l_reg, pa0, pa1, pa2, pa3); SBAR();
    SLOAD(SO, (j + SDEPTH) * KVBLK); SBAR();
    pv_d0(o, vb0, pa0, pa1, pa2, pa3); partialSM<128>(pB0, pB1, m_reg, mnB, alB);
    __syncthreads(); SWAIT(); SWRITE(0, SE);
    RESC(alB); __syncthreads();
    SBAR(); qkt(pA0, pA1, K_lds, qr, r32, hi);
    finishSM(pB0, pB1, alB, l_reg, pa0, pa1, pa2, pa3); SBAR();
    if (SDEPTH == 1 || j + 3 < NT) SLOAD(SE, (j + 1 + SDEPTH) * KVBLK); SBAR();
    pv_d0(o, vb0 + (int)SHM_V, pa0, pa1, pa2, pa3); partialSM<128>(pA0, pA1, m_reg, mnA, alA);
    __syncthreads(); SWAIT(); SWRITE(1, SO);
    RESC(alA); __syncthreads();
  }
  SBAR(); qkt(pB0, pB1, (bf16*)((char*)K_lds + SHM_K), qr, r32, hi);
  finishSM(pA0, pA1, alA, l_reg, pa0, pa1, pa2, pa3); SBAR();
  pv_d0(o, vb0, pa0, pa1, pa2, pa3); partialSM<128>(pB0, pB1, m_reg, mnB, alB);
  __syncthreads(); RESC(alB);
  finishSM(pB0, pB1, alB, l_reg, pa0, pa1, pa2, pa3); SBAR();
  pv_d0(o, vb0 + (int)SHM_V, pa0, pa1, pa2, pa3);
  if (hi == 0) li_l[r32] = l_reg; asm volatile("s_waitcnt lgkmcnt(0)" ::: "memory");
  float rli[16];
#pragma unroll
  for (int r = 0; r < 16; ++r) rli[r] = __builtin_amdgcn_rcpf(li_l[crow(r, hi)]);
  float* Ow = Ob + (long)(wid * QBLK) * LDO;
#pragma unroll
  for (int r = 0; r < 16; ++r) { int orow = crow(r, hi);
    for (int d0 = 0; d0 < 4; ++d0) Ow[(long)orow * LDO + d0 * 32 + r32] = o[d0][r] * rli[r]; }
#undef SLOAD
#undef SWRITE
#undef SWAIT
#undef RESC
}


#define KSWZ192(row, colB) ((row) * 384 + ((colB) ^ (((row) & 7) << 4)))
__device__ __forceinline__ void qkt192(f32x16& p0, f32x16& p1, const char* Ks, const bf16x8* qr, int r32, int hi) {
  p0 = f32x16{}; p1 = f32x16{};
#pragma unroll
  for (int d0 = 0; d0 < 12; ++d0) { const int cb = (d0 * 16 + hi * 8) * 2;
    bf16x8 b0 = *reinterpret_cast<const bf16x8*>(Ks + KSWZ192(r32, cb));
    bf16x8 b1 = *reinterpret_cast<const bf16x8*>(Ks + KSWZ192(32 + r32, cb));
    p0 = __builtin_amdgcn_mfma_f32_32x32x16_bf16(b0, qr[d0], p0, 0, 0, 0);
    p1 = __builtin_amdgcn_mfma_f32_32x32x16_bf16(b1, qr[d0], p1, 0, 0, 0); }
}
template <int LDQ, int LDK, int LDV, int LDO>
__device__ __forceinline__ void attn_body192(const unsigned short* __restrict__ Qb, const unsigned short* __restrict__ Kh, const unsigned short* __restrict__ Vh,
                                             unsigned short* __restrict__ Ob, int seq, char* lds) {
  constexpr size_t SV = 16384, SK = 24576;
  int tid_ = threadIdx.x; asm volatile("" : "+v"(tid_)); const int tid = tid_, wid = tid >> 6, lane = tid & 63, r32 = lane & 31, hi = lane >> 5;
  char* V_lds = lds; char* K_lds = lds + 2 * SV;
  float* ws = (float*)(lds + 2 * SV + 2 * SK) + wid * 64; float* li_l = ws; float* al_l = ws + 32;
  float m_reg = -1e30f, l_reg = 0; f32x16 o[4] = {}; bf16x8 qr[12];
  const unsigned short* Qw = Qb + (long)(wid * QBLK + r32) * LDQ + hi * 8;
#pragma unroll
  for (int d0 = 0; d0 < 12; ++d0) qr[d0] = *reinterpret_cast<const bf16x8*>(Qw + d0 * 16);
  const int sr = tid >> 4, sc = (tid & 15) * 8, vst0 = v_st(sr, sc), vst1 = v_st(32 + sr, sc);
  const unsigned voff0 = (unsigned)(sr * LDV + sc), voff1 = (unsigned)((32 + sr) * LDV + sc);
  unsigned koff[3]; int kst[3];
#pragma unroll
  for (int i = 0; i < 3; ++i) { const int q = tid + 512 * i; const int krow = q / 24, kcol = (q % 24) * 8; koff[i] = (unsigned)(krow * LDK + kcol); kst[i] = KSWZ192(krow, kcol * 2); }
  const int vb0 = (int)(uintptr_t)V_lds + v_rd_base(lane);
  bf16x8 vs0, vs1, ks[3];
#define LD192(k0) do { const unsigned short* vp_ = Vh + (size_t)(k0) * LDV; const unsigned short* kp_ = Kh + (size_t)(k0) * LDK; vs0 = *(const bf16x8*)(vp_ + voff0); vs1 = *(const bf16x8*)(vp_ + voff1); \
    _Pragma("unroll") for (int i_ = 0; i_ < 3; ++i_) ks[i_] = *(const bf16x8*)(kp_ + koff[i_]); } while (0)
#define WR192(b) do { *(bf16x8*)(V_lds + (b) * SV + vst0) = vs0; *(bf16x8*)(V_lds + (b) * SV + vst1) = vs1; \
    _Pragma("unroll") for (int i_ = 0; i_ < 3; ++i_) *(bf16x8*)(K_lds + (b) * SK + kst[i_]) = ks[i_]; } while (0)
  const int NT = seq / KVBLK;
  LD192(0); WR192(0); __syncthreads();
#pragma unroll 1
  for (int j = 0; j < NT; ++j) {
    const int b = j & 1;
    if (j + 1 < NT) LD192((j + 1) * KVBLK);
    f32x16 p0, p1; float mn, al; bf16x8 pa0, pa1, pa2, pa3;
    qkt192(p0, p1, K_lds + b * SK, qr, r32, hi);
    partialSM<192>(p0, p1, m_reg, mn, al);
    if (__any(al < 1.f)) { if (hi == 0) al_l[r32] = al; asm volatile("s_waitcnt lgkmcnt(0)" ::: "memory");
#pragma unroll
      for (int d = 0; d < 4; ++d)
#pragma unroll
        for (int r = 0; r < 16; ++r) o[d][r] *= al_l[crow(r, hi)]; }
    finishSM(p0, p1, al, l_reg, pa0, pa1, pa2, pa3); SBAR();
    pv_d0(o, vb0 + b * (int)SV, pa0, pa1, pa2, pa3);
    if (j + 1 < NT) WR192(b ^ 1);
    __syncthreads();
  }
  if (hi == 0) li_l[r32] = l_reg; asm volatile("s_waitcnt lgkmcnt(0)" ::: "memory");
  float rli[16];
#pragma unroll
  for (int r = 0; r < 16; ++r) rli[r] = __builtin_amdgcn_rcpf(li_l[crow(r, hi)]);
  unsigned short* Ow = Ob + (long)(wid * QBLK) * LDO;
#pragma unroll
  for (int r = 0; r < 16; ++r) { const int orow = crow(r, hi);
#pragma unroll
    for (int d0 = 0; d0 < 4; ++d0) { const float v = o[d0][r] * rli[r]; Ow[(long)orow * LDO + d0 * 32 + r32] = (unsigned short)(cvtpk(v, v) & 0xffffu); } }
  __syncthreads();
#undef LD192
#undef WR192
}
constexpr int NQR = 6;
__device__ __forceinline__ void qkt192p(f32x16& p0, f32x16& p1, const char* Ks, const bf16x8* qr, const char* Qr_lds, int r32, int hi) {
  p0 = f32x16{}; p1 = f32x16{};
#pragma unroll
  for (int d0 = 0; d0 < NQR; ++d0) { const int cb = (d0 * 16 + hi * 8) * 2;
    bf16x8 b0 = *reinterpret_cast<const bf16x8*>(Ks + KSWZ192(r32, cb));
    bf16x8 b1 = *reinterpret_cast<const bf16x8*>(Ks + KSWZ192(32 + r32, cb));
    p0 = __builtin_amdgcn_mfma_f32_32x32x16_bf16(b0, qr[d0], p0, 0, 0, 0);
    p1 = __builtin_amdgcn_mfma_f32_32x32x16_bf16(b1, qr[d0], p1, 0, 0, 0); }
#pragma unroll
  for (int d0 = NQR; d0 < 12; ++d0) { const int cb = (d0 * 16 + hi * 8) * 2;
    bf16x8 q = *reinterpret_cast<const bf16x8*>(Qr_lds + (d0 - NQR) * 1024);
    bf16x8 b0 = *reinterpret_cast<const bf16x8*>(Ks + KSWZ192(r32, cb));
    bf16x8 b1 = *reinterpret_cast<const bf16x8*>(Ks + KSWZ192(32 + r32, cb));
    p0 = __builtin_amdgcn_mfma_f32_32x32x16_bf16(b0, q, p0, 0, 0, 0);
    p1 = __builtin_amdgcn_mfma_f32_32x32x16_bf16(b1, q, p1, 0, 0, 0); }
}
template <int LDQ, int LDK, int LDV, int LDO>
__device__ __forceinline__ void attn_body192p(const unsigned short* __restrict__ Qb, const unsigned short* __restrict__ Kh, const unsigned short* __restrict__ Vh,
                                              unsigned short* __restrict__ Ob, int seq, char* lds) {
  constexpr size_t SV = 16384, SK = 24576;
  int tid_ = threadIdx.x; asm volatile("" : "+v"(tid_)); const int tid = tid_, wid = tid >> 6, lane = tid & 63, r32 = lane & 31, hi = lane >> 5;
  char* V_lds = lds; char* K_lds = lds + 2 * SV; const char* Qr_lds = lds + 2 * SV + 2 * SK + wid * ((12 - NQR) * 1024) + lane * 16;
  float* ws = (float*)(lds + 2 * SV + 2 * SK + 8 * (12 - NQR) * 1024) + wid * 64; float* li_l = ws; float* al_l = ws + 32;
  float m_reg = -1e30f, l_reg = 0; f32x16 o[4] = {}; bf16x8 qr[NQR];
  const unsigned short* Qw = Qb + (long)(wid * QBLK + r32) * LDQ + hi * 8;
#pragma unroll
  for (int d0 = 0; d0 < NQR; ++d0) qr[d0] = *reinterpret_cast<const bf16x8*>(Qw + d0 * 16);
#pragma unroll
  for (int d0 = NQR; d0 < 12; ++d0) *(bf16x8*)(const_cast<char*>(Qr_lds) + (d0 - NQR) * 1024) = *reinterpret_cast<const bf16x8*>(Qw + d0 * 16);
  const int sr = tid >> 4, sc = (tid & 15) * 8, vst0 = v_st(sr, sc), vst1 = v_st(32 + sr, sc);
  const unsigned voff0 = (unsigned)(sr * LDV + sc), voff1 = (unsigned)((32 + sr) * LDV + sc);
  const int kr0 = tid / 24, kc0 = (tid % 24) * 8, kr1 = (tid + 512) / 24, kc1 = ((tid + 512) % 24) * 8, kr2 = (tid + 1024) / 24, kc2 = ((tid + 1024) % 24) * 8;
  const unsigned koff0 = (unsigned)(kr0 * LDK + kc0), koff1 = (unsigned)(kr1 * LDK + kc1), koff2 = (unsigned)(kr2 * LDK + kc2);
  const int kst0 = KSWZ192(kr0, kc0 * 2), kst1 = KSWZ192(kr1, kc1 * 2), kst2 = KSWZ192(kr2, kc2 * 2);
  const int vb0 = (int)(uintptr_t)V_lds + v_rd_base(lane);
  struct { bf16x8 vs0, vs1, ks0, ks1, ks2; } sr_[1];
#define SLOADP(i, k0) do { const unsigned short* vp_ = Vh + (size_t)(k0) * LDV; const unsigned short* kp_ = Kh + (size_t)(k0) * LDK; \
    sr_[i].vs0 = *(const bf16x8*)(vp_ + voff0); sr_[i].vs1 = *(const bf16x8*)(vp_ + voff1); \
    sr_[i].ks0 = *(const bf16x8*)(kp_ + koff0); sr_[i].ks1 = *(const bf16x8*)(kp_ + koff1); sr_[i].ks2 = *(const bf16x8*)(kp_ + koff2); } while (0)
#define SWRITEP(b, i) do { *(bf16x8*)(V_lds + (b) * SV + vst0) = sr_[i].vs0; *(bf16x8*)(V_lds + (b) * SV + vst1) = sr_[i].vs1; \
    *(bf16x8*)(K_lds + (b) * SK + kst0) = sr_[i].ks0; *(bf16x8*)(K_lds + (b) * SK + kst1) = sr_[i].ks1; *(bf16x8*)(K_lds + (b) * SK + kst2) = sr_[i].ks2; } while (0)
#define SWAITP() asm volatile("s_waitcnt vmcnt(0)" ::: "memory")
#define RESCP(a) do { if (__any((a) < 1.f)) { if (hi == 0) al_l[r32] = (a); asm volatile("s_waitcnt lgkmcnt(0)" ::: "memory"); \
    _Pragma("unroll") for (int d = 0; d < 4; ++d) _Pragma("unroll") for (int r = 0; r < 16; ++r) o[d][r] *= al_l[crow(r, hi)]; } } while (0)
  f32x16 pA0, pA1, pB0, pB1; float mnA, mnB, alA, alB; bf16x8 pa0, pa1, pa2, pa3; const int NT = seq / KVBLK;
  constexpr int SE = 0, SO = 0;
  SLOADP(SE, 0); asm volatile("s_waitcnt vmcnt(0)" ::: "memory"); SWRITEP(0, SE); __syncthreads();
  qkt192p(pA0, pA1, K_lds, qr, Qr_lds, r32, hi); partialSM<192>(pA0, pA1, m_reg, mnA, alA);
  SLOADP(SO, KVBLK);
  SWAITP(); SWRITEP(1, SO); __syncthreads();
  for (int j = 1; j + 1 < NT; j += 2) {
    SBAR(); qkt192p(pB0, pB1, K_lds + SK, qr, Qr_lds, r32, hi);
    finishSM(pA0, pA1, alA, l_reg, pa0, pa1, pa2, pa3); SBAR();
    SLOADP(SO, (j + 1) * KVBLK); SBAR();
    pv_d0(o, vb0, pa0, pa1, pa2, pa3); partialSM<192>(pB0, pB1, m_reg, mnB, alB);
    __syncthreads(); SWAITP(); SWRITEP(0, SE);
    RESCP(alB); __syncthreads();
    SBAR(); qkt192p(pA0, pA1, K_lds, qr, Qr_lds, r32, hi);
    finishSM(pB0, pB1, alB, l_reg, pa0, pa1, pa2, pa3); SBAR();
    SLOADP(SE, (j + 2) * KVBLK); SBAR();
    pv_d0(o, vb0 + (int)SV, pa0, pa1, pa2, pa3); partialSM<192>(pA0, pA1, m_reg, mnA, alA);
    __syncthreads(); SWAITP(); SWRITEP(1, SO);
    RESCP(alA); __syncthreads();
  }
  SBAR(); qkt192p(pB0, pB1, K_lds + SK, qr, Qr_lds, r32, hi);
  finishSM(pA0, pA1, alA, l_reg, pa0, pa1, pa2, pa3); SBAR();
  pv_d0(o, vb0, pa0, pa1, pa2, pa3); partialSM<192>(pB0, pB1, m_reg, mnB, alB);
  __syncthreads(); RESCP(alB);
  finishSM(pB0, pB1, alB, l_reg, pa0, pa1, pa2, pa3); SBAR();
  pv_d0(o, vb0 + (int)SV, pa0, pa1, pa2, pa3);
  if (hi == 0) li_l[r32] = l_reg; asm volatile("s_waitcnt lgkmcnt(0)" ::: "memory");
  float rli[16];
#pragma unroll
  for (int r = 0; r < 16; ++r) rli[r] = __builtin_amdgcn_rcpf(li_l[crow(r, hi)]);
  unsigned short* Ow = Ob + (long)(wid * QBLK) * LDO;
#pragma unroll
  for (int r = 0; r < 16; ++r) { const int orow = crow(r, hi);
#pragma unroll
    for (int d0 = 0; d0 < 4; ++d0) { const float v = o[d0][r] * rli[r]; Ow[(long)orow * LDO + d0 * 32 + r32] = (unsigned short)(cvtpk(v, v) & 0xffffu); } }
  __syncthreads();
#undef SLOADP
#undef SWRITEP
#undef SWAITP
#undef RESCP
}
constexpr int NQR2 = 4;
__device__ __forceinline__ int v_st256(int k, int c) { const int kk = (k & ~0xC) | ((k & 4) << 1) | ((k & 8) >> 1); return ((kk >> 3) * 8 + (c >> 5)) * 512 + ((kk & 7) * 32 + (c & 31)) * 2; }
constexpr int v_rd_off256(int d0, int ks, int half) { return d0 * 512 + ks * 8192 + half * 4096; }
template <int D0> __device__ __forceinline__ void pv_one256(f32x16& od, int vb, bf16x8 pa0, bf16x8 pa1, bf16x8 pa2, bf16x8 pa3) {
  const s16x4 l0 = tr_read<v_rd_off256(D0, 0, 0)>(vb), h0 = tr_read<v_rd_off256(D0, 0, 1)>(vb), l1 = tr_read<v_rd_off256(D0, 1, 0)>(vb), h1 = tr_read<v_rd_off256(D0, 1, 1)>(vb);
  const s16x4 l2 = tr_read<v_rd_off256(D0, 2, 0)>(vb), h2 = tr_read<v_rd_off256(D0, 2, 1)>(vb), l3 = tr_read<v_rd_off256(D0, 3, 0)>(vb), h3 = tr_read<v_rd_off256(D0, 3, 1)>(vb);
  asm volatile("s_waitcnt lgkmcnt(0)" ::: "memory"); SBAR();
#define PK(L, H) (bf16x8){L[0], L[1], L[2], L[3], H[0], H[1], H[2], H[3]}
  od = __builtin_amdgcn_mfma_f32_32x32x16_bf16(pa0, PK(l0, h0), od, 0, 0, 0);
  od = __builtin_amdgcn_mfma_f32_32x32x16_bf16(pa1, PK(l1, h1), od, 0, 0, 0);
  od = __builtin_amdgcn_mfma_f32_32x32x16_bf16(pa2, PK(l2, h2), od, 0, 0, 0);
  od = __builtin_amdgcn_mfma_f32_32x32x16_bf16(pa3, PK(l3, h3), od, 0, 0, 0);
#undef PK
}
__device__ __forceinline__ void qkt128q(f32x16& p0, f32x16& p1, const char* Ks, const bf16x8* qr, const char* Qr_lds, int r32, int hi) {
  p0 = f32x16{}; p1 = f32x16{};
#pragma unroll
  for (int d0 = 0; d0 < 8; ++d0) { const int cb = (d0 * 16 + hi * 8) * 2;
    bf16x8 q; if (d0 < NQR2) q = qr[d0 < NQR2 ? d0 : 0]; else q = *reinterpret_cast<const bf16x8*>(Qr_lds + (d0 - NQR2) * 1024);
    bf16x8 b0 = *reinterpret_cast<const bf16x8*>(Ks + KSWZ(r32, cb));
    bf16x8 b1 = *reinterpret_cast<const bf16x8*>(Ks + KSWZ(32 + r32, cb));
    p0 = __builtin_amdgcn_mfma_f32_32x32x16_bf16(b0, q, p0, 0, 0, 0);
    p1 = __builtin_amdgcn_mfma_f32_32x32x16_bf16(b1, q, p1, 0, 0, 0); }
}
template <int LDQ, int LDK, int LDV, int LDO>
__device__ __forceinline__ void attn_body_dv256(const unsigned short* __restrict__ Qb, const unsigned short* __restrict__ Kh, const unsigned short* __restrict__ Vh,
                                                unsigned short* __restrict__ Of, int seq, char* lds) {
  constexpr size_t SV = 32768, SK = 16384;
  int tid_ = threadIdx.x; asm volatile("" : "+v"(tid_)); const int tid = tid_, wid = tid >> 6, lane = tid & 63, r32 = lane & 31, hi = lane >> 5;
  char* V_lds = lds; char* K_lds = lds + 2 * SV; const char* Qr_lds = lds + 2 * SV + 2 * SK + wid * ((8 - NQR2) * 1024) + lane * 16;
  float* ws = (float*)(lds + 2 * SV + 2 * SK + 8 * (8 - NQR2) * 1024) + wid * 64; float* li_l = ws; float* al_l = ws + 32;
  float m_reg = -1e30f, l_reg = 0; f32x16 o[8] = {}; bf16x8 qr[NQR2];
  const unsigned short* Qw = Qb + (long)(wid * QBLK + r32) * LDQ + hi * 8;
#pragma unroll
  for (int d0 = 0; d0 < NQR2; ++d0) qr[d0] = *reinterpret_cast<const bf16x8*>(Qw + d0 * 16);
#pragma unroll
  for (int d0 = NQR2; d0 < 8; ++d0) *(bf16x8*)(const_cast<char*>(Qr_lds) + (d0 - NQR2) * 1024) = *reinterpret_cast<const bf16x8*>(Qw + d0 * 16);
  const int sr = tid >> 4, sc = (tid & 15) * 8; const int kst0 = KSWZ(sr, sc * 2), kst1 = KSWZ(32 + sr, sc * 2);
  const unsigned koff0 = (unsigned)(sr * LDK + sc), koff1 = (unsigned)((32 + sr) * LDK + sc);
  const int vr = tid >> 5, vc = (tid & 31) * 8;
  const unsigned voff = (unsigned)(vr * LDV + vc);
  const int vst0 = v_st256(vr, vc);
  const int vb0 = (int)(uintptr_t)V_lds + v_rd_base(lane);
  bf16x8 vs[4], ks0, ks1;
#define LD256(k0) do { const unsigned short* vp_ = Vh + (size_t)(k0) * LDV; const unsigned short* kp_ = Kh + (size_t)(k0) * LDK; \
    _Pragma("unroll") for (int i_ = 0; i_ < 4; ++i_) vs[i_] = *(const bf16x8*)(vp_ + voff + (unsigned)(16 * i_ * LDV)); \
    ks0 = *(const bf16x8*)(kp_ + koff0); ks1 = *(const bf16x8*)(kp_ + koff1); } while (0)
#define WR256(b) do { _Pragma("unroll") for (int i_ = 0; i_ < 4; ++i_) *(bf16x8*)(V_lds + (b) * SV + vst0 + i_ * 8192) = vs[i_]; \
    *(bf16x8*)(K_lds + (b) * SK + kst0) = ks0; *(bf16x8*)(K_lds + (b) * SK + kst1) = ks1; } while (0)
  const int NT = seq / KVBLK;
  LD256(0); WR256(0); __syncthreads();
#pragma unroll 1
  for (int j = 0; j < NT; ++j) {
    const int b = j & 1;
    if (j + 1 < NT) LD256((j + 1) * KVBLK);
    f32x16 p0, p1; float mn, al; bf16x8 pa0, pa1, pa2, pa3;
    qkt128q(p0, p1, K_lds + b * SK, qr, Qr_lds, r32, hi);
    partialSM<128>(p0, p1, m_reg, mn, al);
    if (__any(al < 1.f)) { if (hi == 0) al_l[r32] = al; asm volatile("s_waitcnt lgkmcnt(0)" ::: "memory");
#pragma unroll
      for (int d = 0; d < 8; ++d)
#pragma unroll
        for (int r = 0; r < 16; ++r) o[d][r] *= al_l[crow(r, hi)]; }
    finishSM(p0, p1, al, l_reg, pa0, pa1, pa2, pa3); SBAR();
    const int vb = vb0 + b * (int)SV;
    pv_one256<0>(o[0], vb, pa0, pa1, pa2, pa3); pv_one256<1>(o[1], vb, pa0, pa1, pa2, pa3); pv_one256<2>(o[2], vb, pa0, pa1, pa2, pa3); pv_one256<3>(o[3], vb, pa0, pa1, pa2, pa3);
    pv_one256<4>(o[4], vb, pa0, pa1, pa2, pa3); pv_one256<5>(o[5], vb, pa0, pa1, pa2, pa3); pv_one256<6>(o[6], vb, pa0, pa1, pa2, pa3); pv_one256<7>(o[7], vb, pa0, pa1, pa2, pa3);
    if (j + 1 < NT) WR256(b ^ 1);
    __syncthreads();
  }
  if (hi == 0) li_l[r32] = l_reg; asm volatile("s_waitcnt lgkmcnt(0)" ::: "memory");
  float rli[16];
#pragma unroll
  for (int r = 0; r < 16; ++r) rli[r] = __builtin_amdgcn_rcpf(li_l[crow(r, hi)]);
  unsigned short* Ow = Of + (long)(wid * QBLK) * LDO;
#pragma unroll
  for (int r = 0; r < 16; ++r) { const int orow = crow(r, hi);
#pragma unroll
    for (int d0 = 0; d0 < 8; ++d0) { const float v = o[d0][r] * rli[r]; Ow[(long)orow * LDO + d0 * 32 + r32] = (unsigned short)(cvtpk(v, v) & 0xffffu); } }
  __syncthreads();
#undef LD256
#undef WR256
}
}

enum { MAP_ID = 0, MAP_MLA_IN = 1, MAP_UQ = 2, MAP_DQKV = 3, MAP_GATE = 4, MAP_UP = 5 };
__device__ __forceinline__ int dmap(int kind, int n) {
    switch (kind) {
        case MAP_MLA_IN: return (n < 1312) ? n : (1408 + (n - 1312));
        case MAP_UQ: { const int head = n / 192, d = n % 192; if (d < 128) return head * 128 + d; const int r = d - 128, bj = r >> 5, i = r & 31; return 2048 + (head >> 2) * 256 + bj * 128 + (head & 3) * 32 + i; }
        case MAP_DQKV: { if (n >= 4096) return n; const int base = n & ~255, r = n & 255, blk = r >> 7, d = r & 127, bj = d >> 6, i = d & 63; return base + bj * 128 + blk * 64 + i; }
        case MAP_GATE: return (n >> 7) * 256 + (n & 127);
        case MAP_UP: return (n >> 7) * 256 + 128 + (n & 127);
        default: return n;
    }
}
__device__ __forceinline__ void cvt_item(const float* W, int K, int N, const float* g, bf16_t* WT, int kind, LAS float* scr, int item, int lane) {
    const int nblk = N / 32, kb = item / nblk, nb = item % nblk, k0 = 64 * kb, n0 = 32 * nb;
#pragma unroll 8
    for (int i = 0; i < 32; ++i) { const int kk = 2 * i + (lane >> 5); scr[kk * 33 + (lane & 31)] = W[(size_t)(k0 + kk) * N + n0 + (lane & 31)]; }
    LDS_WAIT(); asm volatile("" ::: "memory");
    const int c = lane & 7; const int drow0 = dmap(kind, n0);
    float gv[8];
#pragma unroll
    for (int e = 0; e < 8; ++e) gv[e] = g ? g[k0 + 8 * c + e] : 1.f;
#pragma unroll
    for (int j = 0; j < 4; ++j) { const int n = (lane >> 3) + 8 * j; const LAS float* s = scr + (8 * c) * 33 + n;
        u32x4 o; o.x = cvt_pk_bf16(s[0 * 33] * gv[0], s[1 * 33] * gv[1]); o.y = cvt_pk_bf16(s[2 * 33] * gv[2], s[3 * 33] * gv[3]);
        o.z = cvt_pk_bf16(s[4 * 33] * gv[4], s[5 * 33] * gv[5]); o.w = cvt_pk_bf16(s[6 * 33] * gv[6], s[7 * 33] * gv[7]);
        *(u32x4*)(WT + (size_t)(drow0 + n) * K + k0 + 8 * c) = o; }
    LDS_WAIT(); asm volatile("" ::: "memory");
}

__device__ __forceinline__ void cvt_gate_tail(const float* Wg, const float* g, bf16_t* WT, LAS float* scr, int gw, int NGW, int lane) {
    constexpr int NIT = (2048 / 64) * (5632 / 32);
#pragma unroll 1
    for (int it = gw; it < NIT; it += NGW) cvt_item(Wg, 2048, 5632, g, WT, MAP_GATE, scr, it, lane);
}

constexpr int FN = 16384, FNLOG = 14;
#define FP(i) ((i) + (((i) >> 5) << 2))
__device__ __forceinline__ f32x2 cmul(f32x2 a, f32x2 b) { return (f32x2){a.x * b.x - a.y * b.y, a.x * b.y + a.y * b.x}; }
__device__ __forceinline__ f32x2 twiddle(int idx, int M, float sign) {
    const float rev = (float)idx / (float)M;
    return (f32x2){__builtin_amdgcn_cosf(rev), sign * __builtin_amdgcn_sinf(rev)};
}
__device__ __forceinline__ f32x2 rot16(f32x2 v, int jj, float sgn) {
    const float h = 0.70710678118654752f, c1 = 0.92387953251128674f, s1 = 0.38268343236508977f;
    float c, s;
    switch (jj & 7) {
        case 0: return v;
        case 1: c = c1; s = s1; break;
        case 2: c = h; s = h; break;
        case 3: c = s1; s = c1; break;
        case 4: return (f32x2){-sgn * v.y, sgn * v.x};
        case 5: c = -s1; s = c1; break;
        case 6: c = -h; s = h; break;
        default: c = -c1; s = s1; break;
    }
    s *= sgn;
    return (f32x2){v.x * c - v.y * s, v.x * s + v.y * c};
}
#define FADDR(j) ((ls >= 5) ? (a0 + (j) * ps) : (a0 + (j) * s + (((low + (j) * s) >> 5) << 2)))
template <int R> __device__ __forceinline__ void fft_dif_pass(LAS f32x2* L, int ls  , int tid) {
    const int s = 1 << ls; const int ps = (ls >= 5) ? FP(s) : s;
#pragma unroll 1
    for (int g = tid; g < (FN >> R); g += 512) {
        const int low = g & (s - 1); const int i0 = ((g - low) << R) | low; const int a0 = FP(i0);
        f32x2 e[1 << R];
#pragma unroll
        for (int j = 0; j < (1 << R); ++j) e[j] = L[FADDR(j)];
        f32x2 wq[4];
        if (R == 4) { wq[3] = twiddle(low, 16 * s, -1.f); wq[2] = cmul(wq[3], wq[3]); wq[1] = cmul(wq[2], wq[2]); wq[0] = cmul(wq[1], wq[1]); }
#pragma unroll
        for (int q = R - 1; q >= 0; --q) {
            const int sp = 1 << q;
#pragma unroll
            for (int j = 0; j < (1 << R); ++j) if ((j & sp) == 0) {
                const f32x2 a = e[j], b = e[j + sp];
                e[j] = a + b;
                f32x2 d = a - b; const int jj = j & (sp - 1);
                if (R == 4) d = cmul(d, wq[q]);
                e[j + sp] = rot16(d, jj * (8 >> q), -1.f);
            }
        }
#pragma unroll
        for (int j = 0; j < (1 << R); ++j) L[FADDR(j)] = e[j];
    }
}
template <int R> __device__ __forceinline__ void fft_dit_pass(LAS f32x2* L, int ls, int tid) {
    const int s = 1 << ls; const int ps = (ls >= 5) ? FP(s) : s;
#pragma unroll 1
    for (int g = tid; g < (FN >> R); g += 512) {
        const int low = g & (s - 1); const int i0 = ((g - low) << R) | low; const int a0 = FP(i0);
        f32x2 e[1 << R];
#pragma unroll
        for (int j = 0; j < (1 << R); ++j) e[j] = L[FADDR(j)];
        f32x2 wq[4];
        if (R == 4) { wq[3] = twiddle(low, 16 * s, 1.f); wq[2] = cmul(wq[3], wq[3]); wq[1] = cmul(wq[2], wq[2]); wq[0] = cmul(wq[1], wq[1]); }
#pragma unroll
        for (int q = 0; q < R; ++q) {
            const int sp = 1 << q;
#pragma unroll
            for (int j = 0; j < (1 << R); ++j) if ((j & sp) == 0) {
                const int jj = j & (sp - 1);
                f32x2 b = e[j + sp];
                if (R == 4) b = cmul(b, wq[q]);
                b = rot16(b, jj * (8 >> q), 1.f);
                const f32x2 a = e[j];
                e[j] = a + b; e[j + sp] = a - b;
            }
        }
#pragma unroll
        for (int j = 0; j < (1 << R); ++j) L[FADDR(j)] = e[j];
    }
}
__device__ __forceinline__ void fft_fwd(LAS f32x2* L, int tid) {
    __syncthreads();
    fft_dif_pass<4>(L, 10, tid); __syncthreads();
    fft_dif_pass<4>(L, 6, tid); __syncthreads();
    fft_dif_pass<4>(L, 2, tid); __syncthreads();
    fft_dif_pass<2>(L, 0, tid); __syncthreads();
}
__device__ __forceinline__ void fft_inv(LAS f32x2* L, int tid) {
    __syncthreads();
    fft_dit_pass<2>(L, 0, tid); __syncthreads();
    fft_dit_pass<4>(L, 2, tid); __syncthreads();
    fft_dit_pass<4>(L, 6, tid); __syncthreads();
    fft_dit_pass<4>(L, 10, tid); __syncthreads();
}
__device__ __forceinline__ int brev14(int p) { return (int)(__builtin_bitreverse32((unsigned)p) >> 18); }
__device__ __forceinline__ float block_sum(float v, LAS float* red, int tid) {
    v = wave_sum(v);
    __syncthreads();
    if ((tid & 63) == 0) red[tid >> 6] = v;
    __syncthreads();
    float t = 0.f;
#pragma unroll
    for (int i = 0; i < 8; ++i) t += red[i];
    return t;
}
__device__ __forceinline__ f32x2 unpk_bf2(unsigned w) { return (f32x2){__uint_as_float(w << 16), __uint_as_float(w & 0xffff0000u)}; }
__device__ __forceinline__ void spec_mul(LAS f32x2* L, const unsigned* Kp, int tid) {
#pragma unroll 2
    for (int p = tid; p < FN; p += 512) {
        const int k = brev14(p), k2 = (FN - k) & (FN - 1), p2 = brev14(k2);
        if (p > p2) continue;
        const f32x2 z1 = L[FP(p)], z2 = L[FP(p2)], g1 = unpk_bf2(Kp[p]), g2 = unpk_bf2(Kp[p2]);
        const f32x2 ka = (f32x2){0.5f * (g1.x + g2.x), 0.5f * (g1.y - g2.y)};
        const f32x2 kb = (f32x2){0.5f * (g1.y + g2.y), -0.5f * (g1.x - g2.x)};
        const f32x2 P = (ka + kb) * 0.5f, M = (ka - kb) * 0.5f;
        const f32x2 z2c = (f32x2){z2.x, -z2.y}, z1c = (f32x2){z1.x, -z1.y};
        const f32x2 y1 = cmul(z1, P) + cmul(z2c, M);
        const f32x2 Pc = (f32x2){P.x, -P.y}, Mc = (f32x2){M.x, -M.y};
        const f32x2 y2 = cmul(z2, Pc) + cmul(z1c, Mc);
        L[FP(p)] = y1; if (p2 != p) L[FP(p2)] = y2;
    }
}

#define XB_TMO      128
#define XB_XCNT(j)  (256  + 64 * (j))
#define XB_XSUB(j)  (1280 + 64 * (j))
#define XB_XGEN(j)  (2304 + 64 * (j))
#define XB_TOP      3328
#define XB_TOPGEN   3392
#define XCD_BAR_WORDS 3456
#define XB_SPIN_CAP (1u << 18)
__device__ __forceinline__ unsigned xb_ld(unsigned* p)              { return __hip_atomic_load(p, __ATOMIC_RELAXED, __HIP_MEMORY_SCOPE_AGENT); }
__device__ __forceinline__ unsigned xb_add(unsigned* p, unsigned v) { return __hip_atomic_fetch_add(p, v, __ATOMIC_RELAXED, __HIP_MEMORY_SCOPE_AGENT); }
__device__ __forceinline__ unsigned xb_xcc_id() { return (unsigned)__builtin_amdgcn_s_getreg((3 << 11) | 20) & 0xFu; }
#define XB_SPIN(cond, bar) do { unsigned _sp = 0; while (cond) { __builtin_amdgcn_s_sleep(1); \
    if ((++_sp & 255u) == 0u) { if (xb_ld(&(bar)[XB_TMO])) break; if (_sp > XB_SPIN_CAP) { atomicAdd(&(bar)[XB_TMO], 1u); break; } } } } while (0)
struct XcdBarrier { unsigned* bar; unsigned x; volatile LAS unsigned* st; };
__device__ __forceinline__ XcdBarrier xcd_barrier_post(unsigned* bar, volatile LAS unsigned* st) {
    XcdBarrier b; b.bar = bar; b.x = xb_xcc_id(); b.st = st;
    if (threadIdx.x == 0) (void)xb_add(&bar[XB_XCNT(b.x)], 1u);
    return b;
}
__device__ __forceinline__ void xcd_barrier_complete(unsigned* bar, unsigned x, unsigned& nloc, unsigned& nx) {
    const unsigned G = gridDim.x * gridDim.y * gridDim.z;
    unsigned sum, cnt, mine, sp = 0u;
    for (;;) {
        sum = 0u; cnt = 0u; mine = 0u;
#pragma unroll
        for (unsigned j = 0; j < 16; ++j) { const unsigned c = xb_ld(&bar[XB_XCNT(j)]); sum += c; cnt += (c > 0u) ? 1u : 0u; mine = (j == x) ? c : mine; }
        if (sum == G) break;
        __builtin_amdgcn_s_sleep(1);
        if ((++sp & 255u) == 0u) { if (xb_ld(&bar[XB_TMO])) break; if (sp > XB_SPIN_CAP) { atomicAdd(&bar[XB_TMO], 1u); break; } }
    }
    nloc = mine > 0u ? mine : 1u; nx = cnt > 0u ? cnt : 1u;
}
__device__ __forceinline__ void xcd_barrier(const XcdBarrier& b) {
    asm volatile("s_waitcnt vmcnt(0)" ::: "memory");
    __syncthreads();
    if (threadIdx.x == 0) {
        unsigned* bar = b.bar;
        __builtin_amdgcn_s_waitcnt(0);
        unsigned nloc = b.st[0], nx = b.st[1];
        if (nloc == 0u) { xcd_barrier_complete(bar, b.x, nloc, nx); b.st[0] = nloc; b.st[1] = nx; }
        const unsigned old = xb_add(&bar[XB_XSUB(b.x)], 1u);
        const unsigned gen = old / nloc;
        if (old + 1u == (gen + 1u) * nloc) {
            __builtin_amdgcn_fence(__ATOMIC_RELEASE, "agent");
            asm volatile("s_waitcnt vmcnt(0)" ::: "memory");
            const unsigned og = xb_add(&bar[XB_TOP], 1u);
            const unsigned tg = og / nx;
            if (og + 1u == (tg + 1u) * nx) xb_add(&bar[XB_TOPGEN], 1u);
            else XB_SPIN(xb_ld(&bar[XB_TOPGEN]) == tg, bar);
            __builtin_amdgcn_fence(__ATOMIC_ACQUIRE, "agent");
            xb_add(&bar[XB_XGEN(b.x)], 1u);
            asm volatile("s_waitcnt vmcnt(0)" ::: "memory");
        } else {
            XB_SPIN(xb_ld(&bar[XB_XGEN(b.x)]) == gen, bar);
            __builtin_amdgcn_fence(__ATOMIC_ACQUIRE, "agent");
            asm volatile("s_waitcnt vmcnt(0)" ::: "memory");
        }
    }
    __syncthreads();
}

#define T_NONE 0
#define T_P0 1
#define T_GEMM 2
#define T_AMLA 3
#define T_ADIFF 4
#define T_HY 5
#define T_TR 6
#define T_FINAL 7
constexpr int N_PHASES = 1 + 4 * 7 + 1;
__host__ __device__ __forceinline__ int layer_kind(int layer) { return layer == 1 ? 1 : (layer == 2 ? 2 : 0); }
__host__ __device__ __forceinline__ int phase_type(int ph, bool& sync_after) {
    sync_after = true;
    if (ph == 0) return T_P0;
    if (ph == N_PHASES - 1) { sync_after = false; return T_FINAL; }
    const int layer = (ph - 1) / 7, slot = (ph - 1) % 7, kind = layer_kind(layer);
    if (slot == 0 || slot >= 4) return T_GEMM;
    if (kind == 0) { if (slot == 1) { sync_after = false; return T_GEMM; } if (slot == 2) return T_GEMM; return T_AMLA; }
    if (kind == 1) { if (slot == 1) return T_HY; if (slot == 2) return T_TR; sync_after = false; return T_NONE; }
    if (slot == 1) return T_ADIFF; sync_after = false; return T_NONE;
}

struct Ctx {
    unsigned char* ws; bf16_t* WB; bf16_t* XB; bf16_t* AO; float* SSQ; float* MC; float* MS; float* DC; float* DS; float* H3; float* X;
};
__device__ __forceinline__ Ctx make_ctx(KA& a) {
    Ctx c; c.ws = a.ws; c.WB = (bf16_t*)(a.ws + WS_W); c.XB = (bf16_t*)(a.ws + WS_XB); c.AO = (bf16_t*)(a.ws + WS_AO); c.SSQ = (float*)(a.ws + WS_SSQ);
    c.MC = (float*)(a.ws + WS_MC); c.MS = (float*)(a.ws + WS_MS); c.DC = (float*)(a.ws + WS_DC); c.DS = (float*)(a.ws + WS_DS); c.H3 = (float*)(a.ws + WS_H3); c.X = a.out; return c;
}

__device__ __forceinline__ void phase_p0(KA& a, LAS unsigned char* lds) {
    const Ctx c = make_ctx(a);
    const int tid = ltid(), lane = tid & 63, wave = __builtin_amdgcn_readfirstlane(tid >> 6);
    const int G = gridDim.x, bx = lbid(), gw = bx * 8 + wave, NGW = G * 8, gt = bx * 512 + tid, NGT = G * 512;
    bf16_t* WB = c.WB; float* SSQ = c.SSQ;
    for (int i = gt; i < 13 * 8 * S - S; i += NGT) SSQ[S + i] = 0.f;
    LAS float* scr = (LAS float*)(lds + wave * 16384);
#define CJ(src, K_, N_, gptr, off_, kind_) do { const float* W = a.in[src]; const float* g = gptr; const int nitems = ((K_) / 64) * ((N_) / 32); \
        _Pragma("unroll 1") for (int it = gw; it < nitems; it += NGW) cvt_item(W, K_, N_, g, WB + (off_), kind_, scr, it, lane); } while (0)
    CJ(2, 2048, 1344, a.in[1], W0_IN, MAP_MLA_IN); CJ(4, 768, 3072, a.in[3], W0_UQ, MAP_UQ); CJ(6, 512, 4096, a.in[5], W0_UKV, MAP_ID); CJ(7, 2048, 2048, nullptr, W0_O, MAP_ID);
    CJ(9, 2048, 5632, a.in[8], W0_GU, MAP_GATE); CJ(10, 2048, 5632, a.in[8], W0_GU, MAP_UP); CJ(11, 5632, 2048, nullptr, W0_DN, MAP_ID);
    CJ(13, 2048, 6144, a.in[12], W1_IN, MAP_ID); CJ(25, 2048, 2048, nullptr, W1_O, MAP_ID);
    CJ(28, 2048, 5632, a.in[26], W1_GU, MAP_UP); CJ(29, 5632, 2048, nullptr, W1_DN, MAP_ID);
    CJ(31, 2048, 6144, a.in[30], W2_IN, MAP_DQKV); CJ(37, 2048, 2048, nullptr, W2_O, MAP_ID);
    CJ(40, 2048, 5632, a.in[38], W2_GU, MAP_UP); CJ(41, 5632, 2048, nullptr, W2_DN, MAP_ID);
    CJ(43, 2048, 1344, a.in[42], W3_IN, MAP_MLA_IN); CJ(45, 768, 3072, a.in[44], W3_UQ, MAP_UQ); CJ(47, 512, 4096, a.in[46], W3_UKV, MAP_ID); CJ(48, 2048, 2048, nullptr, W3_O, MAP_ID);
    CJ(51, 2048, 5632, a.in[49], W3_GU, MAP_UP); CJ(52, 5632, 2048, nullptr, W3_DN, MAP_ID);
#undef CJ
    for (int i = gt; i < 2 * 192 * 256; i += NGT) {
        const int mtx = i / (192 * 256), rem = i % (192 * 256), rr = rem / 256, ch = rem % 256;
        const int row = rr < 96 ? 1312 + rr : 1440 + (rr - 96);
        *(u32x4*)(WB + (mtx ? W3_IN : W0_IN) + (size_t)row * 2048 + ch * 8) = (u32x4){0u, 0u, 0u, 0u};
    }
#pragma unroll 1
    for (int r = gw; r < S; r += NGW) {
        const f32x4* xr = (const f32x4*)(a.in[0] + (size_t)r * D) + lane; f32x4* xo = (f32x4*)(c.X + (size_t)r * D) + lane;
        u32x2* xb = (u32x2*)(c.XB + (size_t)r * D) + lane; float s2 = 0.f;
#pragma unroll
        for (int j = 0; j < 8; ++j) { const f32x4 v = xr[64 * j]; s2 += (v.x * v.x + v.y * v.y) + (v.z * v.z + v.w * v.w);
            u32x2 w; w.x = cvt_pk_bf16(v.x, v.y); w.y = cvt_pk_bf16(v.z, v.w); xb[64 * j] = w; }
        s2 = wave_sum(s2); if (lane == 0) SSQ[r] = s2;
    }
#pragma unroll 1
    for (int i = gt; i < S * 32; i += NGT) { const int pos = i >> 5, f = i & 31;
        const float inv = (float)exp(-9.210340371976184 * ((double)(2 * f) / 64.0)); const float ang = (float)pos * inv;
        float s, cc; sincos_acc(ang, s, cc); c.MC[i] = cc; c.MS[i] = s; }
#pragma unroll 1
    for (int i = gt; i < S * 64; i += NGT) { const int pos = i >> 6, f = i & 63;
        const float inv = (float)exp(-9.210340371976184 * ((double)(2 * f) / 128.0)); const float ang = (float)pos * inv;
        float s, cc; sincos_acc(ang, s, cc); c.DC[i] = cc; c.DS[i] = s; }
    {
        LAS float* hs = (LAS float*)(lds + 131072 + wave * 1024);
        const float* W1 = a.in[16]; const float* b1 = a.in[17]; const float* fr = a.in[18]; const float* W2 = a.in[19]; const float* b2 = a.in[20];
        const float* W3 = a.in[21]; const float* b3 = a.in[22];
#pragma unroll 1
        for (int l = gw; l < S; l += NGW) {
            asm volatile("" ::: "memory");
            const float fq = fr[lane];
            const float t = (float)l * (1.0f / 8191.0f); const float w = 6.283185307179586f * (float)l / 8192.0f;
            if (lane < 33) { float z;
                if (lane == 0) z = t;
                else { const int k = (lane - 1) & 15; const float f = 1e-4f + (float)k * ((15.0f - 1e-4f) / 15.0f); float s, cc; sincos_acc(f * w, s, cc); z = (lane <= 16) ? cc : -s; }
                hs[lane] = z; }
            LDS_WAIT();
            float acc = 0.f;
#pragma unroll 3
            for (int k = 0; k < 33; ++k) acc = fmaf(hs[k], W1[k * 64 + lane], acc);
            float h = sin_acc(fq * (acc + b1[lane])); hs[64 + lane] = h; LDS_WAIT();
            acc = 0.f;
#pragma unroll 4
            for (int k = 0; k < 64; ++k) acc = fmaf(hs[64 + k], W2[k * 64 + lane], acc);
            h = sin_acc(fq * (acc + b2[lane])); hs[128 + lane] = h; LDS_WAIT();
            acc = 0.f;
#pragma unroll 4
            for (int k = 0; k < 64; ++k) acc = fmaf(hs[128 + k], W3[k * 64 + lane], acc);
            h = sin_acc(fq * (acc + b3[lane])); c.H3[(((size_t)(lane >> 2) * S) + l) * 4 + (lane & 3)] = h;
            LDS_WAIT();
        }
    }
    __syncthreads();
}

__device__ __forceinline__ void phase_gemm(KA& a, int ph, LAS unsigned char* lds) {
    const Ctx c = make_ctx(a); unsigned char* ws = c.ws;
    const int layer = (ph - 1) / 7, slot = (ph - 1) % 7, kind = layer_kind(layer);
    const size_t w_in = layer == 0 ? W0_IN : layer == 1 ? W1_IN : layer == 2 ? W2_IN : W3_IN;
    const size_t w_o = layer == 0 ? W0_O : layer == 1 ? W1_O : layer == 2 ? W2_O : W3_O;
    const size_t w_gu = layer == 0 ? W0_GU : layer == 1 ? W1_GU : layer == 2 ? W2_GU : W3_GU;
    const size_t w_dn = layer == 0 ? W0_DN : layer == 1 ? W1_DN : layer == 2 ? W2_DN : W3_DN;
    const size_t w_uq = layer == 0 ? W0_UQ : W3_UQ, w_ukv = layer == 0 ? W0_UKV : W3_UKV;
    float* ssq_mix = c.SSQ + (size_t)(2 * layer) * 8 * S; float* ssq_ffn = c.SSQ + (size_t)(2 * layer + 1) * 8 * S; float* ssq_nxt = c.SSQ + (size_t)(2 * layer + 2) * 8 * S;
    float* ssq_cq = c.SSQ + (size_t)(9 + (layer ? 2 : 0)) * 8 * S; float* ssq_ckv = ssq_cq + 8 * S;
    Epi E{}; E.exch = (LAS float*)(lds + 131072); const bf16_t* A = c.XB; const bf16_t* Bt = c.WB; int N = 2048, K = 2048;
    if (slot == 0) {
        E.ssq_in = ssq_mix; E.inv_k = 1.f / 2048.f; Bt = c.WB + w_in;
        if (kind == 0) { E.mode = EM_MLA_IN; E.o0 = (bf16_t*)(ws + R_CQ); E.o1 = (bf16_t*)(ws + R_CKV); E.o2 = (bf16_t*)(ws + R_K); E.ssq_out = ssq_cq; E.ssq_out2 = ssq_ckv; E.cs = c.MC; E.sn = c.MS; N = 1536; }
        else if (kind == 1) { E.mode = EM_HY_IN; E.o0 = (bf16_t*)(ws + R_UT); N = 6144; }
        else { E.mode = EM_DIFF_QKV; E.o0 = (bf16_t*)(ws + R_QD); E.o1 = (bf16_t*)(ws + R_KD); E.o2 = (bf16_t*)(ws + R_VD); E.cs = c.DC; E.sn = c.DS; N = 6144; }
    } else if (slot == 1) { E.mode = EM_MLA_UQ; E.ssq_in = ssq_cq; E.inv_k = 1.f / 768.f; E.o0 = (bf16_t*)(ws + R_Q); E.cs = c.MC; E.sn = c.MS; A = (const bf16_t*)(ws + R_CQ); Bt = c.WB + w_uq; N = 3072; K = 768; }
    else if (slot == 2) { E.mode = EM_MLA_UKV; E.ssq_in = ssq_ckv; E.inv_k = 1.f / 512.f; E.o0 = (bf16_t*)(ws + R_K); E.o1 = (bf16_t*)(ws + R_V); A = (const bf16_t*)(ws + R_CKV); Bt = c.WB + w_ukv; N = 4096; K = 512; }
    else if (slot == 4) { E.mode = EM_RES; E.xr = (layer == 0) ? a.in[0] : nullptr; E.o0 = c.XB; E.ssq_out = ssq_ffn; A = c.AO; Bt = c.WB + w_o; }
    else if (slot == 5) { E.mode = EM_GU; E.ssq_in = ssq_ffn; E.inv_k = 1.f / 2048.f; E.o0 = (bf16_t*)(ws + R_H); Bt = c.WB + w_gu; N = 11264; }
    else { E.mode = EM_RES; E.xr = nullptr; E.o0 = c.XB; E.ssq_out = ssq_nxt; A = (const bf16_t*)(ws + R_H); Bt = c.WB + w_dn; K = 5632; }
    pg8::Gemm g{A, Bt, S, N, K}; pg8::StaticOrder so; so.init(S, N, (int)gridDim.x, lbid());
    pg8::gemm_phase<Epi, pg8::StaticOrder>(lds, g, so, E);
    if (slot == 5 && layer < 3) {
        const int G = gridDim.x, bx = lbid(), first = (32 * 44) % G, nconv = G - first;
        if (bx >= first) { const int tid = ltid(), lane = tid & 63, wave = __builtin_amdgcn_readfirstlane(tid >> 6);
            const float* Wg = layer == 0 ? a.in[27] : layer == 1 ? a.in[39] : a.in[50];
            const float* gn = layer == 0 ? a.in[26] : layer == 1 ? a.in[38] : a.in[49];
            const size_t wo = layer == 0 ? W1_GU : layer == 1 ? W2_GU : W3_GU;
            cvt_gate_tail(Wg, gn, c.WB + wo, (LAS float*)(lds + wave * 16384), (bx - first) * 8 + wave, nconv * 8, lane); }
    }
}

__device__ __forceinline__ void phase_amla(KA& a, char* lds) {
    unsigned char* ws = a.ws; bf16_t* AO = (bf16_t*)(ws + WS_AO);
    const bf16_t* Q = (const bf16_t*)(ws + R_Q); const bf16_t* Kk = (const bf16_t*)(ws + R_K); const bf16_t* V = (const bf16_t*)(ws + R_V);
    const int G = gridDim.x, bx = lbid();
#pragma unroll 1
    for (int it = bx; it < 512; it += G) {
        const int h = (it & 7) + 8 * (it >> 8), qb = (it >> 3) & 31; const size_t q0 = (size_t)qb * 256;
        att::ATT192FN<192, 192, 128, 2048>(Q + ((size_t)h * S + q0) * 192, Kk + (size_t)h * S * 192, V + (size_t)h * S * 128, AO + q0 * 2048 + h * 128, S, lds);
    }
}

__device__ __forceinline__ void phase_adiff(KA& a, char* lds) {
    unsigned char* ws = a.ws; bf16_t* AO = (bf16_t*)(ws + WS_AO);
    const int G = gridDim.x, bx = lbid();
    const bf16_t* Qd = (const bf16_t*)(ws + R_QD); const bf16_t* Kd = (const bf16_t*)(ws + R_KD); const bf16_t* Vd = (const bf16_t*)(ws + R_VD);
    bf16_t* T = (bf16_t*)(ws + R_T) + (size_t)bx * (2 * 256 * 256);
#pragma unroll 1
    for (int it = bx; it < 256; it += G) {
        const int h = it & 7, qb = it >> 3; const size_t q0 = (size_t)qb * 256;
#pragma unroll 1
        for (int comp = 0; comp < 2; ++comp) {
            att::attn_body_dv256<128, 128, 256, 256>(Qd + ((size_t)(2 * h + comp) * S + q0) * 128, Kd + (size_t)(2 * h + comp) * S * 128, Vd + (size_t)h * S * 256,
                                                     T + comp * (256 * 256), S, lds);
        }
        __syncthreads();
        const int tid = ltid(), lane = tid & 63, wave = __builtin_amdgcn_readfirstlane(tid >> 6);
        float lam; { const float* lq1 = a.in[32]; const float* lk1 = a.in[33]; const float* lq2 = a.in[34]; const float* lk2 = a.in[35];
            float s1 = lq1[lane] * lk1[lane] + lq1[lane + 64] * lk1[lane + 64], s2 = lq2[lane] * lk2[lane] + lq2[lane + 64] * lk2[lane + 64];
            s1 = wave_sum(s1); s2 = wave_sum(s2); lam = __expf(s1) - __expf(s2) + 0.470713018f; }
        const float* subln = a.in[36];
        const f32x4 gsub = *(const f32x4*)(subln + 4 * lane);
#pragma unroll 1
        for (int rr = 0; rr < 32; ++rr) { const int row = wave * 32 + rr;
            const u32x2 w0 = *(const u32x2*)(T + (size_t)row * 256 + 4 * lane), w1 = *(const u32x2*)(T + 256 * 256 + (size_t)row * 256 + 4 * lane);
            const f32x4 t0 = {__uint_as_float(w0.x << 16), __uint_as_float(w0.x & 0xffff0000u), __uint_as_float(w0.y << 16), __uint_as_float(w0.y & 0xffff0000u)};
            const f32x4 t1 = {__uint_as_float(w1.x << 16), __uint_as_float(w1.x & 0xffff0000u), __uint_as_float(w1.y << 16), __uint_as_float(w1.y & 0xffff0000u)};
            const f32x4 d = t0 - t1 * lam;
            float s2 = (d.x * d.x + d.y * d.y) + (d.z * d.z + d.w * d.w); s2 = wave_sum(s2);
            const float rn = rsqrtf(s2 * (1.f / 256.f) + 1e-5f) * (1.f - 0.470713018f);
            const f32x4 ov = d * rn * gsub;
            u32x2 w; w.x = cvt_pk_bf16(ov.x, ov.y); w.y = cvt_pk_bf16(ov.z, ov.w);
            *(u32x2*)(AO + (q0 + row) * 2048 + h * 256 + 4 * lane) = w;
        }
        __syncthreads();
    }
}

__device__ __forceinline__ void phase_hyena(KA& a, LAS unsigned char* lds) {
    unsigned char* ws = a.ws; const float* H3 = (const float*)(ws + WS_H3);
    const int tid = ltid(); const int G = gridDim.x, bx = lbid();
    LAS f32x2* L = (LAS f32x2*)lds;
    LAS float* w8s = (LAS float*)(lds + 147456);
    LAS float* red = (LAS float*)(lds + 147456 + 2048);
    const bf16_t* UT = (const bf16_t*)(ws + R_UT);
    bf16_t* YT = (bf16_t*)(ws + R_YT);
    f32x2* SP0 = (f32x2*)(ws + R_SPEC) + (size_t)bx * 2 * FN; f32x2* SP1 = SP0 + FN;
    unsigned* SPb0 = (unsigned*)SP0; unsigned* SPb1 = SPb0 + FN;
    unsigned* Z1 = (unsigned*)(ws + R_Z1) + (size_t)bx * S;
    const float* cw = a.in[14]; const float* cb = a.in[15]; const float* W4 = a.in[23]; const float* hb = a.in[24];
#pragma unroll 1
    for (int pp = bx; pp < 1024; pp += G) {
        const int ca = 2 * pp, cbn = 2 * pp + 1;
        const float dla = fabsf(-3.0701134573253944f + (float)ca * ((-15.350567286626972f + 3.0701134573253944f) / 2047.0f));
        const float dlb = fabsf(-3.0701134573253944f + (float)cbn * ((-15.350567286626972f + 3.0701134573253944f) / 2047.0f));
#pragma unroll 1
        for (int rk = 0; rk < 1 + HY_REP_KERN; ++rk) {
        __syncthreads();
        { const int k = tid >> 3, j = tid & 7, o = j >> 2, jj = j & 3;
          w8s[tid] = W4[(size_t)k * 8192 + (jj >> 1) * 4096 + o * 2048 + ((jj & 1) ? cbn : ca)]; }
        __syncthreads();
        float sa0 = 0.f, sb0 = 0.f, sa1 = 0.f, sb1 = 0.f;
#pragma unroll 1
        for (int g = 0; g < 4; ++g) {
            const int lbase = tid + 2048 * g;
            f32x4 acc0[4], acc1[4];
#pragma unroll
            for (int li = 0; li < 4; ++li) { acc0[li] = (f32x4){0.f, 0.f, 0.f, 0.f}; acc1[li] = (f32x4){0.f, 0.f, 0.f, 0.f}; }
#pragma unroll 2
            for (int k4 = 0; k4 < 16; ++k4) {
                f32x4 hv[4];
#pragma unroll
                for (int li = 0; li < 4; ++li) hv[li] = *(const f32x4*)(H3 + ((size_t)k4 * S + (lbase + 512 * li)) * 4);
#pragma unroll
                for (int e = 0; e < 4; ++e) { const f32x4 wA = *(const LAS f32x4*)(w8s + (k4 * 4 + e) * 8), wB = *(const LAS f32x4*)(w8s + (k4 * 4 + e) * 8 + 4);
#pragma unroll
                    for (int li = 0; li < 4; ++li) { acc0[li] += wA * hv[li][e]; acc1[li] += wB * hv[li][e]; } }
            }
#pragma unroll
            for (int li = 0; li < 4; ++li) { const int l = lbase + 512 * li;
                const float t = (float)l * (1.0f / 8191.0f);
                const float da = __expf(-t * dla), db = __expf(-t * dlb);
                const f32x2 f0 = (f32x2){acc0[li][0] * da, acc0[li][1] * db}, b0 = (f32x2){acc0[li][2] * da, acc0[li][3] * db};
                const f32x2 f1 = (f32x2){acc1[li][0] * da, acc1[li][1] * db}, b1 = (f32x2){acc1[li][2] * da, acc1[li][3] * db};
                L[FP(l)] = f0; SP1[l] = f1; sa0 += fabsf(f0.x); sb0 += fabsf(f0.y); sa1 += fabsf(f1.x); sb1 += fabsf(f1.y);
                if (l == 0) { L[FP(S)] = (f32x2){0.f, 0.f}; SP1[S] = (f32x2){0.f, 0.f}; }
                else { L[FP(FN - l)] = b0; SP1[FN - l] = b1; sa0 += fabsf(b0.x); sb0 += fabsf(b0.y); sa1 += fabsf(b1.x); sb1 += fabsf(b1.y); }
            }
        }
        const float ta0 = block_sum(sa0, red, tid); const float tb0 = block_sum(sb0, red, tid);
        const float ta1 = block_sum(sa1, red, tid); const float tb1 = block_sum(sb1, red, tid);
        { const float ia = 1.f / ta0, ib = 1.f / tb0;
#pragma unroll 1
          for (int p = tid; p < FN; p += 512) { f32x2 v = L[FP(p)]; v.x *= ia; v.y *= ib; L[FP(p)] = v; } }
        fft_fwd(L, tid);
#pragma unroll 4
        for (int i = 0; i < 16; ++i) { const int p = 2 * (tid + 512 * i); const f32x4 v = *(const LAS f32x4*)(L + FP(p)); u32x2 w; w.x = cvt_pk_bf16(v[0], v[1]); w.y = cvt_pk_bf16(v[2], v[3]); *(u32x2*)(SPb0 + p) = w; }
        __syncthreads();
        { const float ia = 1.f / ta1, ib = 1.f / tb1;
#pragma unroll 4
          for (int i = 0; i < 16; ++i) { const int p = 2 * (tid + 512 * i); f32x4 v = *(const f32x4*)(SP1 + p); v[0] *= ia; v[1] *= ib; v[2] *= ia; v[3] *= ib; *(LAS f32x4*)(L + FP(p)) = v; } }
        fft_fwd(L, tid);
#pragma unroll 4
        for (int i = 0; i < 16; ++i) { const int p = 2 * (tid + 512 * i); const f32x4 v = *(const LAS f32x4*)(L + FP(p)); u32x2 w; w.x = cvt_pk_bf16(v[0], v[1]); w.y = cvt_pk_bf16(v[2], v[3]); *(u32x2*)(SPb1 + p) = w; }
        __syncthreads();
        }
        const bf16_t* ux1a = UT + (size_t)ca * S; const bf16_t* ux1b = UT + (size_t)cbn * S;
        const bf16_t* ux2a = UT + (size_t)(D + ca) * S; const bf16_t* ux2b = UT + (size_t)(D + cbn) * S;
        const bf16_t* uva = UT + (size_t)(2 * D + ca) * S; const bf16_t* uvb = UT + (size_t)(2 * D + cbn) * S;
#define BF2F(u16) __uint_as_float(((unsigned)(u16)) << 16)
#define SCONV4(dst, up, ch, t) do { const u32x2 xw_ = *(const u32x2*)((up) + (t)); const f32x4 x_ = {__uint_as_float(xw_.x << 16), __uint_as_float(xw_.x & 0xffff0000u), __uint_as_float(xw_.y << 16), __uint_as_float(xw_.y & 0xffff0000u)}; \
        const float xm_ = ((t) > 0) ? BF2F((up)[(t) - 1]) : 0.f, xp_ = ((t) + 4 < S) ? BF2F((up)[(t) + 4]) : 0.f; \
        const float w0_ = cw[ch], w1_ = cw[6144 + (ch)], w2_ = cw[2 * 6144 + (ch)], bb_ = cb[ch]; \
        dst[0] = xm_ * w0_ + x_[0] * w1_ + x_[1] * w2_ + bb_; dst[1] = x_[0] * w0_ + x_[1] * w1_ + x_[2] * w2_ + bb_; \
        dst[2] = x_[1] * w0_ + x_[2] * w1_ + x_[3] * w2_ + bb_; dst[3] = x_[2] * w0_ + x_[3] * w1_ + xp_ * w2_ + bb_; } while (0)
#pragma unroll 2
        for (int i = 0; i < 4; ++i) { const int t = 4 * (tid + 512 * i);
            f32x4 za, zb; SCONV4(za, uva, 2 * D + ca, t); SCONV4(zb, uvb, 2 * D + cbn, t);
            const f32x4 p01 = {za[0], zb[0], za[1], zb[1]}, p23 = {za[2], zb[2], za[3], zb[3]};
            *(LAS f32x4*)(L + FP(t)) = p01; *(LAS f32x4*)(L + FP(t) + 2) = p23;
            *(LAS f32x4*)(L + FP(S + t)) = (f32x4){0.f, 0.f, 0.f, 0.f}; *(LAS f32x4*)(L + FP(S + t) + 2) = (f32x4){0.f, 0.f, 0.f, 0.f};
            { u32x4 zw; zw.x = cvt_pk_bf16(p01[0], p01[1]); zw.y = cvt_pk_bf16(p01[2], p01[3]); zw.z = cvt_pk_bf16(p23[0], p23[1]); zw.w = cvt_pk_bf16(p23[2], p23[3]); *(u32x4*)(Z1 + t) = zw; } }
        fft_fwd(L, tid);
        spec_mul(L, SPb0, tid);
        fft_inv(L, tid);
        const float b0a = hb[ca], b0b = hb[cbn], b1a = hb[D + ca], b1b = hb[D + cbn];
        const float invn = 1.0f / (float)FN;
#pragma unroll 2
        for (int i = 0; i < 4; ++i) { const int t = 4 * (tid + 512 * i);
            f32x4 ga, gb; SCONV4(ga, ux1a, ca, t); SCONV4(gb, ux1b, cbn, t);
            const f32x4 c01 = *(const LAS f32x4*)(L + FP(t)), c23 = *(const LAS f32x4*)(L + FP(t) + 2);
            const u32x4 zw_ = *(const u32x4*)(Z1 + t);
            const f32x4 z01 = {__uint_as_float(zw_.x << 16), __uint_as_float(zw_.x & 0xffff0000u), __uint_as_float(zw_.y << 16), __uint_as_float(zw_.y & 0xffff0000u)};
            const f32x4 z23 = {__uint_as_float(zw_.z << 16), __uint_as_float(zw_.z & 0xffff0000u), __uint_as_float(zw_.w << 16), __uint_as_float(zw_.w & 0xffff0000u)};
            const f32x4 n01 = {ga[0] * (c01[0] * invn + z01[0] * b0a), gb[0] * (c01[1] * invn + z01[1] * b0b), ga[1] * (c01[2] * invn + z01[2] * b0a), gb[1] * (c01[3] * invn + z01[3] * b0b)};
            const f32x4 n23 = {ga[2] * (c23[0] * invn + z23[0] * b0a), gb[2] * (c23[1] * invn + z23[1] * b0b), ga[3] * (c23[2] * invn + z23[2] * b0a), gb[3] * (c23[3] * invn + z23[3] * b0b)};
            { u32x4 zw; zw.x = cvt_pk_bf16(n01[0], n01[1]); zw.y = cvt_pk_bf16(n01[2], n01[3]); zw.z = cvt_pk_bf16(n23[0], n23[1]); zw.w = cvt_pk_bf16(n23[2], n23[3]); *(u32x4*)(Z1 + t) = zw; }
            *(LAS f32x4*)(L + FP(t)) = n01; *(LAS f32x4*)(L + FP(t) + 2) = n23;
            *(LAS f32x4*)(L + FP(S + t)) = (f32x4){0.f, 0.f, 0.f, 0.f}; *(LAS f32x4*)(L + FP(S + t) + 2) = (f32x4){0.f, 0.f, 0.f, 0.f}; }
        fft_fwd(L, tid);
        spec_mul(L, SPb1, tid);
        fft_inv(L, tid);
#pragma unroll 2
        for (int i = 0; i < 4; ++i) { const int t = 4 * (tid + 512 * i);
            f32x4 ga, gb; SCONV4(ga, ux2a, D + ca, t); SCONV4(gb, ux2b, D + cbn, t);
            const f32x4 c01 = *(const LAS f32x4*)(L + FP(t)), c23 = *(const LAS f32x4*)(L + FP(t) + 2);
            const u32x4 zw_ = *(const u32x4*)(Z1 + t);
            const f32x4 z01 = {__uint_as_float(zw_.x << 16), __uint_as_float(zw_.x & 0xffff0000u), __uint_as_float(zw_.y << 16), __uint_as_float(zw_.y & 0xffff0000u)};
            const f32x4 z23 = {__uint_as_float(zw_.z << 16), __uint_as_float(zw_.z & 0xffff0000u), __uint_as_float(zw_.w << 16), __uint_as_float(zw_.w & 0xffff0000u)};
            const float ya0 = ga[0] * (c01[0] * invn + z01[0] * b1a), yb0 = gb[0] * (c01[1] * invn + z01[1] * b1b);
            const float ya1 = ga[1] * (c01[2] * invn + z01[2] * b1a), yb1 = gb[1] * (c01[3] * invn + z01[3] * b1b);
            const float ya2 = ga[2] * (c23[0] * invn + z23[0] * b1a), yb2 = gb[2] * (c23[1] * invn + z23[1] * b1b);
            const float ya3 = ga[3] * (c23[2] * invn + z23[2] * b1a), yb3 = gb[3] * (c23[3] * invn + z23[3] * b1b);
            u32x2 wa, wb; wa.x = cvt_pk_bf16(ya0, ya1); wa.y = cvt_pk_bf16(ya2, ya3); wb.x = cvt_pk_bf16(yb0, yb1); wb.y = cvt_pk_bf16(yb2, yb3);
            *(u32x2*)(YT + (size_t)ca * S + t) = wa; *(u32x2*)(YT + (size_t)cbn * S + t) = wb; }
#undef SCONV4
        __syncthreads();
    }
}

__device__ __forceinline__ void phase_tr(KA& a, LAS unsigned char* lds) {
    unsigned char* ws = a.ws; bf16_t* AO = (bf16_t*)(ws + WS_AO); const bf16_t* YT = (const bf16_t*)(ws + R_YT);
    const int tid = ltid(); const int G = gridDim.x, bx = lbid();
    LAS bf16_t* tl = (LAS bf16_t*)lds;
#pragma unroll 1
    for (int tile = bx; tile < 32 * 128; tile += G) {
        const int c0 = (tile & 31) * 64, t0 = (tile >> 5) * 64;
        __syncthreads();
        { const int i = tid >> 3, j8 = tid & 7;
          const bf16x8 v = *(const bf16x8*)(YT + (size_t)(c0 + i) * S + t0 + j8 * 8);
#pragma unroll
          for (int e = 0; e < 8; ++e) tl[(j8 * 8 + e) * 72 + i] = (bf16_t)v[e]; }
        __syncthreads();
        { const int tt = tid >> 3, c8 = tid & 7;
          const bf16x8 v = *(const LAS bf16x8*)(tl + tt * 72 + c8 * 8);
          *(bf16x8*)(AO + (size_t)(t0 + tt) * D + c0 + c8 * 8) = v; }
    }
    __syncthreads();
}

__device__ __forceinline__ void phase_final(KA& a) {
    const int tid = ltid(), lane = tid & 63, wave = __builtin_amdgcn_readfirstlane(tid >> 6);
    const int gw = lbid() * 8 + wave, NGW = gridDim.x * 8;
    const float* gfin = a.in[53]; const float* ssq = (const float*)(a.ws + WS_SSQ) + (size_t)8 * 8 * S; float* X = a.out;
#pragma unroll 1
    for (int r = gw; r < S; r += NGW) {
        float tsum = 0.f;
#pragma unroll
        for (int p = 0; p < 8; ++p) tsum += ssq[(size_t)p * S + r];
        const float rs = rsqrtf(tsum * (1.f / 2048.f) + RMS_EPS);
        f32x4* xo = (f32x4*)(X + (size_t)r * D) + lane; const f32x4* gg = (const f32x4*)gfin + lane;
        const u32x2* xb = (const u32x2*)((const bf16_t*)(a.ws + WS_XB) + (size_t)r * D) + lane;
#pragma unroll
        for (int j = 0; j < 8; ++j) { const u32x2 w = xb[64 * j];
            const f32x4 v = {__uint_as_float(w.x << 16), __uint_as_float(w.x & 0xffff0000u), __uint_as_float(w.y << 16), __uint_as_float(w.y & 0xffff0000u)};
            xo[64 * j] = v * rs * gg[64 * j]; }
    }
}

template <int TYPE> __device__ __forceinline__ void run_phase(KA& a, int ph, unsigned char* lds_raw) {
    LAS unsigned char* lds = (LAS unsigned char*)lds_raw;
    if constexpr (TYPE == T_P0) phase_p0(a, lds);
    else if constexpr (TYPE == T_GEMM) phase_gemm(a, ph, lds);
    else if constexpr (TYPE == T_AMLA) phase_amla(a, (char*)lds_raw);
    else if constexpr (TYPE == T_ADIFF) phase_adiff(a, (char*)lds_raw);
    else if constexpr (TYPE == T_HY) phase_hyena(a, lds);
    else if constexpr (TYPE == T_TR) phase_tr(a, lds);
    else if constexpr (TYPE == T_FINAL) phase_final(a);
}

template <int TYPE> __global__ void __launch_bounds__(512, 2) phase_kernel(Args a_) {
    extern __shared__ __attribute__((aligned(16))) unsigned char lds_raw[];
    KA& a = *largs();
    run_phase<TYPE>(a, a.ph_lo, lds_raw);
}

#ifndef HY_REP_FFT
#define HY_REP_FFT 0
#endif
#ifndef MK_REPEAT_MASK
#define MK_REPEAT_MASK 0
#endif
#ifndef MK_CUTS
#define MK_CUTS 0, N_PHASES
#endif
#ifndef MEGA_MASK
#define MEGA_MASK 0xff
#endif
#if !MK_MULTI
__global__ void __launch_bounds__(512, 2) mega_fwd(Args a_) {
    extern __shared__ __attribute__((aligned(16))) unsigned char lds_raw[];
    const int ph_lo = a_.ph_lo, ph_hi = a_.ph_hi;
    if (ph_hi < 0) cg::this_grid().sync();
    volatile LAS unsigned* stw = (volatile LAS unsigned*)((LAS unsigned char*)lds_raw + LDS_BYTES - 16);
    if (threadIdx.x == 0) { stw[0] = 0u; stw[1] = 0u; }
    __syncthreads();
    const XcdBarrier bar = xcd_barrier_post((unsigned*)(a_.ws + WS_BAR) + (size_t)a_.li * XCD_BAR_WORDS, stw);
    if (ph_lo == 0) {
#pragma unroll 1
        for (int r0 = 0; r0 < ((MK_REPEAT_MASK & 2) ? 2 : 1); ++r0) {
        { KA& a = *largs(); run_phase<T_P0>(a, 0, lds_raw); }
        if (ph_hi > 1) xcd_barrier(bar);
        }
    }
    const int l0 = ph_lo < 1 ? 1 : ph_lo, l1 = ph_hi < N_PHASES - 1 ? ph_hi : N_PHASES - 1;
    int rep = 0; (void)rep;
#pragma unroll 1
    for (int ph = l0; ph < l1; ++ph) {
        bool sync_after; const int ty = phase_type(ph, sync_after);
        KA& a = *largs();
        switch (ty) {
            case T_GEMM: run_phase<T_GEMM>(a, ph, lds_raw); break;
            case T_AMLA: run_phase<T_AMLA>(a, ph, lds_raw); break;
            case T_ADIFF: run_phase<T_ADIFF>(a, ph, lds_raw); break;
            case T_HY: run_phase<T_HY>(a, ph, lds_raw); break;
            case T_TR: run_phase<T_TR>(a, ph, lds_raw); break;
            default: break;
        }
        if (sync_after && ph + 1 < ph_hi) xcd_barrier(bar);
#if MK_REPEAT_MASK
        if (((MK_REPEAT_MASK >> ty) & 1) && !rep) { rep = 1; --ph; } else rep = 0;
#endif
    }
    if (ph_hi == N_PHASES) { KA& a = *largs(); run_phase<T_FINAL>(a, N_PHASES - 1, lds_raw); }
}
#endif
template <int TYPE> static void launch_phase(int grid, hipStream_t stream, Args a) {
    static bool attr = false;
    if (!attr) { (void)hipFuncSetAttribute((const void*)phase_kernel<TYPE>, hipFuncAttributeMaxDynamicSharedMemorySize, LDS_BYTES); attr = true; }
    hipLaunchKernelGGL(phase_kernel<TYPE>, dim3(grid), dim3(512), LDS_BYTES, stream, a);
}
extern "C" void kernel_launch(void* const* d_in, const int* in_sizes, int n_in, void* d_out, int out_size, void* d_ws, size_t ws_size, hipStream_t stream) {
    static int grid = 0;
    if (grid == 0) {
        if (n_in != 54 || out_size != S * D || ws_size < WS_END) { fprintf(stderr, "kernel_launch: bad shapes n_in %d out %d ws %zu (need %zu)\n", n_in, out_size, ws_size, (size_t)WS_END); grid = -1; return; }
        int dev = 0, cus = 0;
        (void)hipGetDevice(&dev); (void)hipDeviceGetAttribute(&cus, hipDeviceAttributeMultiprocessorCount, dev);
#if !MK_MULTI
        if (hipFuncSetAttribute((const void*)mega_fwd, hipFuncAttributeMaxDynamicSharedMemorySize, LDS_BYTES) != hipSuccess) { fprintf(stderr, "kernel_launch: hipFuncSetAttribute failed\n"); grid = -1; return; }
        int per_cu = 0;
        (void)hipOccupancyMaxActiveBlocksPerMultiprocessor(&per_cu, (const void*)mega_fwd, 512, LDS_BYTES);
        (void)hipGetLastError();
        if (per_cu < 1) fprintf(stderr, "kernel_launch: occupancy query says %d blocks per CU\n", per_cu);
#endif
        grid = cus > 0 ? cus : 256;
    }
    if (grid < 0) return;
    Args a{};
    for (int i = 0; i < 54; ++i) a.in[i] = (const float*)d_in[i];
    a.out = (float*)d_out; a.ws = (unsigned char*)d_ws;
#if MK_MULTI
    for (int p = 0; p < N_PHASES; ++p) {
        bool sa; const int ty = phase_type(p, sa); a.ph_lo = p; a.ph_hi = p + 1;
        switch (ty) {
            case T_P0: launch_phase<T_P0>(grid, stream, a); break;
            case T_GEMM: launch_phase<T_GEMM>(grid, stream, a); break;
            case T_AMLA: launch_phase<T_AMLA>(grid, stream, a); break;
            case T_ADIFF: launch_phase<T_ADIFF>(grid, stream, a); break;
            case T_HY: launch_phase<T_HY>(grid, stream, a); break;
            case T_TR: launch_phase<T_TR>(grid, stream, a); break;
            case T_FINAL: launch_phase<T_FINAL>(grid, stream, a); break;
            default: break;
        }
    }
#else
    {
        const int cuts[] = {MK_CUTS};
        const int ncut = (int)(sizeof(cuts) / sizeof(int));
        (void)hipMemsetAsync((char*)d_ws + WS_BAR, 0, 64 * 1024, stream);
        for (int i = 0; i + 1 < ncut; ++i) {
            a.ph_lo = cuts[i]; a.ph_hi = cuts[i + 1]; a.li = i;
            void* args[] = {&a};
            hipError_t e = hipLaunchCooperativeKernel((const void*)mega_fwd, dim3(grid), dim3(512), args, LDS_BYTES, stream);
            if (e != hipSuccess) fprintf(stderr, "kernel_launch: cooperative launch failed: %s (grid %d)\n", hipGetErrorString(e), grid);
        }
    }
#endif
}
```

```cpp
#include <hip/hip_runtime.h>
#include <hip/hip_bf16.h>
#include <hip/hip_cooperative_groups.h>
#include <cstdio>
#include <cstdint>
namespace cg = cooperative_groups;

#ifndef MK_MULTI
#define MK_MULTI 0
#endif

#ifndef HY_REP_FFT
#define HY_REP_FFT 0
#endif
#ifndef HY_REP_KERN
#define HY_REP_KERN 0
#endif
#define LAS __attribute__((address_space(3)))
typedef unsigned short bf16_t;
typedef short bf16x8 __attribute__((ext_vector_type(8)));
typedef short s16x4 __attribute__((ext_vector_type(4)));
typedef float f32x4 __attribute__((ext_vector_type(4)));
typedef float f32x2 __attribute__((ext_vector_type(2)));
typedef float f32x16 __attribute__((ext_vector_type(16)));
typedef unsigned u32x4 __attribute__((ext_vector_type(4)));
typedef unsigned u32x2 __attribute__((ext_vector_type(2)));

constexpr int S = 8192, D = 2048, FF = 5632, NT512 = 512;
constexpr float RMS_EPS = 1e-6f;
constexpr int LDS_BYTES = 155648;

constexpr size_t MiB = 1u << 20;
constexpr size_t E_IN = (size_t)1536 * 2048, E_UQ = (size_t)3072 * 768, E_UKV = (size_t)4096 * 512, E_O = (size_t)2048 * 2048,
                 E_GU = (size_t)11264 * 2048, E_DN = (size_t)2048 * 5632, E_HY = (size_t)6144 * 2048;
constexpr size_t W0_IN = 0, W0_UQ = W0_IN + E_IN, W0_UKV = W0_UQ + E_UQ, W0_O = W0_UKV + E_UKV, W0_GU = W0_O + E_O, W0_DN = W0_GU + E_GU;
constexpr size_t W1_IN = W0_DN + E_DN, W1_O = W1_IN + E_HY, W1_GU = W1_O + E_O, W1_DN = W1_GU + E_GU;
constexpr size_t W2_IN = W1_DN + E_DN, W2_O = W2_IN + E_HY, W2_GU = W2_O + E_O, W2_DN = W2_GU + E_GU;
constexpr size_t W3_IN = W2_DN + E_DN, W3_UQ = W3_IN + E_IN, W3_UKV = W3_UQ + E_UQ, W3_O = W3_UKV + E_UKV, W3_GU = W3_O + E_O, W3_DN = W3_GU + E_GU;
constexpr size_t W_END_E = W3_DN + E_DN;
constexpr size_t WS_W = 0;
constexpr size_t WS_XB = ((W_END_E * 2 + MiB - 1) / MiB) * MiB;
constexpr size_t WS_AO = WS_XB + 32 * MiB;
constexpr size_t WS_SSQ = WS_AO + 32 * MiB;
constexpr size_t WS_MC = WS_SSQ + 4 * MiB, WS_MS = WS_MC + 1 * MiB;
constexpr size_t WS_DC = WS_MS + 1 * MiB, WS_DS = WS_DC + 2 * MiB;
constexpr size_t WS_H3 = WS_DS + 2 * MiB;
constexpr size_t WS_BAR = WS_H3 + 2 * MiB;
constexpr size_t WS_R = WS_BAR + 1 * MiB;
constexpr size_t R_CQ = WS_R, R_CKV = R_CQ + 12 * MiB, R_Q = R_CKV + 8 * MiB, R_K = R_Q + 48 * MiB, R_V = R_K + 48 * MiB;
constexpr size_t R_UT = WS_R, R_YT = R_UT + 192 * MiB, R_SPEC = R_YT + 32 * MiB, R_Z1 = R_SPEC + 64 * MiB, R_HY_END = R_Z1 + 16 * MiB;
constexpr size_t R_QD = WS_R, R_KD = R_QD + 32 * MiB, R_VD = R_KD + 32 * MiB, R_T = R_VD + 32 * MiB;
constexpr size_t R_H = WS_R;
constexpr size_t WS_END = R_HY_END;

struct Args { const float* in[54]; float* out; unsigned char* ws; int ph_lo, ph_hi, li, pad; };
typedef const __attribute__((address_space(4))) Args KA;
__device__ __forceinline__ KA* largs() { KA* p = (KA*)__builtin_amdgcn_kernarg_segment_ptr(); asm volatile("" : "+s"(p)); return p; }

__device__ __forceinline__ unsigned cvt_pk_bf16(float lo, float hi) { unsigned r; asm volatile("v_cvt_pk_bf16_f32 %0, %1, %2" : "=v"(r) : "v"(lo), "v"(hi)); return r; }
__device__ __forceinline__ float wave_sum(float v) {
#pragma unroll
    for (int o = 1; o < 64; o <<= 1) v += __shfl_xor(v, o);
    return v;
}
__device__ __forceinline__ int ltid() { int t = threadIdx.x; asm volatile("" : "+v"(t)); return t; }
__device__ __forceinline__ int lbid() { int b = blockIdx.x; asm volatile("" : "+s"(b)); return b; }
#define LDS_WAIT() asm volatile("s_waitcnt lgkmcnt(0)" ::: "memory")
__device__ __forceinline__ void sincos_acc(float x, float& s, float& c) {
    const double xd = (double)x; const double q = __builtin_rint(xd * 0.15915494309189533577);
    const float r = (float)(xd - q * 6.283185307179586476925);
    float sgn = 1.f, rr = r;
    if (rr > 1.5707963267948966f) { rr = 3.14159265358979323846f - rr; sgn = -1.f; }
    else if (rr < -1.5707963267948966f) { rr = -3.14159265358979323846f - rr; sgn = -1.f; }
    const float z = rr * rr;
    float ps = -7.6471637318198164759e-13f; ps = fmaf(ps, z, 1.6059043836821614599e-10f); ps = fmaf(ps, z, -2.5052108385441718775e-8f); ps = fmaf(ps, z, 2.7557319223985890653e-6f);
    ps = fmaf(ps, z, -1.9841269841269841270e-4f); ps = fmaf(ps, z, 8.3333333333333333333e-3f); ps = fmaf(ps, z, -1.6666666666666666667e-1f);
    s = fmaf(rr * z, ps, rr);
    float pc = 4.7794773323873852974e-14f; pc = fmaf(pc, z, -1.1470745597729724714e-11f); pc = fmaf(pc, z, 2.0876756987868098979e-9f); pc = fmaf(pc, z, -2.7557319223985890653e-7f);
    pc = fmaf(pc, z, 2.4801587301587301587e-5f); pc = fmaf(pc, z, -1.3888888888888888889e-3f); pc = fmaf(pc, z, 4.1666666666666666667e-2f); pc = fmaf(pc, z, -0.5f);
    c = sgn * fmaf(pc, z, 1.0f);
}
__device__ __forceinline__ float sin_acc(float x) { float s, c; sincos_acc(x, s, c); return s; }

namespace pg8 {
#define PG8_LAS __attribute__((address_space(3)))
constexpr int BM = 256, BK = 64, HALF = 128, HTB = HALF * BK * 2, STAGE_BYTES = 8 * HTB, NXCD = 8, WGM = 8;
__host__ __device__ __forceinline__ int lds_byte(int r, int c) { const int st = (r >> 4) * 2 + (c >> 5), rr = r & 15, cc = c & 31, ob = rr * 64 + cc * 2; return st * 1024 + (ob ^ (((ob >> 9) & 1) << 5)); }
__host__ __device__ __forceinline__ void stage_rc(int b, int& R, int& C) { const int st = b / 1024, sb = b % 1024, swz = sb ^ (((sb >> 9) & 1) << 5); R = (st >> 1) * 16 + swz / 64; C = (st & 1) * 32 + (swz % 64) / 2; }
__host__ __device__ __forceinline__ int perm32(int rho) { const int n = rho >> 4, i = rho & 15; return 8 * (i >> 2) + 4 * n + (i & 3); }
struct Unit { int pm, pn; };
struct Gemm { const bf16_t* A; const bf16_t* Bt; int M, N, K; };
struct StaticOrder {
    int nM, nN, nwg, G, c;
    __host__ __device__ void init(int M, int N, int G_, int c_) { nM = M / BM; nN = N / BM; nwg = nM * nN; G = G_; c = c_; }
    __host__ __device__ bool next(int i, Unit& u) const {
        const long L = (long)i * G + c; if (L >= nwg) return false;
        int wgid = (int)L; { const int q = nwg / NXCD, r = nwg % NXCD, xcd = wgid % NXCD, off = wgid / NXCD; wgid = (xcd < r ? xcd * (q + 1) : r * (q + 1) + (xcd - r) * q) + off; }
        const int nig = WGM * nN, gid = wgid / nig, fm = gid * WGM, gsz = (nM - fm) < WGM ? (nM - fm) : WGM;
        u.pm = fm + ((wgid % nig) % gsz); u.pn = (wgid % nig) / gsz; return true;
    }
};

template <class Epi, class Sched>
__device__ __forceinline__ void gemm_phase(PG8_LAS unsigned char* lds, const Gemm g, const Sched& S, const Epi& E) {
    const int tid = ltid(), wid = __builtin_amdgcn_readfirstlane(tid >> 6), lane = tid & 63, wr = wid >> 2, wc = wid & 3, fr = lane & 15, fq = lane >> 4;
    const int K = g.K, nt = K / BK;
    unsigned voffA[2], voffB[2];
#pragma unroll
    for (int i = 0; i < 2; ++i) { int R, C; stage_rc(tid * 16 + i * 8192, R, C); const int Rb = ((R & ~31) + perm32(R & 31));
        voffA[i] = (unsigned)(R * K + C) * 2u; voffB[i] = (unsigned)(Rb * K + C) * 2u; }
    const size_t kstep = (size_t)(BK * 2);
    const size_t hstep = (size_t)HALF * K * 2;
    const size_t tstep = 2 * hstep;
    const unsigned ldsw = (unsigned)wid * 1024u;
    const int aoff = lds_byte(wr * 64 + fr, fq * 8), boff = lds_byte(wc * 32 + fr, fq * 8);
#define PG8_SA(b, h) (((b) * 2 + (h)) * HTB)
#define PG8_SB(b, h) ((4 + (b) * 2 + (h)) * HTB)
#define PG8_STAGE(bufoff, gbase, voff) do { _Pragma("unroll") for (int _i = 0; _i < 2; ++_i) \
        __builtin_amdgcn_global_load_lds((const unsigned*)((const char*)(gbase) + (voff)[_i]), (PG8_LAS unsigned*)(lds + (bufoff) + ldsw + _i * 8192), 16, 0, 0); } while (0)
#define PG8_LDA(dst, b, h) do { _Pragma("unroll") for (int m = 0; m < 4; ++m) _Pragma("unroll") for (int k = 0; k < 2; ++k) dst[m][k] = *(const PG8_LAS bf16x8*)(lds + PG8_SA(b, h) + aoff + m * 2048 + k * 1024); } while (0)
#define PG8_LDB(dst, b, h) do { _Pragma("unroll") for (int n = 0; n < 2; ++n) _Pragma("unroll") for (int k = 0; k < 2; ++k) dst[n][k] = *(const PG8_LAS bf16x8*)(lds + PG8_SB(b, h) + boff + n * 2048 + k * 1024); } while (0)
#define PG8_MMA(ai, bj, At, Bt) do { __builtin_amdgcn_s_setprio(1); _Pragma("unroll") for (int m = 0; m < 4; ++m) _Pragma("unroll") for (int n = 0; n < 2; ++n) _Pragma("unroll") for (int k = 0; k < 2; ++k) \
        acc[ai][bj][m][n] = __builtin_amdgcn_mfma_f32_16x16x32_bf16(Bt[n][k], At[m][k], acc[ai][bj][m][n], 0, 0, 0); __builtin_amdgcn_s_setprio(0); } while (0)
#define PG8_WAIT_V(n) asm volatile("s_waitcnt vmcnt(" #n ")" ::: "memory")
#define PG8_WAIT_L(n) asm volatile("s_waitcnt lgkmcnt(" #n ")" ::: "memory")
#define PG8_BAR __builtin_amdgcn_s_barrier()
#define PG8_SCHED __builtin_amdgcn_sched_barrier(0)
    Unit cur, nxt; int ui = 0;
    if (!S.next(0, cur)) return;
    f32x4 acc[2][2][4][2];
#pragma unroll
    for (int a = 0; a < 2; ++a)
#pragma unroll
        for (int b = 0; b < 2; ++b)
#pragma unroll
            for (int m = 0; m < 4; ++m)
#pragma unroll
                for (int n = 0; n < 2; ++n) acc[a][b][m][n] = (f32x4){0.f, 0.f, 0.f, 0.f};
    bf16x8 At[4][2], B0[2][2], B1[2][2];
    const char* cA = (const char*)g.A + (size_t)cur.pm * tstep; const char* cB = (const char*)g.Bt + (size_t)cur.pn * tstep;
    PG8_STAGE(PG8_SB(0, 0), cB, voffB); PG8_STAGE(PG8_SB(0, 1), cB + hstep, voffB); PG8_STAGE(PG8_SA(0, 0), cA, voffA); PG8_STAGE(PG8_SA(0, 1), cA + hstep, voffA);
    if (wr == 1) PG8_BAR;
    PG8_WAIT_V(2); PG8_BAR;
    PG8_STAGE(PG8_SB(1, 0), cB + kstep, voffB); PG8_STAGE(PG8_SA(1, 0), cA + kstep, voffA); PG8_STAGE(PG8_SB(1, 1), cB + hstep + kstep, voffB);
    PG8_WAIT_V(6); PG8_BAR;
    for (;;) {
        const bool has_next = S.next(ui + 1, nxt);
        const char* nA = has_next ? (const char*)g.A + (size_t)nxt.pm * tstep : cA; const char* nB = has_next ? (const char*)g.Bt + (size_t)nxt.pn * tstep : cB;
        for (int t = 0; t < nt; t += 2) {
            const bool last = (t == nt - 2);
            const char* a1 = cA + (size_t)(t + 1) * kstep;
            const char* a2 = last ? nA : cA + (size_t)(t + 2) * kstep; const char* b2 = last ? nB : cB + (size_t)(t + 2) * kstep;
            const char* a3 = a2 + kstep; const char* b3 = b2 + kstep;
            PG8_LDB(B0, 0, 0); PG8_LDB(B1, 0, 1); PG8_SCHED; PG8_LDA(At, 0, 0); PG8_STAGE(PG8_SA(1, 1), a1 + hstep, voffA);
            PG8_WAIT_V(8); PG8_WAIT_L(0); PG8_BAR; PG8_MMA(0, 0, At, B0); PG8_MMA(0, 1, At, B1); PG8_BAR; PG8_SCHED;
            PG8_LDA(At, 0, 1); PG8_STAGE(PG8_SB(0, 0), b2, voffB); PG8_STAGE(PG8_SB(0, 1), b2 + hstep, voffB); PG8_STAGE(PG8_SA(0, 0), a2, voffA);
            PG8_WAIT_V(8); PG8_WAIT_L(0); PG8_BAR; PG8_MMA(1, 0, At, B0); PG8_MMA(1, 1, At, B1); PG8_BAR; PG8_SCHED;
            PG8_LDB(B0, 1, 0); PG8_LDB(B1, 1, 1); PG8_SCHED; PG8_LDA(At, 1, 0); PG8_STAGE(PG8_SA(0, 1), a2 + hstep, voffA);
            PG8_WAIT_V(8); PG8_WAIT_L(0); PG8_BAR; PG8_MMA(0, 0, At, B0); PG8_MMA(0, 1, At, B1); PG8_BAR; PG8_SCHED;
            PG8_LDA(At, 1, 1); PG8_STAGE(PG8_SB(1, 0), b3, voffB); PG8_STAGE(PG8_SB(1, 1), b3 + hstep, voffB); PG8_STAGE(PG8_SA(1, 0), a3, voffA);
            PG8_WAIT_V(8); PG8_WAIT_L(0); PG8_BAR; PG8_MMA(1, 0, At, B0); PG8_MMA(1, 1, At, B1); PG8_BAR; PG8_SCHED;
        }
        if (wr == 0) PG8_BAR;
        E(acc, cur, wr, wc, fr, fq);
        if (!has_next) break;
#pragma unroll
        for (int a = 0; a < 2; ++a)
#pragma unroll
            for (int b = 0; b < 2; ++b)
#pragma unroll
                for (int m = 0; m < 4; ++m)
#pragma unroll
                    for (int n = 0; n < 2; ++n) acc[a][b][m][n] = (f32x4){0.f, 0.f, 0.f, 0.f};
        cur = nxt; cA = nA; cB = nB; ++ui;
        if (wr == 1) PG8_BAR;
    }
    PG8_WAIT_V(0);
    PG8_BAR;
#undef PG8_SA
#undef PG8_SB
#undef PG8_STAGE
#undef PG8_LDA
#undef PG8_LDB
#undef PG8_MMA
#undef PG8_WAIT_V
#undef PG8_WAIT_L
#undef PG8_BAR
#undef PG8_SCHED
}
}

enum { EM_MLA_IN = 0, EM_MLA_UQ = 1, EM_MLA_UKV = 2, EM_RES = 3, EM_HY_IN = 4, EM_DIFF_QKV = 5, EM_GU = 6 };
struct Epi {
    static constexpr bool PERM = true;
    int mode;
    const float* ssq_in; float inv_k;
    float* ssq_out; float* ssq_out2;
    bf16_t* o0; bf16_t* o1; bf16_t* o2;
    float* xf; const float* xr;
    const float* cs; const float* sn;
    LAS float* exch;
    __device__ __forceinline__ static void st8(bf16_t* p, f32x4 a, f32x4 b) {
        u32x4 w; w.x = cvt_pk_bf16(a[0], a[1]); w.y = cvt_pk_bf16(a[2], a[3]); w.z = cvt_pk_bf16(b[0], b[1]); w.w = cvt_pk_bf16(b[2], b[3]); *(u32x4*)p = w; }
    __device__ __forceinline__ static void st4(bf16_t* p, f32x4 a) { u32x2 w; w.x = cvt_pk_bf16(a[0], a[1]); w.y = cvt_pk_bf16(a[2], a[3]); *(u32x2*)p = w; }
    __device__ __forceinline__ static float dot8(f32x4 a, f32x4 b) { return (a[0] * a[0] + a[1] * a[1]) + (a[2] * a[2] + a[3] * a[3]) + (b[0] * b[0] + b[1] * b[1]) + (b[2] * b[2] + b[3] * b[3]); }
    __device__ __forceinline__ void operator()(const f32x4 (&acc)[2][2][4][2], const pg8::Unit& u, int wr, int wc, int fr_, int fq_) const {
        int fr = fr_, fq = fq_; asm volatile("" : "+v"(fr), "+v"(fq));
        const int cw = wc * 32 + 8 * fq;
#pragma unroll
        for (int ai = 0; ai < 2; ++ai)
#pragma unroll
        for (int m = 0; m < 4; ++m) {
            const int r = u.pm * 256 + ai * 128 + wr * 64 + m * 16 + fr;
            float rs = 1.f;
            if (mode != EM_RES) { float t = 0.f;
#pragma unroll
                for (int p = 0; p < 8; ++p) t += ssq_in[(size_t)p * S + r];
                rs = rsqrtf(t * inv_k + RMS_EPS); }
            if (mode == EM_MLA_IN) {
                if (u.pn < 5) {
                    bf16_t* dst = (u.pn < 3) ? (o0 + (size_t)r * 768 + u.pn * 256) : (o1 + (size_t)r * 512 + (u.pn - 3) * 256);
                    float part = 0.f;
#pragma unroll
                    for (int bj = 0; bj < 2; ++bj) { const f32x4 v0 = acc[ai][bj][m][0] * rs, v1 = acc[ai][bj][m][1] * rs; part += dot8(v0, v1); st8(dst + bj * 128 + cw, v0, v1); }
                    part += __shfl_xor(part, 16); part += __shfl_xor(part, 32);
                    if (fq == 0) exch[(ai * 128 + wr * 64 + m * 16 + fr) * 4 + wc] = part;
                } else if (wc == 0) {
#pragma unroll
                    for (int n = 0; n < 2; ++n) { const int i0 = 8 * fq + 4 * n;
                        const f32x4 c = *(const f32x4*)(cs + (size_t)r * 32 + i0), s = *(const f32x4*)(sn + (size_t)r * 32 + i0);
                        const f32x4 x1 = acc[ai][0][m][n] * rs, x2 = acc[ai][1][m][n] * rs;
                        const f32x4 y1 = x1 * c - x2 * s, y2 = x1 * s + x2 * c;
                        u32x2 w1, w2; w1.x = cvt_pk_bf16(y1[0], y1[1]); w1.y = cvt_pk_bf16(y1[2], y1[3]); w2.x = cvt_pk_bf16(y2[0], y2[1]); w2.y = cvt_pk_bf16(y2[2], y2[3]);
                        bf16_t* kp = o2 + (size_t)r * 192 + 128 + i0;
#pragma unroll
                        for (int h = 0; h < 16; ++h) { *(u32x2*)(kp + (size_t)h * S * 192) = w1; *(u32x2*)(kp + (size_t)h * S * 192 + 32) = w2; } }
                }
            } else if (mode == EM_MLA_UQ) {
                if (u.pn < 8) {
#pragma unroll
                    for (int bj = 0; bj < 2; ++bj) { const int c = u.pn * 256 + bj * 128 + cw; st8(o0 + ((size_t)(c >> 7) * S + r) * 192 + (c & 127), acc[ai][bj][m][0] * rs, acc[ai][bj][m][1] * rs); }
                } else { const int head = 4 * (u.pn - 8) + wc;
#pragma unroll
                    for (int n = 0; n < 2; ++n) { const int i0 = 8 * fq + 4 * n;
                        const f32x4 c = *(const f32x4*)(cs + (size_t)r * 32 + i0), s = *(const f32x4*)(sn + (size_t)r * 32 + i0);
                        const f32x4 x1 = acc[ai][0][m][n] * rs, x2 = acc[ai][1][m][n] * rs;
                        bf16_t* qp = o0 + ((size_t)head * S + r) * 192 + 128 + i0;
                        st4(qp, x1 * c - x2 * s); st4(qp + 32, x1 * s + x2 * c); }
                }
            } else if (mode == EM_MLA_UKV) {
                st8(o0 + ((size_t)u.pn * S + r) * 192 + cw, acc[ai][0][m][0] * rs, acc[ai][0][m][1] * rs);
                st8(o1 + ((size_t)u.pn * S + r) * 128 + cw, acc[ai][1][m][0] * rs, acc[ai][1][m][1] * rs);
            } else if (mode == EM_RES) {
                float part = 0.f;
#pragma unroll
                for (int bj = 0; bj < 2; ++bj) { const int c = u.pn * 256 + bj * 128 + cw; bf16_t* bp = o0 + (size_t)r * 2048 + c;
                    f32x4 p0, p1;
                    { const u32x4 w = *(const u32x4*)bp;
                        p0 = (f32x4){__uint_as_float(w.x << 16), __uint_as_float(w.x & 0xffff0000u), __uint_as_float(w.y << 16), __uint_as_float(w.y & 0xffff0000u)};
                        p1 = (f32x4){__uint_as_float(w.z << 16), __uint_as_float(w.z & 0xffff0000u), __uint_as_float(w.w << 16), __uint_as_float(w.w & 0xffff0000u)}; }
                    const f32x4 x0 = p0 + acc[ai][bj][m][0], x1 = p1 + acc[ai][bj][m][1];
                    part += dot8(x0, x1); st8(bp, x0, x1); }
                part += __shfl_xor(part, 16); part += __shfl_xor(part, 32);
                if (fq == 0) exch[(ai * 128 + wr * 64 + m * 16 + fr) * 4 + wc] = part;
            } else if (mode == EM_HY_IN) {
#pragma unroll
                for (int bj = 0; bj < 2; ++bj)
#pragma unroll
                for (int n = 0; n < 2; ++n)
#pragma unroll
                for (int e = 0; e < 4; ++e) { const int c = u.pn * 256 + bj * 128 + cw + 4 * n + e; const float v = acc[ai][bj][m][n][e] * rs; o0[(size_t)c * S + r] = (bf16_t)(cvt_pk_bf16(v, v) & 0xffffu); }
            } else if (mode == EM_DIFF_QKV) {
                if (u.pn < 16) { bf16_t* dst = (u.pn < 8) ? o0 : o1; const int hc = 2 * (u.pn & 7) + (wc >> 1), ib = 32 * (wc & 1) + 8 * fq;
#pragma unroll
                    for (int n = 0; n < 2; ++n) { const int i0 = ib + 4 * n;
                        const f32x4 c = *(const f32x4*)(cs + (size_t)r * 64 + i0), s = *(const f32x4*)(sn + (size_t)r * 64 + i0);
                        const f32x4 x1 = acc[ai][0][m][n] * rs, x2 = acc[ai][1][m][n] * rs;
                        bf16_t* qp = dst + ((size_t)hc * S + r) * 128 + i0;
                        st4(qp, x1 * c - x2 * s); st4(qp + 64, x1 * s + x2 * c); }
                } else {
#pragma unroll
                    for (int bj = 0; bj < 2; ++bj) st8(o2 + ((size_t)(u.pn - 16) * S + r) * 256 + bj * 128 + cw, acc[ai][bj][m][0] * rs, acc[ai][bj][m][1] * rs);
                }
            } else {
                f32x4 hv[2];
#pragma unroll
                for (int n = 0; n < 2; ++n) { const f32x4 gg = acc[ai][0][m][n] * rs, uu = acc[ai][1][m][n] * rs;
#pragma unroll
                    for (int e = 0; e < 4; ++e) hv[n][e] = gg[e] * __builtin_amdgcn_rcpf(1.f + __expf(-gg[e])) * uu[e]; }
                st8(o0 + (size_t)r * FF + u.pn * 128 + cw, hv[0], hv[1]);
            }
        }
        if (mode == EM_RES || (mode == EM_MLA_IN && u.pn < 5)) {
            asm volatile("s_waitcnt lgkmcnt(0)" ::: "memory"); __builtin_amdgcn_s_barrier();
            const int t = ltid();
            if (t < 256) { const f32x4 p4 = *(const LAS f32x4*)(exch + t * 4); const float tot = (p4[0] + p4[1]) + (p4[2] + p4[3]);
                float* dst = (mode == EM_RES) ? (ssq_out + (size_t)u.pn * S) : ((u.pn < 3) ? (ssq_out + (size_t)u.pn * S) : (ssq_out2 + (size_t)(u.pn - 3) * S));
                dst[u.pm * 256 + t] = tot; }
        }
    }
};

#ifndef ATT192FN
#define ATT192FN attn_body192p
#endif
namespace att {
using bf16 = __hip_bfloat16;
constexpr int   D = 128, NW = 8, QBLK = 32, KVBLK = 64;
constexpr float THR = 8.f;
constexpr int SDEPTH = 2;
constexpr size_t SHM_V = KVBLK * D * 2, SHM_K = KVBLK * D * 2, SHM_ATTN = 2 * SHM_V + 2 * SHM_K + NW * 64 * 4;
using bf16x8 = __attribute__((ext_vector_type(8))) short;
using s16x4  = __attribute__((ext_vector_type(4))) short;
using f32x16 = __attribute__((ext_vector_type(16))) float;
using f32x8  = __attribute__((ext_vector_type(8))) float;
using u32x4  = __attribute__((ext_vector_type(4))) unsigned;
#define KSWZ(row, colB) ((row) * 256 + ((colB) ^ (((row) & 7) << 4)))
#define SBAR() __builtin_amdgcn_sched_barrier(0)
__device__ __forceinline__ int crow(int r, int hi) { return (r & 3) + 8 * (r >> 2) + 4 * hi; }
__device__ __forceinline__ unsigned cvtpk(float lo, float hi) {
  unsigned r; asm volatile("v_cvt_pk_bf16_f32 %0, %1, %2" : "=v"(r) : "v"(lo), "v"(hi)); return r;
}
template <typename TIn> struct Stage;
template <> struct Stage<bf16>  { using T = bf16x8;
  __device__ static __forceinline__ T ld8(const bf16* p) { return *reinterpret_cast<const bf16x8*>(p); }
  __device__ static __forceinline__ bf16x8 tobf(T x) { return x; } };
template <> struct Stage<float> { using T = f32x8;
  __device__ static __forceinline__ T ld8(const float* p) { return *reinterpret_cast<const f32x8*>(p); }
  __device__ static __forceinline__ bf16x8 tobf(T x) {
    u32x4 w = {cvtpk(x[0], x[1]), cvtpk(x[2], x[3]), cvtpk(x[4], x[5]), cvtpk(x[6], x[7])}; return *reinterpret_cast<bf16x8*>(&w); } };

template <int DK> __device__ __forceinline__ void partialSM(f32x16& p0, f32x16& p1, float& m_reg, float& mn, float& alpha) {
  constexpr float SCALE = (DK == 192) ? 0.07216878364870322f : 0.08838834764831845f;
  constexpr float C = SCALE * 1.4426950408889634f;
  float pmax = p0[0]; for (int r = 1; r < 16; ++r) pmax = fmaxf(pmax, p0[r]); for (int r = 0; r < 16; ++r) pmax = fmaxf(pmax, p1[r]);
  { auto rr = __builtin_amdgcn_permlane32_swap(__float_as_uint(pmax), __float_as_uint(pmax), false, false);
    pmax = fmaxf(__uint_as_float(rr[0]), __uint_as_float(rr[1])); }
  if (__builtin_expect(__all(pmax - m_reg <= THR / SCALE), 1)) { mn = m_reg; alpha = 1.f; }
  else { mn = fmaxf(m_reg, pmax); alpha = __builtin_amdgcn_exp2f((m_reg - mn) * C); m_reg = mn; }
  float mnC = -mn * C;
  for (int r = 0; r < 16; ++r) p0[r] = fmaf(p0[r], C, mnC); for (int r = 0; r < 16; ++r) p1[r] = fmaf(p1[r], C, mnC);
  for (int r = 0; r < 16; ++r) p0[r] = __builtin_amdgcn_exp2f(p0[r]);
}
__device__ __forceinline__ void finishSM(f32x16& p0, f32x16& p1, float alpha, float& l_reg, bf16x8& pa0, bf16x8& pa1, bf16x8& pa2, bf16x8& pa3) {
  for (int r = 0; r < 16; ++r) p1[r] = __builtin_amdgcn_exp2f(p1[r]);
  float ps = 0; for (int r = 0; r < 16; ++r) ps += p0[r]; for (int r = 0; r < 16; ++r) ps += p1[r];
  { auto rr = __builtin_amdgcn_permlane32_swap(__float_as_uint(ps), __float_as_uint(ps), false, false);
    ps = __uint_as_float(rr[0]) + __uint_as_float(rr[1]); }
  l_reg = l_reg * alpha + ps;
#define PK4(P, BASE, OUT) do { unsigned a0 = cvtpk(P[BASE + 0], P[BASE + 1]), a1 = cvtpk(P[BASE + 2], P[BASE + 3]);   \
    unsigned b0 = cvtpk(P[BASE + 4], P[BASE + 5]), b1 = cvtpk(P[BASE + 6], P[BASE + 7]);                              \
    auto r0 = __builtin_amdgcn_permlane32_swap(a0, b0, false, false); auto r1 = __builtin_amdgcn_permlane32_swap(a1, b1, false, false); \
    u32x4 w = {r0[0], r1[0], r0[1], r1[1]}; OUT = *reinterpret_cast<bf16x8*>(&w); } while (0)
  PK4(p0, 0, pa0); PK4(p0, 8, pa1); PK4(p1, 0, pa2); PK4(p1, 8, pa3);
#undef PK4
}
__device__ __forceinline__ void qkt(f32x16& p0, f32x16& p1, const bf16* Ks, const bf16x8* qr, int r32, int hi) {
  p0 = f32x16{}; p1 = f32x16{};
  for (int d0 = 0; d0 < 8; ++d0) { int cb = (d0 * 16 + hi * 8) * 2;
    bf16x8 b0 = *reinterpret_cast<const bf16x8*>((const char*)Ks + KSWZ(r32, cb));
    bf16x8 b1 = *reinterpret_cast<const bf16x8*>((const char*)Ks + KSWZ(32 + r32, cb));
    p0 = __builtin_amdgcn_mfma_f32_32x32x16_bf16(b0, qr[d0], p0, 0, 0, 0);
    p1 = __builtin_amdgcn_mfma_f32_32x32x16_bf16(b1, qr[d0], p1, 0, 0, 0); }
}
__device__ __forceinline__ int v_st(int k, int c) { const int kk = (k & ~0xC) | ((k & 4) << 1) | ((k & 8) >> 1); return ((kk >> 3) * 4 + (c >> 5)) * 512 + ((kk & 7) * 32 + (c & 31)) * 2; }
__device__ __forceinline__ int v_rd_base(int lane) { return ((lane & 3) << 3) | (((lane >> 2) & 3) << 6) | (((lane >> 4) & 1) << 5) | (((lane >> 5) & 1) << 8); }
constexpr int v_rd_off(int d0, int ks, int half) { return d0 * 512 + ks * 4096 + half * 2048; }
template <int OFF> __device__ __forceinline__ s16x4 tr_read(int vb) {
  s16x4 r; asm volatile("ds_read_b64_tr_b16 %0, %1 offset:%2" : "=&v"(r) : "v"(vb), "i"(OFF) : "memory"); return r;
}
template <int D0> __device__ __forceinline__ void pv_one(f32x16& od, int vb, bf16x8 pa0, bf16x8 pa1, bf16x8 pa2, bf16x8 pa3) {
  const s16x4 l0 = tr_read<v_rd_off(D0, 0, 0)>(vb), h0 = tr_read<v_rd_off(D0, 0, 1)>(vb), l1 = tr_read<v_rd_off(D0, 1, 0)>(vb), h1 = tr_read<v_rd_off(D0, 1, 1)>(vb);
  const s16x4 l2 = tr_read<v_rd_off(D0, 2, 0)>(vb), h2 = tr_read<v_rd_off(D0, 2, 1)>(vb), l3 = tr_read<v_rd_off(D0, 3, 0)>(vb), h3 = tr_read<v_rd_off(D0, 3, 1)>(vb);
  asm volatile("s_waitcnt lgkmcnt(0)" ::: "memory"); SBAR();
#define PK(L, H) (bf16x8){L[0], L[1], L[2], L[3], H[0], H[1], H[2], H[3]}
  od = __builtin_amdgcn_mfma_f32_32x32x16_bf16(pa0, PK(l0, h0), od, 0, 0, 0);
  od = __builtin_amdgcn_mfma_f32_32x32x16_bf16(pa1, PK(l1, h1), od, 0, 0, 0);
  od = __builtin_amdgcn_mfma_f32_32x32x16_bf16(pa2, PK(l2, h2), od, 0, 0, 0);
  od = __builtin_amdgcn_mfma_f32_32x32x16_bf16(pa3, PK(l3, h3), od, 0, 0, 0);
#undef PK
}
__device__ __forceinline__ void pv_d0(f32x16* o, int vb, bf16x8 pa0, bf16x8 pa1, bf16x8 pa2, bf16x8 pa3) {
  pv_one<0>(o[0], vb, pa0, pa1, pa2, pa3); pv_one<1>(o[1], vb, pa0, pa1, pa2, pa3); pv_one<2>(o[2], vb, pa0, pa1, pa2, pa3); pv_one<3>(o[3], vb, pa0, pa1, pa2, pa3);
}

template <typename TQ, int LDQ, int LDK, int LDV, int LDO>
__device__ __forceinline__ void attn_dense_body(const TQ* __restrict__ Qb, const bf16* __restrict__ Kh, const bf16* __restrict__ Vh,
                                                float* __restrict__ Ob, int seq, char* lds) {
  using St = Stage<bf16>; using SQ = Stage<TQ>;
  int tid_ = threadIdx.x; asm volatile("" : "+v"(tid_)); const int tid = tid_, wid = tid >> 6, lane = tid & 63, r32 = lane & 31, hi = lane >> 5;
  bf16* V_lds = (bf16*)lds; bf16* K_lds = (bf16*)(lds + 2 * SHM_V);
  float* ws = (float*)(lds + 2 * SHM_V + 2 * SHM_K) + wid * 64; float* li_l = ws; float* al_l = ws + 32;
  float m_reg = -1e30f, l_reg = 0; f32x16 o[4] = {}; bf16x8 qr[8];
  const TQ* Qw = Qb + (long)(wid * QBLK + r32) * LDQ + hi * 8;
#pragma unroll
  for (int d0 = 0; d0 < 8; ++d0) qr[d0] = SQ::tobf(SQ::ld8(Qw + d0 * 16));
  const int sr = tid >> 4, sc = (tid & 15) * 8, vst0 = v_st(sr, sc), vst1 = v_st(32 + sr, sc);
  const int vb0 = (int)(uintptr_t)V_lds + v_rd_base(lane);
  struct { typename St::T vs0, vs1, ks0, ks1; } sr_[SDEPTH];
#define SLOAD(i, k0) do { sr_[i].vs0 = St::ld8(&Vh[(long)((k0) + sr) * LDV + sc]); sr_[i].vs1 = St::ld8(&Vh[(long)((k0) + 32 + sr) * LDV + sc]); \
    sr_[i].ks0 = St::ld8(&Kh[(long)((k0) + sr) * LDK + sc]); sr_[i].ks1 = St::ld8(&Kh[(long)((k0) + 32 + sr) * LDK + sc]); } while (0)
#define SWRITE(b, i) do { *(bf16x8*)((char*)V_lds + (b) * SHM_V + vst0) = St::tobf(sr_[i].vs0);          \
    *(bf16x8*)((char*)V_lds + (b) * SHM_V + vst1) = St::tobf(sr_[i].vs1); int kc = sc * 2;               \
    *(bf16x8*)((char*)K_lds + (b) * SHM_K + KSWZ(sr, kc)) = St::tobf(sr_[i].ks0);                       \
    *(bf16x8*)((char*)K_lds + (b) * SHM_K + KSWZ(32 + sr, kc)) = St::tobf(sr_[i].ks1); } while (0)
#define SWAIT() do { if constexpr (SDEPTH == 2) asm volatile("s_waitcnt vmcnt(4)" ::: "memory"); else asm volatile("s_waitcnt vmcnt(0)" ::: "memory"); } while (0)
#define RESC(a) do { if (__any((a) < 1.f)) { if (hi == 0) al_l[r32] = (a); asm volatile("s_waitcnt lgkmcnt(0)" ::: "memory"); \
    for (int d = 0; d < 4; ++d) for (int r = 0; r < 16; ++r) o[d][r] *= al_l[crow(r, hi)]; } } while (0)
  f32x16 pA0, pA1, pB0, pB1; float mnA, mnB, alA, alB; bf16x8 pa0, pa1, pa2, pa3; const int NT = seq / KVBLK;
  constexpr int SE = 0, SO = SDEPTH - 1;
  SLOAD(SE, 0); asm volatile("s_waitcnt vmcnt(0)" ::: "memory"); SWRITE(0, SE); __syncthreads();
  qkt(pA0, pA1, K_lds, qr, r32, hi); partialSM<128>(pA0, pA1, m_reg, mnA, alA);
  SLOAD(SO, KVBLK); if constexpr (SDEPTH == 2) { if (2 < NT) SLOAD(SE, 2 * KVBLK); }
  SWAIT(); SWRITE(1, SO); __syncthreads();
  for (int j = 1; j + 1 < NT; j += 2) {
    SBAR(); qkt(pB0, pB1, (bf16*)((char*)K_lds + SHM_K), qr, r32, hi);
    finishSM(pA0, pA1, alA, l_reg, pa0, pa1, pa2, pa3); SBAR();
    SLOAD(SO, (j + SDEPTH) * KVBLK); SBAR();
    pv_d0(o, vb0, pa0, pa1, pa2, pa3); partialSM<128>(pB0, pB1, m_reg, mnB, alB);
    __syncthreads(); SWAIT(); SWRITE(0, SE);
    RESC(alB); __syncthreads();
    SBAR(); qkt(pA0, pA1, K_lds, qr, r32, hi);
    finishSM(pB0, pB1, alB, l_reg, pa0, pa1, pa2, pa3); SBAR();
    if (SDEPTH == 1 || j + 3 < NT) SLOAD(SE, (j + 1 + SDEPTH) * KVBLK); SBAR();
    pv_d0(o, vb0 + (int)SHM_V, pa0, pa1, pa2, pa3); partialSM<128>(pA0, pA1, m_reg, mnA, alA);
    __syncthreads(); SWAIT(); SWRITE(1, SO);
    RESC(alA); __syncthreads();
  }
  SBAR(); qkt(pB0, pB1, (bf16*)((char*)K_lds + SHM_K), qr, r32, hi);
  finishSM(pA0, pA1, alA, l_reg, pa0, pa1, pa2, pa3); SBAR();
  pv_d0(o, vb0, pa0, pa1, pa2, pa3); partialSM<128>(pB0, pB1, m_reg, mnB, alB);
  __syncthreads(); RESC(alB);
  finishSM(pB0, pB1, alB, l_reg, pa0, pa1, pa2, pa3); SBAR();
  pv_d0(o, vb0 + (int)SHM_V, pa0, pa1, pa2, pa3);
  if (hi == 0) li_l[r32] = l_reg; asm volatile("s_waitcnt lgkmcnt(0)" ::: "memory");
  float rli[16];
#pragma unroll
  for (int r = 0; r < 16; ++r) rli[r] = __builtin_amdgcn_rcpf(li_l[crow(r, hi)]);
  float* Ow = Ob + (long)(wid * QBLK) * LDO;
#pragma unroll
  for (int r = 0; r < 16; ++r) { int orow = crow(r, hi);
    for (int d0 = 0; d0 < 4; ++d0) Ow[(long)orow * LDO + d0 * 32 + r32] = o[d0][r] * rli[r]; }
#undef SLOAD
#undef SWRITE
#undef SWAIT
#undef RESC
}


#define KSWZ192(row, colB) ((row) * 384 + ((colB) ^ (((row) & 7) << 4)))
__device__ __forceinline__ void qkt192(f32x16& p0, f32x16& p1, const char* Ks, const bf16x8* qr, int r32, int hi) {
  p0 = f32x16{}; p1 = f32x16{};
#pragma unroll
  for (int d0 = 0; d0 < 12; ++d0) { const int cb = (d0 * 16 + hi * 8) * 2;
    bf16x8 b0 = *reinterpret_cast<const bf16x8*>(Ks + KSWZ192(r32, cb));
    bf16x8 b1 = *reinterpret_cast<const bf16x8*>(Ks + KSWZ192(32 + r32, cb));
    p0 = __builtin_amdgcn_mfma_f32_32x32x16_bf16(b0, qr[d0], p0, 0, 0, 0);
    p1 = __builtin_amdgcn_mfma_f32_32x32x16_bf16(b1, qr[d0], p1, 0, 0, 0); }
}
template <int LDQ, int LDK, int LDV, int LDO>
__device__ __forceinline__ void attn_body192(const unsigned short* __restrict__ Qb, const unsigned short* __restrict__ Kh, const unsigned short* __restrict__ Vh,
                                             unsigned short* __restrict__ Ob, int seq, char* lds) {
  constexpr size_t SV = 16384, SK = 24576;
  int tid_ = threadIdx.x; asm volatile("" : "+v"(tid_)); const int tid = tid_, wid = tid >> 6, lane = tid & 63, r32 = lane & 31, hi = lane >> 5;
  char* V_lds = lds; char* K_lds = lds + 2 * SV;
  float* ws = (float*)(lds + 2 * SV + 2 * SK) + wid * 64; float* li_l = ws; float* al_l = ws + 32;
  float m_reg = -1e30f, l_reg = 0; f32x16 o[4] = {}; bf16x8 qr[12];
  const unsigned short* Qw = Qb + (long)(wid * QBLK + r32) * LDQ + hi * 8;
#pragma unroll
  for (int d0 = 0; d0 < 12; ++d0) qr[d0] = *reinterpret_cast<const bf16x8*>(Qw + d0 * 16);
  const int sr = tid >> 4, sc = (tid & 15) * 8, vst0 = v_st(sr, sc), vst1 = v_st(32 + sr, sc);
  const unsigned voff0 = (unsigned)(sr * LDV + sc), voff1 = (unsigned)((32 + sr) * LDV + sc);
  unsigned koff[3]; int kst[3];
#pragma unroll
  for (int i = 0; i < 3; ++i) { const int q = tid + 512 * i; const int krow = q / 24, kcol = (q % 24) * 8; koff[i] = (unsigned)(krow * LDK + kcol); kst[i] = KSWZ192(krow, kcol * 2); }
  const int vb0 = (int)(uintptr_t)V_lds + v_rd_base(lane);
  bf16x8 vs0, vs1, ks[3];
#define LD192(k0) do { const unsigned short* vp_ = Vh + (size_t)(k0) * LDV; const unsigned short* kp_ = Kh + (size_t)(k0) * LDK; vs0 = *(const bf16x8*)(vp_ + voff0); vs1 = *(const bf16x8*)(vp_ + voff1); \
    _Pragma("unroll") for (int i_ = 0; i_ < 3; ++i_) ks[i_] = *(const bf16x8*)(kp_ + koff[i_]); } while (0)
#define WR192(b) do { *(bf16x8*)(V_lds + (b) * SV + vst0) = vs0; *(bf16x8*)(V_lds + (b) * SV + vst1) = vs1; \
    _Pragma("unroll") for (int i_ = 0; i_ < 3; ++i_) *(bf16x8*)(K_lds + (b) * SK + kst[i_]) = ks[i_]; } while (0)
  const int NT = seq / KVBLK;
  LD192(0); WR192(0); __syncthreads();
#pragma unroll 1
  for (int j = 0; j < NT; ++j) {
    const int b = j & 1;
    if (j + 1 < NT) LD192((j + 1) * KVBLK);
    f32x16 p0, p1; float mn, al; bf16x8 pa0, pa1, pa2, pa3;
    qkt192(p0, p1, K_lds + b * SK, qr, r32, hi);
    partialSM<192>(p0, p1, m_reg, mn, al);
    if (__any(al < 1.f)) { if (hi == 0) al_l[r32] = al; asm volatile("s_waitcnt lgkmcnt(0)" ::: "memory");
#pragma unroll
      for (int d = 0; d < 4; ++d)
#pragma unroll
        for (int r = 0; r < 16; ++r) o[d][r] *= al_l[crow(r, hi)]; }
    finishSM(p0, p1, al, l_reg, pa0, pa1, pa2, pa3); SBAR();
    pv_d0(o, vb0 + b * (int)SV, pa0, pa1, pa2, pa3);
    if (j + 1 < NT) WR192(b ^ 1);
    __syncthreads();
  }
  if (hi == 0) li_l[r32] = l_reg; asm volatile("s_waitcnt lgkmcnt(0)" ::: "memory");
  float rli[16];
#pragma unroll
  for (int r = 0; r < 16; ++r) rli[r] = __builtin_amdgcn_rcpf(li_l[crow(r, hi)]);
  unsigned short* Ow = Ob + (long)(wid * QBLK) * LDO;
#pragma unroll
  for (int r = 0; r < 16; ++r) { const int orow = crow(r, hi);
#pragma unroll
    for (int d0 = 0; d0 < 4; ++d0) { const float v = o[d0][r] * rli[r]; Ow[(long)orow * LDO + d0 * 32 + r32] = (unsigned short)(cvtpk(v, v) & 0xffffu); } }
  __syncthreads();
#undef LD192
#undef WR192
}
constexpr int NQR = 7;
__device__ __forceinline__ void qkt192p(f32x16& p0, f32x16& p1, const char* Ks, const bf16x8* qr, const char* Qr_lds, int r32, int hi) {
  p0 = f32x16{}; p1 = f32x16{};
#pragma unroll
  for (int d0 = 0; d0 < NQR; ++d0) { const int cb = (d0 * 16 + hi * 8) * 2;
    bf16x8 b0 = *reinterpret_cast<const bf16x8*>(Ks + KSWZ192(r32, cb));
    bf16x8 b1 = *reinterpret_cast<const bf16x8*>(Ks + KSWZ192(32 + r32, cb));
    p0 = __builtin_amdgcn_mfma_f32_32x32x16_bf16(b0, qr[d0], p0, 0, 0, 0);
    p1 = __builtin_amdgcn_mfma_f32_32x32x16_bf16(b1, qr[d0], p1, 0, 0, 0); }
#pragma unroll
  for (int d0 = NQR; d0 < 12; ++d0) { const int cb = (d0 * 16 + hi * 8) * 2;
    bf16x8 q = *reinterpret_cast<const bf16x8*>(Qr_lds + (d0 - NQR) * 1024);
    bf16x8 b0 = *reinterpret_cast<const bf16x8*>(Ks + KSWZ192(r32, cb));
    bf16x8 b1 = *reinterpret_cast<const bf16x8*>(Ks + KSWZ192(32 + r32, cb));
    p0 = __builtin_amdgcn_mfma_f32_32x32x16_bf16(b0, q, p0, 0, 0, 0);
    p1 = __builtin_amdgcn_mfma_f32_32x32x16_bf16(b1, q, p1, 0, 0, 0); }
}
template <int LDQ, int LDK, int LDV, int LDO>
__device__ __forceinline__ void attn_body192p(const unsigned short* __restrict__ Qb, const unsigned short* __restrict__ Kh, const unsigned short* __restrict__ Vh,
                                              unsigned short* __restrict__ Ob, int seq, char* lds) {
  constexpr size_t SV = 16384, SK = 24576;
  int tid_ = threadIdx.x; asm volatile("" : "+v"(tid_)); const int tid = tid_, wid = tid >> 6, lane = tid & 63, r32 = lane & 31, hi = lane >> 5;
  char* V_lds = lds; char* K_lds = lds + 2 * SV; const char* Qr_lds = lds + 2 * SV + 2 * SK + wid * ((12 - NQR) * 1024) + lane * 16;
  float* ws = (float*)(lds + 2 * SV + 2 * SK + 8 * (12 - NQR) * 1024) + wid * 64; float* li_l = ws; float* al_l = ws + 32;
  float m_reg = -1e30f, l_reg = 0; f32x16 o[4] = {}; bf16x8 qr[NQR];
  const unsigned short* Qw = Qb + (long)(wid * QBLK + r32) * LDQ + hi * 8;
#pragma unroll
  for (int d0 = 0; d0 < NQR; ++d0) qr[d0] = *reinterpret_cast<const bf16x8*>(Qw + d0 * 16);
#pragma unroll
  for (int d0 = NQR; d0 < 12; ++d0) *(bf16x8*)(const_cast<char*>(Qr_lds) + (d0 - NQR) * 1024) = *reinterpret_cast<const bf16x8*>(Qw + d0 * 16);
  const int sr = tid >> 4, sc = (tid & 15) * 8, vst0 = v_st(sr, sc), vst1 = v_st(32 + sr, sc);
  const unsigned voff0 = (unsigned)(sr * LDV + sc), voff1 = (unsigned)((32 + sr) * LDV + sc);
  const int kr0 = tid / 24, kc0 = (tid % 24) * 8, kr1 = (tid + 512) / 24, kc1 = ((tid + 512) % 24) * 8, kr2 = (tid + 1024) / 24, kc2 = ((tid + 1024) % 24) * 8;
  const unsigned koff0 = (unsigned)(kr0 * LDK + kc0), koff1 = (unsigned)(kr1 * LDK + kc1), koff2 = (unsigned)(kr2 * LDK + kc2);
  const int kst0 = KSWZ192(kr0, kc0 * 2), kst1 = KSWZ192(kr1, kc1 * 2), kst2 = KSWZ192(kr2, kc2 * 2);
  const int vb0 = (int)(uintptr_t)V_lds + v_rd_base(lane);
  struct { bf16x8 vs0, vs1, ks0, ks1, ks2; } sr_[1];
#define SLOADP(i, k0) do { const unsigned short* vp_ = Vh + (size_t)(k0) * LDV; const unsigned short* kp_ = Kh + (size_t)(k0) * LDK; \
    sr_[i].vs0 = *(const bf16x8*)(vp_ + voff0); sr_[i].vs1 = *(const bf16x8*)(vp_ + voff1); \
    sr_[i].ks0 = *(const bf16x8*)(kp_ + koff0); sr_[i].ks1 = *(const bf16x8*)(kp_ + koff1); sr_[i].ks2 = *(const bf16x8*)(kp_ + koff2); } while (0)
#define SWRITEP(b, i) do { *(bf16x8*)(V_lds + (b) * SV + vst0) = sr_[i].vs0; *(bf16x8*)(V_lds + (b) * SV + vst1) = sr_[i].vs1; \
    *(bf16x8*)(K_lds + (b) * SK + kst0) = sr_[i].ks0; *(bf16x8*)(K_lds + (b) * SK + kst1) = sr_[i].ks1; *(bf16x8*)(K_lds + (b) * SK + kst2) = sr_[i].ks2; } while (0)
#define SWAITP() asm volatile("s_waitcnt vmcnt(0)" ::: "memory")
#define RESCP(a) do { if (__any((a) < 1.f)) { if (hi == 0) al_l[r32] = (a); asm volatile("s_waitcnt lgkmcnt(0)" ::: "memory"); \
    _Pragma("unroll") for (int d = 0; d < 4; ++d) _Pragma("unroll") for (int r = 0; r < 16; ++r) o[d][r] *= al_l[crow(r, hi)]; } } while (0)
  f32x16 pA0, pA1, pB0, pB1; float mnA, mnB, alA, alB; bf16x8 pa0, pa1, pa2, pa3; const int NT = seq / KVBLK;
  constexpr int SE = 0, SO = 0;
  SLOADP(SE, 0); asm volatile("s_waitcnt vmcnt(0)" ::: "memory"); SWRITEP(0, SE); __syncthreads();
  qkt192p(pA0, pA1, K_lds, qr, Qr_lds, r32, hi); partialSM<192>(pA0, pA1, m_reg, mnA, alA);
  SLOADP(SO, KVBLK);
  SWAITP(); SWRITEP(1, SO); __syncthreads();
  for (int j = 1; j + 1 < NT; j += 2) {
    SBAR(); qkt192p(pB0, pB1, K_lds + SK, qr, Qr_lds, r32, hi);
    finishSM(pA0, pA1, alA, l_reg, pa0, pa1, pa2, pa3); SBAR();
    SLOADP(SO, (j + 1) * KVBLK); SBAR();
    pv_d0(o, vb0, pa0, pa1, pa2, pa3); partialSM<192>(pB0, pB1, m_reg, mnB, alB);
    __syncthreads(); SWAITP(); SWRITEP(0, SE);
    RESCP(alB); __syncthreads();
    SBAR(); qkt192p(pA0, pA1, K_lds, qr, Qr_lds, r32, hi);
    finishSM(pB0, pB1, alB, l_reg, pa0, pa1, pa2, pa3); SBAR();
    SLOADP(SE, (j + 2) * KVBLK); SBAR();
    pv_d0(o, vb0 + (int)SV, pa0, pa1, pa2, pa3); partialSM<192>(pA0, pA1, m_reg, mnA, alA);
    __syncthreads(); SWAITP(); SWRITEP(1, SO);
    RESCP(alA); __syncthreads();
  }
  SBAR(); qkt192p(pB0, pB1, K_lds + SK, qr, Qr_lds, r32, hi);
  finishSM(pA0, pA1, alA, l_reg, pa0, pa1, pa2, pa3); SBAR();
  pv_d0(o, vb0, pa0, pa1, pa2, pa3); partialSM<192>(pB0, pB1, m_reg, mnB, alB);
  __syncthreads(); RESCP(alB);
  finishSM(pB0, pB1, alB, l_reg, pa0, pa1, pa2, pa3); SBAR();
  pv_d0(o, vb0 + (int)SV, pa0, pa1, pa2, pa3);
  if (hi == 0) li_l[r32] = l_reg; asm volatile("s_waitcnt lgkmcnt(0)" ::: "memory");
  float rli[16];
#pragma unroll
  for (int r = 0; r < 16; ++r) rli[r] = __builtin_amdgcn_rcpf(li_l[crow(r, hi)]);
  unsigned short* Ow = Ob + (long)(wid * QBLK) * LDO;
#pragma unroll
  for (int r = 0; r < 16; ++r) { const int orow = crow(r, hi);
#pragma unroll
    for (int d0 = 0; d0 < 4; ++d0) { const float v = o[d0][r] * rli[r]; Ow[(long)orow * LDO + d0 * 32 + r32] = (unsigned short)(cvtpk(v, v) & 0xffffu); } }
  __syncthreads();
#undef SLOADP
#undef SWRITEP
#undef SWAITP
#undef RESCP
}
constexpr int NQR2 = 4;
__device__ __forceinline__ int v_st256(int k, int c) { const int kk = (k & ~0xC) | ((k & 4) << 1) | ((k & 8) >> 1); return ((kk >> 3) * 8 + (c >> 5)) * 512 + ((kk & 7) * 32 + (c & 31)) * 2; }
constexpr int v_rd_off256(int d0, int ks, int half) { return d0 * 512 + ks * 8192 + half * 4096; }
template <int D0> __device__ __forceinline__ void pv_one256(f32x16& od, int vb, bf16x8 pa0, bf16x8 pa1, bf16x8 pa2, bf16x8 pa3) {
  const s16x4 l0 = tr_read<v_rd_off256(D0, 0, 0)>(vb), h0 = tr_read<v_rd_off256(D0, 0, 1)>(vb), l1 = tr_read<v_rd_off256(D0, 1, 0)>(vb), h1 = tr_read<v_rd_off256(D0, 1, 1)>(vb);
  const s16x4 l2 = tr_read<v_rd_off256(D0, 2, 0)>(vb), h2 = tr_read<v_rd_off256(D0, 2, 1)>(vb), l3 = tr_read<v_rd_off256(D0, 3, 0)>(vb), h3 = tr_read<v_rd_off256(D0, 3, 1)>(vb);
  asm volatile("s_waitcnt lgkmcnt(0)" ::: "memory"); SBAR();
#define PK(L, H) (bf16x8){L[0], L[1], L[2], L[3], H[0], H[1], H[2], H[3]}
  od = __builtin_amdgcn_mfma_f32_32x32x16_bf16(pa0, PK(l0, h0), od, 0, 0, 0);
  od = __builtin_amdgcn_mfma_f32_32x32x16_bf16(pa1, PK(l1, h1), od, 0, 0, 0);
  od = __builtin_amdgcn_mfma_f32_32x32x16_bf16(pa2, PK(l2, h2), od, 0, 0, 0);
  od = __builtin_amdgcn_mfma_f32_32x32x16_bf16(pa3, PK(l3, h3), od, 0, 0, 0);
#undef PK
}
__device__ __forceinline__ void qkt128q(f32x16& p0, f32x16& p1, const char* Ks, const bf16x8* qr, const char* Qr_lds, int r32, int hi) {
  p0 = f32x16{}; p1 = f32x16{};
#pragma unroll
  for (int d0 = 0; d0 < 8; ++d0) { const int cb = (d0 * 16 + hi * 8) * 2;
    bf16x8 q; if (d0 < NQR2) q = qr[d0 < NQR2 ? d0 : 0]; else q = *reinterpret_cast<const bf16x8*>(Qr_lds + (d0 - NQR2) * 1024);
    bf16x8 b0 = *reinterpret_cast<const bf16x8*>(Ks + KSWZ(r32, cb));
    bf16x8 b1 = *reinterpret_cast<const bf16x8*>(Ks + KSWZ(32 + r32, cb));
    p0 = __builtin_amdgcn_mfma_f32_32x32x16_bf16(b0, q, p0, 0, 0, 0);
    p1 = __builtin_amdgcn_mfma_f32_32x32x16_bf16(b1, q, p1, 0, 0, 0); }
}
template <int LDQ, int LDK, int LDV, int LDO>
__device__ __forceinline__ void attn_body_dv256(const unsigned short* __restrict__ Qb, const unsigned short* __restrict__ Kh, const unsigned short* __restrict__ Vh,
                                                unsigned short* __restrict__ Of, int seq, char* lds) {
  constexpr size_t SV = 32768, SK = 16384;
  int tid_ = threadIdx.x; asm volatile("" : "+v"(tid_)); const int tid = tid_, wid = tid >> 6, lane = tid & 63, r32 = lane & 31, hi = lane >> 5;
  char* V_lds = lds; char* K_lds = lds + 2 * SV; const char* Qr_lds = lds + 2 * SV + 2 * SK + wid * ((8 - NQR2) * 1024) + lane * 16;
  float* ws = (float*)(lds + 2 * SV + 2 * SK + 8 * (8 - NQR2) * 1024) + wid * 64; float* li_l = ws; float* al_l = ws + 32;
  float m_reg = -1e30f, l_reg = 0; f32x16 o[8] = {}; bf16x8 qr[NQR2];
  const unsigned short* Qw = Qb + (long)(wid * QBLK + r32) * LDQ + hi * 8;
#pragma unroll
  for (int d0 = 0; d0 < NQR2; ++d0) qr[d0] = *reinterpret_cast<const bf16x8*>(Qw + d0 * 16);
#pragma unroll
  for (int d0 = NQR2; d0 < 8; ++d0) *(bf16x8*)(const_cast<char*>(Qr_lds) + (d0 - NQR2) * 1024) = *reinterpret_cast<const bf16x8*>(Qw + d0 * 16);
  const int sr = tid >> 4, sc = (tid & 15) * 8; const int kst0 = KSWZ(sr, sc * 2), kst1 = KSWZ(32 + sr, sc * 2);
  const unsigned koff0 = (unsigned)(sr * LDK + sc), koff1 = (unsigned)((32 + sr) * LDK + sc);
  const int vr = tid >> 5, vc = (tid & 31) * 8;
  const unsigned voff = (unsigned)(vr * LDV + vc);
  const int vst0 = v_st256(vr, vc);
  const int vb0 = (int)(uintptr_t)V_lds + v_rd_base(lane);
  bf16x8 vs[4], ks0, ks1;
#define LD256(k0) do { const unsigned short* vp_ = Vh + (size_t)(k0) * LDV; const unsigned short* kp_ = Kh + (size_t)(k0) * LDK; \
    _Pragma("unroll") for (int i_ = 0; i_ < 4; ++i_) vs[i_] = *(const bf16x8*)(vp_ + voff + (unsigned)(16 * i_ * LDV)); \
    ks0 = *(const bf16x8*)(kp_ + koff0); ks1 = *(const bf16x8*)(kp_ + koff1); } while (0)
#define WR256(b) do { _Pragma("unroll") for (int i_ = 0; i_ < 4; ++i_) *(bf16x8*)(V_lds + (b) * SV + vst0 + i_ * 8192) = vs[i_]; \
    *(bf16x8*)(K_lds + (b) * SK + kst0) = ks0; *(bf16x8*)(K_lds + (b) * SK + kst1) = ks1; } while (0)
  const int NT = seq / KVBLK;
  LD256(0); WR256(0); __syncthreads();
#pragma unroll 1
  for (int j = 0; j < NT; ++j) {
    const int b = j & 1;
    if (j + 1 < NT) LD256((j + 1) * KVBLK);
    f32x16 p0, p1; float mn, al; bf16x8 pa0, pa1, pa2, pa3;
    qkt128q(p0, p1, K_lds + b * SK, qr, Qr_lds, r32, hi);
    partialSM<128>(p0, p1, m_reg, mn, al);
    if (__any(al < 1.f)) { if (hi == 0) al_l[r32] = al; asm volatile("s_waitcnt lgkmcnt(0)" ::: "memory");
#pragma unroll
      for (int d = 0; d < 8; ++d)
#pragma unroll
        for (int r = 0; r < 16; ++r) o[d][r] *= al_l[crow(r, hi)]; }
    finishSM(p0, p1, al, l_reg, pa0, pa1, pa2, pa3); SBAR();
    const int vb = vb0 + b * (int)SV;
    pv_one256<0>(o[0], vb, pa0, pa1, pa2, pa3); pv_one256<1>(o[1], vb, pa0, pa1, pa2, pa3); pv_one256<2>(o[2], vb, pa0, pa1, pa2, pa3); pv_one256<3>(o[3], vb, pa0, pa1, pa2, pa3);
    pv_one256<4>(o[4], vb, pa0, pa1, pa2, pa3); pv_one256<5>(o[5], vb, pa0, pa1, pa2, pa3); pv_one256<6>(o[6], vb, pa0, pa1, pa2, pa3); pv_one256<7>(o[7], vb, pa0, pa1, pa2, pa3);
    if (j + 1 < NT) WR256(b ^ 1);
    __syncthreads();
  }
  if (hi == 0) li_l[r32] = l_reg; asm volatile("s_waitcnt lgkmcnt(0)" ::: "memory");
  float rli[16];
#pragma unroll
  for (int r = 0; r < 16; ++r) rli[r] = __builtin_amdgcn_rcpf(li_l[crow(r, hi)]);
  unsigned short* Ow = Of + (long)(wid * QBLK) * LDO;
#pragma unroll
  for (int r = 0; r < 16; ++r) { const int orow = crow(r, hi);
#pragma unroll
    for (int d0 = 0; d0 < 8; ++d0) { const float v = o[d0][r] * rli[r]; Ow[(long)orow * LDO + d0 * 32 + r32] = (unsigned short)(cvtpk(v, v) & 0xffffu); } }
  __syncthreads();
#undef LD256
#undef WR256
}
}

enum { MAP_ID = 0, MAP_MLA_IN = 1, MAP_UQ = 2, MAP_DQKV = 3, MAP_GATE = 4, MAP_UP = 5 };
__device__ __forceinline__ int dmap(int kind, int n) {
    switch (kind) {
        case MAP_MLA_IN: return (n < 1312) ? n : (1408 + (n - 1312));
        case MAP_UQ: { const int head = n / 192, d = n % 192; if (d < 128) return head * 128 + d; const int r = d - 128, bj = r >> 5, i = r & 31; return 2048 + (head >> 2) * 256 + bj * 128 + (head & 3) * 32 + i; }
        case MAP_DQKV: { if (n >= 4096) return n; const int base = n & ~255, r = n & 255, blk = r >> 7, d = r & 127, bj = d >> 6, i = d & 63; return base + bj * 128 + blk * 64 + i; }
        case MAP_GATE: return (n >> 7) * 256 + (n & 127);
        case MAP_UP: return (n >> 7) * 256 + 128 + (n & 127);
        default: return n;
    }
}
__device__ __forceinline__ void cvt_item(const float* W, int K, int N, const float* g, bf16_t* WT, int kind, LAS float* scr, int item, int lane) {
    const int nblk = N / 32, kb = item / nblk, nb = item % nblk, k0 = 64 * kb, n0 = 32 * nb;
#pragma unroll 8
    for (int i = 0; i < 32; ++i) { const int kk = 2 * i + (lane >> 5); scr[kk * 33 + (lane & 31)] = W[(size_t)(k0 + kk) * N + n0 + (lane & 31)]; }
    LDS_WAIT(); asm volatile("" ::: "memory");
    const int c = lane & 7; const int drow0 = dmap(kind, n0);
    float gv[8];
#pragma unroll
    for (int e = 0; e < 8; ++e) gv[e] = g ? g[k0 + 8 * c + e] : 1.f;
#pragma unroll
    for (int j = 0; j < 4; ++j) { const int n = (lane >> 3) + 8 * j; const LAS float* s = scr + (8 * c) * 33 + n;
        u32x4 o; o.x = cvt_pk_bf16(s[0 * 33] * gv[0], s[1 * 33] * gv[1]); o.y = cvt_pk_bf16(s[2 * 33] * gv[2], s[3 * 33] * gv[3]);
        o.z = cvt_pk_bf16(s[4 * 33] * gv[4], s[5 * 33] * gv[5]); o.w = cvt_pk_bf16(s[6 * 33] * gv[6], s[7 * 33] * gv[7]);
        *(u32x4*)(WT + (size_t)(drow0 + n) * K + k0 + 8 * c) = o; }
    LDS_WAIT(); asm volatile("" ::: "memory");
}

__device__ __forceinline__ void cvt_gate_tail(const float* Wg, const float* g, bf16_t* WT, LAS float* scr, int gw, int NGW, int lane) {
    constexpr int NIT = (2048 / 64) * (5632 / 32);
#pragma unroll 1
    for (int it = gw; it < NIT; it += NGW) cvt_item(Wg, 2048, 5632, g, WT, MAP_GATE, scr, it, lane);
}

constexpr int FN = 16384, FNLOG = 14;
#define FP(i) ((i) + (((i) >> 5) << 2))
__device__ __forceinline__ f32x2 cmul(f32x2 a, f32x2 b) { return (f32x2){a.x * b.x - a.y * b.y, a.x * b.y + a.y * b.x}; }
__device__ __forceinline__ f32x2 twiddle(int idx, int M, float sign) {
    const float rev = (float)idx / (float)M;
    return (f32x2){__builtin_amdgcn_cosf(rev), sign * __builtin_amdgcn_sinf(rev)};
}
__device__ __forceinline__ f32x2 rot16(f32x2 v, int jj, float sgn) {
    const float h = 0.70710678118654752f, c1 = 0.92387953251128674f, s1 = 0.38268343236508977f;
    float c, s;
    switch (jj & 7) {
        case 0: return v;
        case 1: c = c1; s = s1; break;
        case 2: c = h; s = h; break;
        case 3: c = s1; s = c1; break;
        case 4: return (f32x2){-sgn * v.y, sgn * v.x};
        case 5: c = -s1; s = c1; break;
        case 6: c = -h; s = h; break;
        default: c = -c1; s = s1; break;
    }
    s *= sgn;
    return (f32x2){v.x * c - v.y * s, v.x * s + v.y * c};
}
#define FADDR(j) ((ls >= 5) ? (a0 + (j) * ps) : (a0 + (j) * s + (((low + (j) * s) >> 5) << 2)))
template <int R> __device__ __forceinline__ void fft_dif_pass(LAS f32x2* L, int ls  , int tid) {
    const int s = 1 << ls; const int ps = (ls >= 5) ? FP(s) : s;
#pragma unroll 1
    for (int g = tid; g < (FN >> R); g += 512) {
        const int low = g & (s - 1); const int i0 = ((g - low) << R) | low; const int a0 = FP(i0);
        f32x2 e[1 << R];
#pragma unroll
        for (int j = 0; j < (1 << R); ++j) e[j] = L[FADDR(j)];
        f32x2 wq[4];
        if (R == 4) { wq[3] = twiddle(low, 16 * s, -1.f); wq[2] = cmul(wq[3], wq[3]); wq[1] = cmul(wq[2], wq[2]); wq[0] = cmul(wq[1], wq[1]); }
#pragma unroll
        for (int q = R - 1; q >= 0; --q) {
            const int sp = 1 << q;
#pragma unroll
            for (int j = 0; j < (1 << R); ++j) if ((j & sp) == 0) {
                const f32x2 a = e[j], b = e[j + sp];
                e[j] = a + b;
                f32x2 d = a - b; const int jj = j & (sp - 1);
                if (R == 4) d = cmul(d, wq[q]);
                e[j + sp] = rot16(d, jj * (8 >> q), -1.f);
            }
        }
#pragma unroll
        for (int j = 0; j < (1 << R); ++j) L[FADDR(j)] = e[j];
    }
}
template <int R> __device__ __forceinline__ void fft_dit_pass(LAS f32x2* L, int ls, int tid) {
    const int s = 1 << ls; const int ps = (ls >= 5) ? FP(s) : s;
#pragma unroll 1
    for (int g = tid; g < (FN >> R); g += 512) {
        const int low = g & (s - 1); const int i0 = ((g - low) << R) | low; const int a0 = FP(i0);
        f32x2 e[1 << R];
#pragma unroll
        for (int j = 0; j < (1 << R); ++j) e[j] = L[FADDR(j)];
        f32x2 wq[4];
        if (R == 4) { wq[3] = twiddle(low, 16 * s, 1.f); wq[2] = cmul(wq[3], wq[3]); wq[1] = cmul(wq[2], wq[2]); wq[0] = cmul(wq[1], wq[1]); }
#pragma unroll
        for (int q = 0; q < R; ++q) {
            const int sp = 1 << q;
#pragma unroll
            for (int j = 0; j < (1 << R); ++j) if ((j & sp) == 0) {
                const int jj = j & (sp - 1);
                f32x2 b = e[j + sp];
                if (R == 4) b = cmul(b, wq[q]);
                b = rot16(b, jj * (8 >> q), 1.f);
                const f32x2 a = e[j];
                e[j] = a + b; e[j + sp] = a - b;
            }
        }
#pragma unroll
        for (int j = 0; j < (1 << R); ++j) L[FADDR(j)] = e[j];
    }
}
__device__ __forceinline__ void fft_fwd(LAS f32x2* L, int tid) {
    __syncthreads();
    fft_dif_pass<4>(L, 10, tid); __syncthreads();
    fft_dif_pass<4>(L, 6, tid); __syncthreads();
    fft_dif_pass<4>(L, 2, tid); __syncthreads();
    fft_dif_pass<2>(L, 0, tid); __syncthreads();
}
__device__ __forceinline__ void fft_inv(LAS f32x2* L, int tid) {
    __syncthreads();
    fft_dit_pass<2>(L, 0, tid); __syncthreads();
    fft_dit_pass<4>(L, 2, tid); __syncthreads();
    fft_dit_pass<4>(L, 6, tid); __syncthreads();
    fft_dit_pass<4>(L, 10, tid); __syncthreads();
}
__device__ __forceinline__ int brev14(int p) { return (int)(__builtin_bitreverse32((unsigned)p) >> 18); }
__device__ __forceinline__ float block_sum(float v, LAS float* red, int tid) {
    v = wave_sum(v);
    __syncthreads();
    if ((tid & 63) == 0) red[tid >> 6] = v;
    __syncthreads();
    float t = 0.f;
#pragma unroll
    for (int i = 0; i < 8; ++i) t += red[i];
    return t;
}
__device__ __forceinline__ f32x2 unpk_bf2(unsigned w) { return (f32x2){__uint_as_float(w << 16), __uint_as_float(w & 0xffff0000u)}; }
__device__ __forceinline__ void spec_mul(LAS f32x2* L, const unsigned* Kp, int tid) {
#pragma unroll 2
    for (int p = tid; p < FN; p += 512) {
        const int k = brev14(p), k2 = (FN - k) & (FN - 1), p2 = brev14(k2);
        if (p > p2) continue;
        const f32x2 z1 = L[FP(p)], z2 = L[FP(p2)], g1 = unpk_bf2(Kp[p]), g2 = unpk_bf2(Kp[p2]);
        const f32x2 ka = (f32x2){0.5f * (g1.x + g2.x), 0.5f * (g1.y - g2.y)};
        const f32x2 kb = (f32x2){0.5f * (g1.y + g2.y), -0.5f * (g1.x - g2.x)};
        const f32x2 P = (ka + kb) * 0.5f, M = (ka - kb) * 0.5f;
        const f32x2 z2c = (f32x2){z2.x, -z2.y}, z1c = (f32x2){z1.x, -z1.y};
        const f32x2 y1 = cmul(z1, P) + cmul(z2c, M);
        const f32x2 Pc = (f32x2){P.x, -P.y}, Mc = (f32x2){M.x, -M.y};
        const f32x2 y2 = cmul(z2, Pc) + cmul(z1c, Mc);
        L[FP(p)] = y1; if (p2 != p) L[FP(p2)] = y2;
    }
}

#define XB_TMO      128
#define XB_XCNT(j)  (256  + 64 * (j))
#define XB_XSUB(j)  (1280 + 64 * (j))
#define XB_XGEN(j)  (2304 + 64 * (j))
#define XB_TOP      3328
#define XB_TOPGEN   3392
#define XCD_BAR_WORDS 3456
#define XB_SPIN_CAP (1u << 18)
__device__ __forceinline__ unsigned xb_ld(unsigned* p)              { return __hip_atomic_load(p, __ATOMIC_RELAXED, __HIP_MEMORY_SCOPE_AGENT); }
__device__ __forceinline__ unsigned xb_add(unsigned* p, unsigned v) { return __hip_atomic_fetch_add(p, v, __ATOMIC_RELAXED, __HIP_MEMORY_SCOPE_AGENT); }
__device__ __forceinline__ unsigned xb_xcc_id() { return (unsigned)__builtin_amdgcn_s_getreg((3 << 11) | 20) & 0xFu; }
#define XB_SPIN(cond, bar) do { unsigned _sp = 0; while (cond) { __builtin_amdgcn_s_sleep(1); \
    if ((++_sp & 255u) == 0u) { if (xb_ld(&(bar)[XB_TMO])) break; if (_sp > XB_SPIN_CAP) { atomicAdd(&(bar)[XB_TMO], 1u); break; } } } } while (0)
struct XcdBarrier { unsigned* bar; unsigned x; volatile LAS unsigned* st; };
__device__ __forceinline__ XcdBarrier xcd_barrier_post(unsigned* bar, volatile LAS unsigned* st) {
    XcdBarrier b; b.bar = bar; b.x = xb_xcc_id(); b.st = st;
    if (threadIdx.x == 0) (void)xb_add(&bar[XB_XCNT(b.x)], 1u);
    return b;
}
__device__ __forceinline__ void xcd_barrier_complete(unsigned* bar, unsigned x, unsigned& nloc, unsigned& nx) {
    const unsigned G = gridDim.x * gridDim.y * gridDim.z;
    unsigned sum, cnt, mine, sp = 0u;
    for (;;) {
        sum = 0u; cnt = 0u; mine = 0u;
#pragma unroll
        for (unsigned j = 0; j < 16; ++j) { const unsigned c = xb_ld(&bar[XB_XCNT(j)]); sum += c; cnt += (c > 0u) ? 1u : 0u; mine = (j == x) ? c : mine; }
        if (sum == G) break;
        __builtin_amdgcn_s_sleep(1);
        if ((++sp & 255u) == 0u) { if (xb_ld(&bar[XB_TMO])) break; if (sp > XB_SPIN_CAP) { atomicAdd(&bar[XB_TMO], 1u); break; } }
    }
    nloc = mine > 0u ? mine : 1u; nx = cnt > 0u ? cnt : 1u;
}
__device__ __forceinline__ void xcd_barrier(const XcdBarrier& b) {
    asm volatile("s_waitcnt vmcnt(0)" ::: "memory");
    __syncthreads();
    if (threadIdx.x == 0) {
        unsigned* bar = b.bar;
        __builtin_amdgcn_s_waitcnt(0);
        unsigned nloc = b.st[0], nx = b.st[1];
        if (nloc == 0u) { xcd_barrier_complete(bar, b.x, nloc, nx); b.st[0] = nloc; b.st[1] = nx; }
        const unsigned old = xb_add(&bar[XB_XSUB(b.x)], 1u);
        const unsigned gen = old / nloc;
        if (old + 1u == (gen + 1u) * nloc) {
            __builtin_amdgcn_fence(__ATOMIC_RELEASE, "agent");
            asm volatile("s_waitcnt vmcnt(0)" ::: "memory");
            const unsigned og = xb_add(&bar[XB_TOP], 1u);
            const unsigned tg = og / nx;
            if (og + 1u == (tg + 1u) * nx) xb_add(&bar[XB_TOPGEN], 1u);
            else XB_SPIN(xb_ld(&bar[XB_TOPGEN]) == tg, bar);
            __builtin_amdgcn_fence(__ATOMIC_ACQUIRE, "agent");
            xb_add(&bar[XB_XGEN(b.x)], 1u);
            asm volatile("s_waitcnt vmcnt(0)" ::: "memory");
        } else {
            XB_SPIN(xb_ld(&bar[XB_XGEN(b.x)]) == gen, bar);
            __builtin_amdgcn_fence(__ATOMIC_ACQUIRE, "agent");
            asm volatile("s_waitcnt vmcnt(0)" ::: "memory");
        }
    }
    __syncthreads();
}

#define T_NONE 0
#define T_P0 1
#define T_GEMM 2
#define T_AMLA 3
#define T_ADIFF 4
#define T_HY 5
#define T_TR 6
#define T_FINAL 7
constexpr int N_PHASES = 1 + 4 * 7 + 1;
__host__ __device__ __forceinline__ int layer_kind(int layer) { return layer == 1 ? 1 : (layer == 2 ? 2 : 0); }
__host__ __device__ __forceinline__ int phase_type(int ph, bool& sync_after) {
    sync_after = true;
    if (ph == 0) return T_P0;
    if (ph == N_PHASES - 1) { sync_after = false; return T_FINAL; }
    const int layer = (ph - 1) / 7, slot = (ph - 1) % 7, kind = layer_kind(layer);
    if (slot == 0 || slot >= 4) return T_GEMM;
    if (kind == 0) { if (slot == 1) { sync_after = false; return T_GEMM; } if (slot == 2) return T_GEMM; return T_AMLA; }
    if (kind == 1) { if (slot == 1) return T_HY; if (slot == 2) return T_TR; sync_after = false; return T_NONE; }
    if (slot == 1) return T_ADIFF; sync_after = false; return T_NONE;
}

struct Ctx {
    unsigned char* ws; bf16_t* WB; bf16_t* XB; bf16_t* AO; float* SSQ; float* MC; float* MS; float* DC; float* DS; float* H3; float* X;
};
__device__ __forceinline__ Ctx make_ctx(KA& a) {
    Ctx c; c.ws = a.ws; c.WB = (bf16_t*)(a.ws + WS_W); c.XB = (bf16_t*)(a.ws + WS_XB); c.AO = (bf16_t*)(a.ws + WS_AO); c.SSQ = (float*)(a.ws + WS_SSQ);
    c.MC = (float*)(a.ws + WS_MC); c.MS = (float*)(a.ws + WS_MS); c.DC = (float*)(a.ws + WS_DC); c.DS = (float*)(a.ws + WS_DS); c.H3 = (float*)(a.ws + WS_H3); c.X = a.out; return c;
}

__device__ __forceinline__ void phase_p0(KA& a, LAS unsigned char* lds) {
    const Ctx c = make_ctx(a);
    const int tid = ltid(), lane = tid & 63, wave = __builtin_amdgcn_readfirstlane(tid >> 6);
    const int G = gridDim.x, bx = lbid(), gw = bx * 8 + wave, NGW = G * 8, gt = bx * 512 + tid, NGT = G * 512;
    bf16_t* WB = c.WB; float* SSQ = c.SSQ;
    for (int i = gt; i < 13 * 8 * S - S; i += NGT) SSQ[S + i] = 0.f;
    LAS float* scr = (LAS float*)(lds + wave * 16384);
#define CJ(src, K_, N_, gptr, off_, kind_) do { const float* W = a.in[src]; const float* g = gptr; const int nitems = ((K_) / 64) * ((N_) / 32); \
        _Pragma("unroll 1") for (int it = gw; it < nitems; it += NGW) cvt_item(W, K_, N_, g, WB + (off_), kind_, scr, it, lane); } while (0)
    CJ(2, 2048, 1344, a.in[1], W0_IN, MAP_MLA_IN); CJ(4, 768, 3072, a.in[3], W0_UQ, MAP_UQ); CJ(6, 512, 4096, a.in[5], W0_UKV, MAP_ID); CJ(7, 2048, 2048, nullptr, W0_O, MAP_ID);
    CJ(9, 2048, 5632, a.in[8], W0_GU, MAP_GATE); CJ(10, 2048, 5632, a.in[8], W0_GU, MAP_UP); CJ(11, 5632, 2048, nullptr, W0_DN, MAP_ID);
    CJ(13, 2048, 6144, a.in[12], W1_IN, MAP_ID); CJ(25, 2048, 2048, nullptr, W1_O, MAP_ID);
    CJ(28, 2048, 5632, a.in[26], W1_GU, MAP_UP); CJ(29, 5632, 2048, nullptr, W1_DN, MAP_ID);
    CJ(31, 2048, 6144, a.in[30], W2_IN, MAP_DQKV); CJ(37, 2048, 2048, nullptr, W2_O, MAP_ID);
    CJ(40, 2048, 5632, a.in[38], W2_GU, MAP_UP); CJ(41, 5632, 2048, nullptr, W2_DN, MAP_ID);
    CJ(43, 2048, 1344, a.in[42], W3_IN, MAP_MLA_IN); CJ(45, 768, 3072, a.in[44], W3_UQ, MAP_UQ); CJ(47, 512, 4096, a.in[46], W3_UKV, MAP_ID); CJ(48, 2048, 2048, nullptr, W3_O, MAP_ID);
    CJ(51, 2048, 5632, a.in[49], W3_GU, MAP_UP); CJ(52, 5632, 2048, nullptr, W3_DN, MAP_ID);
#undef CJ
    for (int i = gt; i < 2 * 192 * 256; i += NGT) {
        const int mtx = i / (192 * 256), rem = i % (192 * 256), rr = rem / 256, ch = rem % 256;
        const int row = rr < 96 ? 1312 + rr : 1440 + (rr - 96);
        *(u32x4*)(WB + (mtx ? W3_IN : W0_IN) + (size_t)row * 2048 + ch * 8) = (u32x4){0u, 0u, 0u, 0u};
    }
#pragma unroll 1
    for (int r = gw; r < S; r += NGW) {
        const f32x4* xr = (const f32x4*)(a.in[0] + (size_t)r * D) + lane; f32x4* xo = (f32x4*)(c.X + (size_t)r * D) + lane;
        u32x2* xb = (u32x2*)(c.XB + (size_t)r * D) + lane; float s2 = 0.f;
#pragma unroll
        for (int j = 0; j < 8; ++j) { const f32x4 v = xr[64 * j]; s2 += (v.x * v.x + v.y * v.y) + (v.z * v.z + v.w * v.w);
            u32x2 w; w.x = cvt_pk_bf16(v.x, v.y); w.y = cvt_pk_bf16(v.z, v.w); xb[64 * j] = w; }
        s2 = wave_sum(s2); if (lane == 0) SSQ[r] = s2;
    }
#pragma unroll 1
    for (int i = gt; i < S * 32; i += NGT) { const int pos = i >> 5, f = i & 31;
        const float inv = (float)exp(-9.210340371976184 * ((double)(2 * f) / 64.0)); const float ang = (float)pos * inv;
        float s, cc; sincos_acc(ang, s, cc); c.MC[i] = cc; c.MS[i] = s; }
#pragma unroll 1
    for (int i = gt; i < S * 64; i += NGT) { const int pos = i >> 6, f = i & 63;
        const float inv = (float)exp(-9.210340371976184 * ((double)(2 * f) / 128.0)); const float ang = (float)pos * inv;
        float s, cc; sincos_acc(ang, s, cc); c.DC[i] = cc; c.DS[i] = s; }
    {
        LAS float* hs = (LAS float*)(lds + 131072 + wave * 1024);
        const float* W1 = a.in[16]; const float* b1 = a.in[17]; const float* fr = a.in[18]; const float* W2 = a.in[19]; const float* b2 = a.in[20];
        const float* W3 = a.in[21]; const float* b3 = a.in[22];
#pragma unroll 1
        for (int l = gw; l < S; l += NGW) {
            asm volatile("" ::: "memory");
            const float fq = fr[lane];
            const float t = (float)l * (1.0f / 8191.0f); const float w = 6.283185307179586f * (float)l / 8192.0f;
            if (lane < 33) { float z;
                if (lane == 0) z = t;
                else { const int k = (lane - 1) & 15; const float f = 1e-4f + (float)k * ((15.0f - 1e-4f) / 15.0f); float s, cc; sincos_acc(f * w, s, cc); z = (lane <= 16) ? cc : -s; }
                hs[lane] = z; }
            LDS_WAIT();
            float acc = 0.f;
#pragma unroll 3
            for (int k = 0; k < 33; ++k) acc = fmaf(hs[k], W1[k * 64 + lane], acc);
            float h = sin_acc(fq * (acc + b1[lane])); hs[64 + lane] = h; LDS_WAIT();
            acc = 0.f;
#pragma unroll 4
            for (int k = 0; k < 64; ++k) acc = fmaf(hs[64 + k], W2[k * 64 + lane], acc);
            h = sin_acc(fq * (acc + b2[lane])); hs[128 + lane] = h; LDS_WAIT();
            acc = 0.f;
#pragma unroll 4
            for (int k = 0; k < 64; ++k) acc = fmaf(hs[128 + k], W3[k * 64 + lane], acc);
            h = sin_acc(fq * (acc + b3[lane])); c.H3[(((size_t)(lane >> 2) * S) + l) * 4 + (lane & 3)] = h;
            LDS_WAIT();
        }
    }
    __syncthreads();
}

__device__ __forceinline__ void phase_gemm(KA& a, int ph, LAS unsigned char* lds) {
    const Ctx c = make_ctx(a); unsigned char* ws = c.ws;
    const int layer = (ph - 1) / 7, slot = (ph - 1) % 7, kind = layer_kind(layer);
    const size_t w_in = layer == 0 ? W0_IN : layer == 1 ? W1_IN : layer == 2 ? W2_IN : W3_IN;
    const size_t w_o = layer == 0 ? W0_O : layer == 1 ? W1_O : layer == 2 ? W2_O : W3_O;
    const size_t w_gu = layer == 0 ? W0_GU : layer == 1 ? W1_GU : layer == 2 ? W2_GU : W3_GU;
    const size_t w_dn = layer == 0 ? W0_DN : layer == 1 ? W1_DN : layer == 2 ? W2_DN : W3_DN;
    const size_t w_uq = layer == 0 ? W0_UQ : W3_UQ, w_ukv = layer == 0 ? W0_UKV : W3_UKV;
    float* ssq_mix = c.SSQ + (size_t)(2 * layer) * 8 * S; float* ssq_ffn = c.SSQ + (size_t)(2 * layer + 1) * 8 * S; float* ssq_nxt = c.SSQ + (size_t)(2 * layer + 2) * 8 * S;
    float* ssq_cq = c.SSQ + (size_t)(9 + (layer ? 2 : 0)) * 8 * S; float* ssq_ckv = ssq_cq + 8 * S;
    Epi E{}; E.exch = (LAS float*)(lds + 131072); const bf16_t* A = c.XB; const bf16_t* Bt = c.WB; int N = 2048, K = 2048;
    if (slot == 0) {
        E.ssq_in = ssq_mix; E.inv_k = 1.f / 2048.f; Bt = c.WB + w_in;
        if (kind == 0) { E.mode = EM_MLA_IN; E.o0 = (bf16_t*)(ws + R_CQ); E.o1 = (bf16_t*)(ws + R_CKV); E.o2 = (bf16_t*)(ws + R_K); E.ssq_out = ssq_cq; E.ssq_out2 = ssq_ckv; E.cs = c.MC; E.sn = c.MS; N = 1536; }
        else if (kind == 1) { E.mode = EM_HY_IN; E.o0 = (bf16_t*)(ws + R_UT); N = 6144; }
        else { E.mode = EM_DIFF_QKV; E.o0 = (bf16_t*)(ws + R_QD); E.o1 = (bf16_t*)(ws + R_KD); E.o2 = (bf16_t*)(ws + R_VD); E.cs = c.DC; E.sn = c.DS; N = 6144; }
    } else if (slot == 1) { E.mode = EM_MLA_UQ; E.ssq_in = ssq_cq; E.inv_k = 1.f / 768.f; E.o0 = (bf16_t*)(ws + R_Q); E.cs = c.MC; E.sn = c.MS; A = (const bf16_t*)(ws + R_CQ); Bt = c.WB + w_uq; N = 3072; K = 768; }
    else if (slot == 2) { E.mode = EM_MLA_UKV; E.ssq_in = ssq_ckv; E.inv_k = 1.f / 512.f; E.o0 = (bf16_t*)(ws + R_K); E.o1 = (bf16_t*)(ws + R_V); A = (const bf16_t*)(ws + R_CKV); Bt = c.WB + w_ukv; N = 4096; K = 512; }
    else if (slot == 4) { E.mode = EM_RES; E.xr = nullptr; E.o0 = c.XB; E.ssq_out = ssq_ffn; A = c.AO; Bt = c.WB + w_o; }
    else if (slot == 5) { E.mode = EM_GU; E.ssq_in = ssq_ffn; E.inv_k = 1.f / 2048.f; E.o0 = (bf16_t*)(ws + R_H); Bt = c.WB + w_gu; N = 11264; }
    else { E.mode = EM_RES; E.xr = nullptr; E.o0 = c.XB; E.ssq_out = ssq_nxt; A = (const bf16_t*)(ws + R_H); Bt = c.WB + w_dn; K = 5632; }
    pg8::Gemm g{A, Bt, S, N, K}; pg8::StaticOrder so; so.init(S, N, (int)gridDim.x, lbid());
    pg8::gemm_phase<Epi, pg8::StaticOrder>(lds, g, so, E);
    if (slot == 5 && layer < 3) {
        const int G = gridDim.x, bx = lbid(), first = (32 * 44) % G, nconv = G - first;
        if (bx >= first) { const int tid = ltid(), lane = tid & 63, wave = __builtin_amdgcn_readfirstlane(tid >> 6);
            const float* Wg = layer == 0 ? a.in[27] : layer == 1 ? a.in[39] : a.in[50];
            const float* gn = layer == 0 ? a.in[26] : layer == 1 ? a.in[38] : a.in[49];
            const size_t wo = layer == 0 ? W1_GU : layer == 1 ? W2_GU : W3_GU;
            cvt_gate_tail(Wg, gn, c.WB + wo, (LAS float*)(lds + wave * 16384), (bx - first) * 8 + wave, nconv * 8, lane); }
    }
}

__device__ __forceinline__ void phase_amla(KA& a, char* lds) {
    unsigned char* ws = a.ws; bf16_t* AO = (bf16_t*)(ws + WS_AO);
    const bf16_t* Q = (const bf16_t*)(ws + R_Q); const bf16_t* Kk = (const bf16_t*)(ws + R_K); const bf16_t* V = (const bf16_t*)(ws + R_V);
    const int G = gridDim.x, bx = lbid();
#pragma unroll 1
    for (int it = bx; it < 512; it += G) {
        const int h = (it & 7) + 8 * (it >> 8), qb = (it >> 3) & 31; const size_t q0 = (size_t)qb * 256;
        att::ATT192FN<192, 192, 128, 2048>(Q + ((size_t)h * S + q0) * 192, Kk + (size_t)h * S * 192, V + (size_t)h * S * 128, AO + q0 * 2048 + h * 128, S, lds);
    }
}

__device__ __forceinline__ void phase_adiff(KA& a, char* lds) {
    unsigned char* ws = a.ws; bf16_t* AO = (bf16_t*)(ws + WS_AO);
    const int G = gridDim.x, bx = lbid();
    const bf16_t* Qd = (const bf16_t*)(ws + R_QD); const bf16_t* Kd = (const bf16_t*)(ws + R_KD); const bf16_t* Vd = (const bf16_t*)(ws + R_VD);
    bf16_t* T = (bf16_t*)(ws + R_T) + (size_t)bx * (2 * 256 * 256);
#pragma unroll 1
    for (int it = bx; it < 256; it += G) {
        const int h = it & 7, qb = it >> 3; const size_t q0 = (size_t)qb * 256;
#pragma unroll 1
        for (int comp = 0; comp < 2; ++comp) {
            att::attn_body_dv256<128, 128, 256, 256>(Qd + ((size_t)(2 * h + comp) * S + q0) * 128, Kd + (size_t)(2 * h + comp) * S * 128, Vd + (size_t)h * S * 256,
                                                     T + comp * (256 * 256), S, lds);
        }
        __syncthreads();
        const int tid = ltid(), lane = tid & 63, wave = __builtin_amdgcn_readfirstlane(tid >> 6);
        float lam; { const float* lq1 = a.in[32]; const float* lk1 = a.in[33]; const float* lq2 = a.in[34]; const float* lk2 = a.in[35];
            float s1 = lq1[lane] * lk1[lane] + lq1[lane + 64] * lk1[lane + 64], s2 = lq2[lane] * lk2[lane] + lq2[lane + 64] * lk2[lane + 64];
            s1 = wave_sum(s1); s2 = wave_sum(s2); lam = __expf(s1) - __expf(s2) + 0.470713018f; }
        const float* subln = a.in[36];
        const f32x4 gsub = *(const f32x4*)(subln + 4 * lane);
#pragma unroll 1
        for (int rr = 0; rr < 32; ++rr) { const int row = wave * 32 + rr;
            const u32x2 w0 = *(const u32x2*)(T + (size_t)row * 256 + 4 * lane), w1 = *(const u32x2*)(T + 256 * 256 + (size_t)row * 256 + 4 * lane);
            const f32x4 t0 = {__uint_as_float(w0.x << 16), __uint_as_float(w0.x & 0xffff0000u), __uint_as_float(w0.y << 16), __uint_as_float(w0.y & 0xffff0000u)};
            const f32x4 t1 = {__uint_as_float(w1.x << 16), __uint_as_float(w1.x & 0xffff0000u), __uint_as_float(w1.y << 16), __uint_as_float(w1.y & 0xffff0000u)};
            const f32x4 d = t0 - t1 * lam;
            float s2 = (d.x * d.x + d.y * d.y) + (d.z * d.z + d.w * d.w); s2 = wave_sum(s2);
            const float rn = rsqrtf(s2 * (1.f / 256.f) + 1e-5f) * (1.f - 0.470713018f);
            const f32x4 ov = d * rn * gsub;
            u32x2 w; w.x = cvt_pk_bf16(ov.x, ov.y); w.y = cvt_pk_bf16(ov.z, ov.w);
            *(u32x2*)(AO + (q0 + row) * 2048 + h * 256 + 4 * lane) = w;
        }
        __syncthreads();
    }
}

__device__ __forceinline__ void phase_hyena(KA& a, LAS unsigned char* lds) {
    unsigned char* ws = a.ws; const float* H3 = (const float*)(ws + WS_H3);
    const int tid = ltid(); const int G = gridDim.x, bx = lbid();
    LAS f32x2* L = (LAS f32x2*)lds;
    LAS float* w8s = (LAS float*)(lds + 147456);
    LAS float* red = (LAS float*)(lds + 147456 + 2048);
    const bf16_t* UT = (const bf16_t*)(ws + R_UT);
    bf16_t* YT = (bf16_t*)(ws + R_YT);
    f32x2* SP0 = (f32x2*)(ws + R_SPEC) + (size_t)bx * 2 * FN; f32x2* SP1 = SP0 + FN;
    unsigned* SPb0 = (unsigned*)SP0; unsigned* SPb1 = SPb0 + FN;
    unsigned* Z1 = (unsigned*)(ws + R_Z1) + (size_t)bx * S;
    const float* cw = a.in[14]; const float* cb = a.in[15]; const float* W4 = a.in[23]; const float* hb = a.in[24];
#pragma unroll 1
    for (int pp = bx; pp < 1024; pp += G) {
        const int ca = 2 * pp, cbn = 2 * pp + 1;
        const float dla = fabsf(-3.0701134573253944f + (float)ca * ((-15.350567286626972f + 3.0701134573253944f) / 2047.0f));
        const float dlb = fabsf(-3.0701134573253944f + (float)cbn * ((-15.350567286626972f + 3.0701134573253944f) / 2047.0f));
#pragma unroll 1
        for (int rk = 0; rk < 1 + HY_REP_KERN; ++rk) {
        __syncthreads();
        { const int k = tid >> 3, j = tid & 7, o = j >> 2, jj = j & 3;
          w8s[tid] = W4[(size_t)k * 8192 + (jj >> 1) * 4096 + o * 2048 + ((jj & 1) ? cbn : ca)]; }
        __syncthreads();
        float sa0 = 0.f, sb0 = 0.f, sa1 = 0.f, sb1 = 0.f;
#pragma unroll 1
        for (int g = 0; g < 4; ++g) {
            const int lbase = tid + 2048 * g;
            f32x4 acc0[4], acc1[4];
#pragma unroll
            for (int li = 0; li < 4; ++li) { acc0[li] = (f32x4){0.f, 0.f, 0.f, 0.f}; acc1[li] = (f32x4){0.f, 0.f, 0.f, 0.f}; }
#pragma unroll 2
            for (int k4 = 0; k4 < 16; ++k4) {
                f32x4 hv[4];
#pragma unroll
                for (int li = 0; li < 4; ++li) hv[li] = *(const f32x4*)(H3 + ((size_t)k4 * S + (lbase + 512 * li)) * 4);
#pragma unroll
                for (int e = 0; e < 4; ++e) { const f32x4 wA = *(const LAS f32x4*)(w8s + (k4 * 4 + e) * 8), wB = *(const LAS f32x4*)(w8s + (k4 * 4 + e) * 8 + 4);
#pragma unroll
                    for (int li = 0; li < 4; ++li) { acc0[li] += wA * hv[li][e]; acc1[li] += wB * hv[li][e]; } }
            }
#pragma unroll
            for (int li = 0; li < 4; ++li) { const int l = lbase + 512 * li;
                const float t = (float)l * (1.0f / 8191.0f);
                const float da = __expf(-t * dla), db = __expf(-t * dlb);
                const f32x2 f0 = (f32x2){acc0[li][0] * da, acc0[li][1] * db}, b0 = (f32x2){acc0[li][2] * da, acc0[li][3] * db};
                const f32x2 f1 = (f32x2){acc1[li][0] * da, acc1[li][1] * db}, b1 = (f32x2){acc1[li][2] * da, acc1[li][3] * db};
                L[FP(l)] = f0; SP1[l] = f1; sa0 += fabsf(f0.x); sb0 += fabsf(f0.y); sa1 += fabsf(f1.x); sb1 += fabsf(f1.y);
                if (l == 0) { L[FP(S)] = (f32x2){0.f, 0.f}; SP1[S] = (f32x2){0.f, 0.f}; }
                else { L[FP(FN - l)] = b0; SP1[FN - l] = b1; sa0 += fabsf(b0.x); sb0 += fabsf(b0.y); sa1 += fabsf(b1.x); sb1 += fabsf(b1.y); }
            }
        }
        const float ta0 = block_sum(sa0, red, tid); const float tb0 = block_sum(sb0, red, tid);
        const float ta1 = block_sum(sa1, red, tid); const float tb1 = block_sum(sb1, red, tid);
        { const float ia = 1.f / ta0, ib = 1.f / tb0;
#pragma unroll 1
          for (int p = tid; p < FN; p += 512) { f32x2 v = L[FP(p)]; v.x *= ia; v.y *= ib; L[FP(p)] = v; } }
        fft_fwd(L, tid);
#pragma unroll 4
        for (int i = 0; i < 16; ++i) { const int p = 2 * (tid + 512 * i); const f32x4 v = *(const LAS f32x4*)(L + FP(p)); u32x2 w; w.x = cvt_pk_bf16(v[0], v[1]); w.y = cvt_pk_bf16(v[2], v[3]); *(u32x2*)(SPb0 + p) = w; }
        __syncthreads();
        { const float ia = 1.f / ta1, ib = 1.f / tb1;
#pragma unroll 4
          for (int i = 0; i < 16; ++i) { const int p = 2 * (tid + 512 * i); f32x4 v = *(const f32x4*)(SP1 + p); v[0] *= ia; v[1] *= ib; v[2] *= ia; v[3] *= ib; *(LAS f32x4*)(L + FP(p)) = v; } }
        fft_fwd(L, tid);
#pragma unroll 4
        for (int i = 0; i < 16; ++i) { const int p = 2 * (tid + 512 * i); const f32x4 v = *(const LAS f32x4*)(L + FP(p)); u32x2 w; w.x = cvt_pk_bf16(v[0], v[1]); w.y = cvt_pk_bf16(v[2], v[3]); *(u32x2*)(SPb1 + p) = w; }
        __syncthreads();
        }
        const bf16_t* ux1a = UT + (size_t)ca * S; const bf16_t* ux1b = UT + (size_t)cbn * S;
        const bf16_t* ux2a = UT + (size_t)(D + ca) * S; const bf16_t* ux2b = UT + (size_t)(D + cbn) * S;
        const bf16_t* uva = UT + (size_t)(2 * D + ca) * S; const bf16_t* uvb = UT + (size_t)(2 * D + cbn) * S;
#define BF2F(u16) __uint_as_float(((unsigned)(u16)) << 16)
#define SCONV4(dst, up, ch, t) do { const u32x2 xw_ = *(const u32x2*)((up) + (t)); const f32x4 x_ = {__uint_as_float(xw_.x << 16), __uint_as_float(xw_.x & 0xffff0000u), __uint_as_float(xw_.y << 16), __uint_as_float(xw_.y & 0xffff0000u)}; \
        const float xm_ = ((t) > 0) ? BF2F((up)[(t) - 1]) : 0.f, xp_ = ((t) + 4 < S) ? BF2F((up)[(t) + 4]) : 0.f; \
        const float w0_ = cw[ch], w1_ = cw[6144 + (ch)], w2_ = cw[2 * 6144 + (ch)], bb_ = cb[ch]; \
        dst[0] = xm_ * w0_ + x_[0] * w1_ + x_[1] * w2_ + bb_; dst[1] = x_[0] * w0_ + x_[1] * w1_ + x_[2] * w2_ + bb_; \
        dst[2] = x_[1] * w0_ + x_[2] * w1_ + x_[3] * w2_ + bb_; dst[3] = x_[2] * w0_ + x_[3] * w1_ + xp_ * w2_ + bb_; } while (0)
#pragma unroll 2
        for (int i = 0; i < 4; ++i) { const int t = 4 * (tid + 512 * i);
            f32x4 za, zb; SCONV4(za, uva, 2 * D + ca, t); SCONV4(zb, uvb, 2 * D + cbn, t);
            const f32x4 p01 = {za[0], zb[0], za[1], zb[1]}, p23 = {za[2], zb[2], za[3], zb[3]};
            *(LAS f32x4*)(L + FP(t)) = p01; *(LAS f32x4*)(L + FP(t) + 2) = p23;
            *(LAS f32x4*)(L + FP(S + t)) = (f32x4){0.f, 0.f, 0.f, 0.f}; *(LAS f32x4*)(L + FP(S + t) + 2) = (f32x4){0.f, 0.f, 0.f, 0.f};
            { u32x4 zw; zw.x = cvt_pk_bf16(p01[0], p01[1]); zw.y = cvt_pk_bf16(p01[2], p01[3]); zw.z = cvt_pk_bf16(p23[0], p23[1]); zw.w = cvt_pk_bf16(p23[2], p23[3]); *(u32x4*)(Z1 + t) = zw; } }
        fft_fwd(L, tid);
        spec_mul(L, SPb0, tid);
        fft_inv(L, tid);
        const float b0a = hb[ca], b0b = hb[cbn], b1a = hb[D + ca], b1b = hb[D + cbn];
        const float invn = 1.0f / (float)FN;
#pragma unroll 2
        for (int i = 0; i < 4; ++i) { const int t = 4 * (tid + 512 * i);
            f32x4 ga, gb; SCONV4(ga, ux1a, ca, t); SCONV4(gb, ux1b, cbn, t);
            const f32x4 c01 = *(const LAS f32x4*)(L + FP(t)), c23 = *(const LAS f32x4*)(L + FP(t) + 2);
            const u32x4 zw_ = *(const u32x4*)(Z1 + t);
            const f32x4 z01 = {__uint_as_float(zw_.x << 16), __uint_as_float(zw_.x & 0xffff0000u), __uint_as_float(zw_.y << 16), __uint_as_float(zw_.y & 0xffff0000u)};
            const f32x4 z23 = {__uint_as_float(zw_.z << 16), __uint_as_float(zw_.z & 0xffff0000u), __uint_as_float(zw_.w << 16), __uint_as_float(zw_.w & 0xffff0000u)};
            const f32x4 n01 = {ga[0] * (c01[0] * invn + z01[0] * b0a), gb[0] * (c01[1] * invn + z01[1] * b0b), ga[1] * (c01[2] * invn + z01[2] * b0a), gb[1] * (c01[3] * invn + z01[3] * b0b)};
            const f32x4 n23 = {ga[2] * (c23[0] * invn + z23[0] * b0a), gb[2] * (c23[1] * invn + z23[1] * b0b), ga[3] * (c23[2] * invn + z23[2] * b0a), gb[3] * (c23[3] * invn + z23[3] * b0b)};
            { u32x4 zw; zw.x = cvt_pk_bf16(n01[0], n01[1]); zw.y = cvt_pk_bf16(n01[2], n01[3]); zw.z = cvt_pk_bf16(n23[0], n23[1]); zw.w = cvt_pk_bf16(n23[2], n23[3]); *(u32x4*)(Z1 + t) = zw; }
            *(LAS f32x4*)(L + FP(t)) = n01; *(LAS f32x4*)(L + FP(t) + 2) = n23;
            *(LAS f32x4*)(L + FP(S + t)) = (f32x4){0.f, 0.f, 0.f, 0.f}; *(LAS f32x4*)(L + FP(S + t) + 2) = (f32x4){0.f, 0.f, 0.f, 0.f}; }
        fft_fwd(L, tid);
        spec_mul(L, SPb1, tid);
        fft_inv(L, tid);
#pragma unroll 2
        for (int i = 0; i < 4; ++i) { const int t = 4 * (tid + 512 * i);
            f32x4 ga, gb; SCONV4(ga, ux2a, D + ca, t); SCONV4(gb, ux2b, D + cbn, t);
            const f32x4 c01 = *(const LAS f32x4*)(L + FP(t)), c23 = *(const LAS f32x4*)(L + FP(t) + 2);
            const u32x4 zw_ = *(const u32x4*)(Z1 + t);
            const f32x4 z01 = {__uint_as_float(zw_.x << 16), __uint_as_float(zw_.x & 0xffff0000u), __uint_as_float(zw_.y << 16), __uint_as_float(zw_.y & 0xffff0000u)};
            const f32x4 z23 = {__uint_as_float(zw_.z << 16), __uint_as_float(zw_.z & 0xffff0000u), __uint_as_float(zw_.w << 16), __uint_as_float(zw_.w & 0xffff0000u)};
            const float ya0 = ga[0] * (c01[0] * invn + z01[0] * b1a), yb0 = gb[0] * (c01[1] * invn + z01[1] * b1b);
            const float ya1 = ga[1] * (c01[2] * invn + z01[2] * b1a), yb1 = gb[1] * (c01[3] * invn + z01[3] * b1b);
            const float ya2 = ga[2] * (c23[0] * invn + z23[0] * b1a), yb2 = gb[2] * (c23[1] * invn + z23[1] * b1b);
            const float ya3 = ga[3] * (c23[2] * invn + z23[2] * b1a), yb3 = gb[3] * (c23[3] * invn + z23[3] * b1b);
            u32x2 wa, wb; wa.x = cvt_pk_bf16(ya0, ya1); wa.y = cvt_pk_bf16(ya2, ya3); wb.x = cvt_pk_bf16(yb0, yb1); wb.y = cvt_pk_bf16(yb2, yb3);
            *(u32x2*)(YT + (size_t)ca * S + t) = wa; *(u32x2*)(YT + (size_t)cbn * S + t) = wb; }
#undef SCONV4
        __syncthreads();
    }
}

__device__ __forceinline__ void phase_tr(KA& a, LAS unsigned char* lds) {
    unsigned char* ws = a.ws; bf16_t* AO = (bf16_t*)(ws + WS_AO); const bf16_t* YT = (const bf16_t*)(ws + R_YT);
    const int tid = ltid(); const int G = gridDim.x, bx = lbid();
    LAS bf16_t* tl = (LAS bf16_t*)lds;
#pragma unroll 1
    for (int tile = bx; tile < 32 * 128; tile += G) {
        const int c0 = (tile & 31) * 64, t0 = (tile >> 5) * 64;
        __syncthreads();
        { const int i = tid >> 3, j8 = tid & 7;
          const bf16x8 v = *(const bf16x8*)(YT + (size_t)(c0 + i) * S + t0 + j8 * 8);
#pragma unroll
          for (int e = 0; e < 8; ++e) tl[(j8 * 8 + e) * 72 + i] = (bf16_t)v[e]; }
        __syncthreads();
        { const int tt = tid >> 3, c8 = tid & 7;
          const bf16x8 v = *(const LAS bf16x8*)(tl + tt * 72 + c8 * 8);
          *(bf16x8*)(AO + (size_t)(t0 + tt) * D + c0 + c8 * 8) = v; }
    }
    __syncthreads();
}

__device__ __forceinline__ void phase_final(KA& a) {
    const int tid = ltid(), lane = tid & 63, wave = __builtin_amdgcn_readfirstlane(tid >> 6);
    const int gw = lbid() * 8 + wave, NGW = gridDim.x * 8;
    const float* gfin = a.in[53]; const float* ssq = (const float*)(a.ws + WS_SSQ) + (size_t)8 * 8 * S; float* X = a.out;
#pragma unroll 1
    for (int r = gw; r < S; r += NGW) {
        float tsum = 0.f;
#pragma unroll
        for (int p = 0; p < 8; ++p) tsum += ssq[(size_t)p * S + r];
        const float rs = rsqrtf(tsum * (1.f / 2048.f) + RMS_EPS);
        f32x4* xo = (f32x4*)(X + (size_t)r * D) + lane; const f32x4* gg = (const f32x4*)gfin + lane;
        const u32x2* xb = (const u32x2*)((const bf16_t*)(a.ws + WS_XB) + (size_t)r * D) + lane;
#pragma unroll
        for (int j = 0; j < 8; ++j) { const u32x2 w = xb[64 * j];
            const f32x4 v = {__uint_as_float(w.x << 16), __uint_as_float(w.x & 0xffff0000u), __uint_as_float(w.y << 16), __uint_as_float(w.y & 0xffff0000u)};
            xo[64 * j] = v * rs * gg[64 * j]; }
    }
}

template <int TYPE> __device__ __forceinline__ void run_phase(KA& a, int ph, unsigned char* lds_raw) {
    LAS unsigned char* lds = (LAS unsigned char*)lds_raw;
    if constexpr (TYPE == T_P0) phase_p0(a, lds);
    else if constexpr (TYPE == T_GEMM) phase_gemm(a, ph, lds);
    else if constexpr (TYPE == T_AMLA) phase_amla(a, (char*)lds_raw);
    else if constexpr (TYPE == T_ADIFF) phase_adiff(a, (char*)lds_raw);
    else if constexpr (TYPE == T_HY) phase_hyena(a, lds);
    else if constexpr (TYPE == T_TR) phase_tr(a, lds);
    else if constexpr (TYPE == T_FINAL) phase_final(a);
}

template <int TYPE> __global__ void __launch_bounds__(512, 2) phase_kernel(Args a_) {
    extern __shared__ __attribute__((aligned(16))) unsigned char lds_raw[];
    KA& a = *largs();
    run_phase<TYPE>(a, a.ph_lo, lds_raw);
}

#ifndef HY_REP_FFT
#define HY_REP_FFT 0
#endif
#ifndef MK_REPEAT_MASK
#define MK_REPEAT_MASK 0
#endif
#ifndef MK_CUTS
#define MK_CUTS 0, N_PHASES
#endif
#ifndef MEGA_MASK
#define MEGA_MASK 0xff
#endif
#if !MK_MULTI
__global__ void __launch_bounds__(512, 2) mega_fwd(Args a_) {
    extern __shared__ __attribute__((aligned(16))) unsigned char lds_raw[];
    const int ph_lo = a_.ph_lo, ph_hi = a_.ph_hi;
    if (ph_hi < 0) cg::this_grid().sync();
    volatile LAS unsigned* stw = (volatile LAS unsigned*)((LAS unsigned char*)lds_raw + LDS_BYTES - 16);
    if (threadIdx.x == 0) { stw[0] = 0u; stw[1] = 0u; }
    __syncthreads();
    const XcdBarrier bar = xcd_barrier_post((unsigned*)(a_.ws + WS_BAR) + (size_t)a_.li * XCD_BAR_WORDS, stw);
    if (ph_lo == 0) {
#pragma unroll 1
        for (int r0 = 0; r0 < ((MK_REPEAT_MASK & 2) ? 2 : 1); ++r0) {
        { KA& a = *largs(); run_phase<T_P0>(a, 0, lds_raw); }
        if (ph_hi > 1) xcd_barrier(bar);
        }
    }
    const int l0 = ph_lo < 1 ? 1 : ph_lo, l1 = ph_hi < N_PHASES - 1 ? ph_hi : N_PHASES - 1;
    int rep = 0; (void)rep;
#pragma unroll 1
    for (int ph = l0; ph < l1; ++ph) {
        bool sync_after; const int ty = phase_type(ph, sync_after);
        KA& a = *largs();
        switch (ty) {
            case T_GEMM: run_phase<T_GEMM>(a, ph, lds_raw); break;
            case T_AMLA: run_phase<T_AMLA>(a, ph, lds_raw); break;
            case T_ADIFF: run_phase<T_ADIFF>(a, ph, lds_raw); break;
            case T_HY: run_phase<T_HY>(a, ph, lds_raw); break;
            case T_TR: run_phase<T_TR>(a, ph, lds_raw); break;
            default: break;
        }
        if (sync_after && ph + 1 < ph_hi) xcd_barrier(bar);
#if MK_REPEAT_MASK
        if (((MK_REPEAT_MASK >> ty) & 1) && !rep) { rep = 1; --ph; } else rep = 0;
#endif
    }
    if (ph_hi == N_PHASES) { KA& a = *largs(); run_phase<T_FINAL>(a, N_PHASES - 1, lds_raw); }
}
#endif
template <int TYPE> static void launch_phase(int grid, hipStream_t stream, Args a) {
    static bool attr = false;
    if (!attr) { (void)hipFuncSetAttribute((const void*)phase_kernel<TYPE>, hipFuncAttributeMaxDynamicSharedMemorySize, LDS_BYTES); attr = true; }
    hipLaunchKernelGGL(phase_kernel<TYPE>, dim3(grid), dim3(512), LDS_BYTES, stream, a);
}
extern "C" void kernel_launch(void* const* d_in, const int* in_sizes, int n_in, void* d_out, int out_size, void* d_ws, size_t ws_size, hipStream_t stream) {
    static int grid = 0;
    if (grid == 0) {
        if (n_in != 54 || out_size != S * D || ws_size < WS_END) { fprintf(stderr, "kernel_launch: bad shapes n_in %d out %d ws %zu (need %zu)\n", n_in, out_size, ws_size, (size_t)WS_END); grid = -1; return; }
        int dev = 0, cus = 0;
        (void)hipGetDevice(&dev); (void)hipDeviceGetAttribute(&cus, hipDeviceAttributeMultiprocessorCount, dev);
#if !MK_MULTI
        if (hipFuncSetAttribute((const void*)mega_fwd, hipFuncAttributeMaxDynamicSharedMemorySize, LDS_BYTES) != hipSuccess) { fprintf(stderr, "kernel_launch: hipFuncSetAttribute failed\n"); grid = -1; return; }
        int per_cu = 0;
        (void)hipOccupancyMaxActiveBlocksPerMultiprocessor(&per_cu, (const void*)mega_fwd, 512, LDS_BYTES);
        (void)hipGetLastError();
        if (per_cu < 1) fprintf(stderr, "kernel_launch: occupancy query says %d blocks per CU\n", per_cu);
#endif
        grid = cus > 0 ? cus : 256;
    }
    if (grid < 0) return;
    Args a{};
    for (int i = 0; i < 54; ++i) a.in[i] = (const float*)d_in[i];
    a.out = (float*)d_out; a.ws = (unsigned char*)d_ws;
#if MK_MULTI
    for (int p = 0; p < N_PHASES; ++p) {
        bool sa; const int ty = phase_type(p, sa); a.ph_lo = p; a.ph_hi = p + 1;
        switch (ty) {
            case T_P0: launch_phase<T_P0>(grid, stream, a); break;
            case T_GEMM: launch_phase<T_GEMM>(grid, stream, a); break;
            case T_AMLA: launch_phase<T_AMLA>(grid, stream, a); break;
            case T_ADIFF: launch_phase<T_ADIFF>(grid, stream, a); break;
            case T_HY: launch_phase<T_HY>(grid, stream, a); break;
            case T_TR: launch_phase<T_TR>(grid, stream, a); break;
            case T_FINAL: launch_phase<T_FINAL>(grid, stream, a); break;
            default: break;
        }
    }
#else
    {
        const int cuts[] = {MK_CUTS};
        const int ncut = (int)(sizeof(cuts) / sizeof(int));
        (void)hipMemsetAsync((char*)d_ws + WS_BAR, 0, 64 * 1024, stream);
        for (int i = 0; i + 1 < ncut; ++i) {
            a.ph_lo = cuts[i]; a.ph_hi = cuts[i + 1]; a.li = i;
            void* args[] = {&a};
            hipError_t e = hipLaunchCooperativeKernel((const void*)mega_fwd, dim3(grid), dim3(512), args, LDS_BYTES, stream);
            if (e != hipSuccess) fprintf(stderr, "kernel_launch: cooperative launch failed: %s (grid %d)\n", hipGetErrorString(e), grid);
        }
    }
#endif
}
```
